# Optimizing an MI355X kernel written in HIP

```python
import math
import jax, jax.numpy as jnp
from jax import lax
import numpy as np

D_MODEL = 1024
BATCH = 8
SEQ = 2048
DEPTH = 2

HEAD_DIM = 64
POOL_DIM = D_MODEL // 4
POOL_WINDOWS = (2, 4, 8, 16)
POOL_GROUP = POOL_DIM // len(POOL_WINDOWS)
N_ATT_HEADS = (3 * D_MODEL // 8) // HEAD_DIM
N_KV_HEADS = 2
GQA_GROUP = N_ATT_HEADS // N_KV_HEADS
ATT_DIM = N_ATT_HEADS * HEAD_DIM
KV_DIM = N_KV_HEADS * HEAD_DIM
WINDOW = 128
N_BUCKETS = 32
MAX_DISTANCE = 128
N_GDN_HEADS = (3 * D_MODEL // 8) // HEAD_DIM
GDN_DIM = N_GDN_HEADS * HEAD_DIM
CONV_WIDTH = 4
GDN_CHUNK = 64
MIX_DIM = POOL_DIM + ATT_DIM + GDN_DIM
IN_DIM = POOL_DIM + ATT_DIM + 2 * KV_DIM + 4 * GDN_DIM + 2 * N_GDN_HEADS
N_EXPERTS = 32
TOP_K = 4
EXPERT_DIM = D_MODEL
SWIGLU_ALPHA = 1.702
SWIGLU_LIMIT = 7.0
MOE_BLOCK = 256
DEEPNORM_ALPHA = (2 * DEPTH) ** 0.25
DEEPNORM_BETA = (8 * DEPTH) ** -0.25
LN_EPS = 1e-5
NORM_EPS = 1e-6
NEG_INF = -1e30

kernel_name = "hybrid_pool_swa_gdn_moe_deepnorm"


def layer_norm(x, g, b):
    xf = x.astype(jnp.float32)
    mu = xf.mean(-1, keepdims=True)
    var = jnp.square(xf - mu).mean(-1, keepdims=True)
    y = (xf - mu) * lax.rsqrt(var + LN_EPS) * g.astype(jnp.float32) + b.astype(jnp.float32)
    return y.astype(x.dtype)


def t5_bucket(n):
    max_exact = N_BUCKETS // 2
    nf = jnp.maximum(n, 1).astype(jnp.float32)
    large = max_exact + (jnp.log(nf / max_exact) / math.log(MAX_DISTANCE / max_exact)
                         * (N_BUCKETS - max_exact)).astype(jnp.int32)
    large = jnp.minimum(large, N_BUCKETS - 1)
    return jnp.where(n < max_exact, n, large)


def pool_mixer(u, pool_w, pool_scale):
    Bb, S_, _ = u.shape
    uf = u.astype(jnp.float32)
    cnt_base = jnp.arange(1, S_ + 1, dtype=jnp.float32)
    outs = []
    for gi, w in enumerate(POOL_WINDOWS):
        ug = uf[..., gi * POOL_GROUP:(gi + 1) * POOL_GROUP]
        cs = jnp.cumsum(ug, axis=1)
        shifted = jnp.pad(cs, ((0, 0), (w, 0), (0, 0)))[:, :S_]
        cnt = jnp.minimum(cnt_base, float(w))
        outs.append((cs - shifted) / cnt[None, :, None] - ug)
    p = jnp.stack(outs, axis=2)
    y = jnp.einsum('bsgc,gcd->bsgd', p, pool_w.astype(jnp.float32)).reshape(Bb, S_, POOL_DIM)
    return (y * pool_scale.astype(jnp.float32)).astype(u.dtype)


def swa_attention(q, k, v, sinks, rel_bias):
    Bb, S_ = q.shape[:2]
    NB = S_ // WINDOW
    qf, kf, vf = (t.astype(jnp.float32) for t in (q, k, v))
    qb = qf.reshape(Bb, NB, WINDOW, N_KV_HEADS, GQA_GROUP, HEAD_DIM)

    def band(t):
        tp = jnp.pad(t, ((0, 0), (WINDOW, 0), (0, 0), (0, 0)))
        prev = tp[:, :S_].reshape(Bb, NB, WINDOW, N_KV_HEADS, HEAD_DIM)
        cur = t.reshape(Bb, NB, WINDOW, N_KV_HEADS, HEAD_DIM)
        return jnp.concatenate([prev, cur], axis=2)

    kb, vb = band(kf), band(vf)
    s = jnp.einsum('bnqhgd,bnkhd->bnhgqk', qb, kb) * (HEAD_DIM ** -0.5)
    qi = jnp.arange(WINDOW)[:, None]
    kj = jnp.arange(2 * WINDOW)[None, :]
    dist = qi + WINDOW - kj
    in_band = (dist >= 0) & (dist < WINDOW)
    key_abs = jnp.arange(NB)[:, None] * WINDOW - WINDOW + kj
    valid = in_band[None] & (key_abs >= 0)[:, None, :]
    bias = rel_bias.astype(jnp.float32)[t5_bucket(jnp.maximum(dist, 0))]
    bias = bias.transpose(2, 0, 1).reshape(N_KV_HEADS, GQA_GROUP, WINDOW, 2 * WINDOW)
    s = jnp.where(valid[None, :, None, None], s + bias[None, None], NEG_INF)
    sink = sinks.astype(jnp.float32).reshape(N_KV_HEADS, GQA_GROUP)[None, None, :, :, None, None]
    m = jnp.maximum(s.max(-1, keepdims=True), sink)
    p = jnp.exp(s - m)
    den = p.sum(-1, keepdims=True) + jnp.exp(sink - m)
    o = jnp.einsum('bnhgqk,bnkhd->bnqhgd', p / den, vb)
    return o.reshape(Bb, S_, ATT_DIM).astype(q.dtype)


def gated_delta_chunked(q, k, v, g, beta):
    Bb, S_, H, Dk = q.shape
    Dv = v.shape[-1]
    N = S_ // GDN_CHUNK
    C = GDN_CHUNK
    q = q * (Dk ** -0.5)

    def chunks(t):
        return t.reshape(Bb, N, C, H, -1).transpose(0, 3, 1, 2, 4)

    qc, kc, vc = chunks(q), chunks(k), chunks(v)
    gc = g.reshape(Bb, N, C, H).transpose(0, 3, 1, 2)
    bc = beta.reshape(Bb, N, C, H).transpose(0, 3, 1, 2)
    gcum = jnp.cumsum(gc, axis=-1)
    causal = jnp.tril(jnp.ones((C, C), dtype=bool))
    strict = jnp.tril(jnp.ones((C, C), dtype=jnp.float32), -1)
    decay = jnp.exp(jnp.where(causal, gcum[..., :, None] - gcum[..., None, :], -jnp.inf))
    kbeta = kc * bc[..., None]
    vbeta = vc * bc[..., None]
    L = jnp.einsum('bhnid,bhnjd->bhnij', kbeta, kc) * decay * strict
    a_mat = jnp.eye(C, dtype=jnp.float32) + L
    rhs = jnp.concatenate([vbeta, kbeta * jnp.exp(gcum)[..., None]], axis=-1)
    sol = lax.linalg.triangular_solve(a_mat, rhs, left_side=True, lower=True, unit_diagonal=True)
    u, w = sol[..., :Dv], sol[..., Dv:]
    attn = jnp.einsum('bhnid,bhnjd->bhnij', qc, kc) * decay
    q_dec = qc * jnp.exp(gcum)[..., None]
    k_dec = kc * jnp.exp(gcum[..., -1:] - gcum)[..., None]
    chunk_decay = jnp.exp(gcum[..., -1])

    def step(state, inp):
        u_n, w_n, qd_n, kd_n, a_n, cd_n = inp
        v_new = u_n - jnp.einsum('bhck,bhkv->bhcv', w_n, state)
        o_n = jnp.einsum('bhck,bhkv->bhcv', qd_n, state) + jnp.einsum('bhij,bhjv->bhiv', a_n, v_new)
        state = state * cd_n[..., None, None] + jnp.einsum('bhck,bhcv->bhkv', kd_n, v_new)
        return state, o_n

    xs = tuple(jnp.moveaxis(t, 2, 0) for t in (u, w, q_dec, k_dec, attn, chunk_decay))
    state0 = jnp.zeros((Bb, H, Dk, Dv), jnp.float32)
    _, o = lax.scan(step, state0, xs)
    return o.transpose(1, 0, 3, 2, 4).reshape(Bb, S_, H, Dv)


def gdn_mixer(qkv, z, b_raw, a_raw, conv_w, a_log, dt_bias, norm_w):
    Bb, S_, Cc = qkv.shape
    conv = lax.conv_general_dilated(
        qkv, conv_w.astype(qkv.dtype)[:, None, :], window_strides=(1,),
        padding=[(CONV_WIDTH - 1, 0)], dimension_numbers=('NWC', 'WIO', 'NWC'),
        feature_group_count=Cc)
    conv = jax.nn.silu(conv.astype(jnp.float32))
    q, k, v = (t.reshape(Bb, S_, N_GDN_HEADS, HEAD_DIM) for t in jnp.split(conv, 3, axis=-1))
    q = q * lax.rsqrt(jnp.sum(q * q, -1, keepdims=True) + NORM_EPS)
    k = k * lax.rsqrt(jnp.sum(k * k, -1, keepdims=True) + NORM_EPS)
    beta = jax.nn.sigmoid(b_raw.astype(jnp.float32))
    g = -jnp.exp(a_log.astype(jnp.float32)) * jax.nn.softplus(a_raw.astype(jnp.float32) + dt_bias.astype(jnp.float32))
    o = gated_delta_chunked(q, k, v, g, beta)
    o = o * lax.rsqrt(jnp.mean(o * o, -1, keepdims=True) + NORM_EPS) * norm_w.astype(jnp.float32)
    o = o * jax.nn.silu(z.astype(jnp.float32).reshape(Bb, S_, N_GDN_HEADS, HEAD_DIM))
    return o.reshape(Bb, S_, GDN_DIM).astype(qkv.dtype)


def hybrid_mixer(h, w_in, w_out, pool_w, pool_scale, sinks, rel_bias, conv_w, a_log, dt_bias, norm_w):
    Bb, S_, _ = h.shape
    proj = h @ w_in.astype(h.dtype)
    sizes = (POOL_DIM, ATT_DIM, KV_DIM, KV_DIM, 3 * GDN_DIM, GDN_DIM, N_GDN_HEADS, N_GDN_HEADS)
    cuts = tuple(int(i) for i in np.cumsum(sizes)[:-1])
    u_pool, aq, ak, av, gqkv, gz, gb, ga = jnp.split(proj, cuts, axis=-1)
    y_pool = pool_mixer(u_pool, pool_w, pool_scale)
    y_att = swa_attention(aq.reshape(Bb, S_, N_ATT_HEADS, HEAD_DIM),
                          ak.reshape(Bb, S_, N_KV_HEADS, HEAD_DIM),
                          av.reshape(Bb, S_, N_KV_HEADS, HEAD_DIM), sinks, rel_bias)
    y_gdn = gdn_mixer(gqkv, gz, gb, ga, conv_w, a_log, dt_bias, norm_w)
    y = jnp.concatenate([y_pool, y_att, y_gdn], axis=-1)
    return y @ w_out.astype(h.dtype)


def moe_ffn(h, router_w, router_b, w_up, b_up, w_down, b_down):
    Bb, S_, D = h.shape
    T = Bb * S_
    A = T * TOP_K
    xt = h.reshape(T, D)
    logits = xt.astype(jnp.float32) @ router_w.astype(jnp.float32) + router_b.astype(jnp.float32)
    top_vals, top_idx = lax.top_k(logits, TOP_K)
    gates = jax.nn.softmax(top_vals, axis=-1)
    flat_e = top_idx.reshape(A)
    order = jnp.argsort(flat_e, stable=True)
    sorted_e = flat_e[order]
    counts = jnp.bincount(flat_e, length=N_EXPERTS)
    padded = ((counts + MOE_BLOCK - 1) // MOE_BLOCK) * MOE_BLOCK
    start = jnp.cumsum(counts) - counts
    pcum = jnp.cumsum(padded)
    pstart = pcum - padded
    dest_sorted = pstart[sorted_e] + (jnp.arange(A) - start[sorted_e])
    dest = jnp.zeros((A,), jnp.int32).at[order].set(dest_sorted.astype(jnp.int32))
    n_blocks = -(-A // MOE_BLOCK) + N_EXPERTS
    P = n_blocks * MOE_BLOCK
    tok = jnp.arange(A) // TOP_K
    xbuf = jnp.zeros((P, D), h.dtype).at[dest].set(xt[tok])
    block_e = jnp.minimum(jnp.searchsorted(pcum, jnp.arange(n_blocks) * MOE_BLOCK, side='right'),
                          N_EXPERTS - 1)

    def expert_block(args):
        xb, e = args
        hb = xb @ w_up[e].astype(xb.dtype) + b_up[e].astype(xb.dtype)
        x_glu = jnp.minimum(hb[:, :EXPERT_DIM], SWIGLU_LIMIT)
        x_lin = jnp.clip(hb[:, EXPERT_DIM:], -SWIGLU_LIMIT, SWIGLU_LIMIT)
        act = x_glu * jax.nn.sigmoid(SWIGLU_ALPHA * x_glu) * (x_lin + 1)
        return act @ w_down[e].astype(xb.dtype) + b_down[e].astype(xb.dtype)

    ybuf = lax.map(expert_block, (xbuf.reshape(n_blocks, MOE_BLOCK, D), block_e)).reshape(P, D)
    y = ybuf[dest].reshape(T, TOP_K, D)
    out = jnp.einsum('tk,tkd->td', gates.astype(y.dtype), y)
    return out.reshape(Bb, S_, D)


def setup_inputs(seed: int = 0) -> dict:
    key = jax.random.key(seed)
    ks = jax.random.split(key, 26)
    f32 = jnp.float32

    def nrm(k, shape, s):
        return jax.random.normal(k, shape, f32) * s

    dt = jnp.exp(jax.random.uniform(ks[15], (DEPTH, N_GDN_HEADS), f32, math.log(1e-3), math.log(1e-1)))
    return {
        "x": nrm(ks[0], (BATCH, SEQ, D_MODEL), 1.0),
        "c": nrm(ks[1], (BATCH, D_MODEL), 1.0),
        "rel_bias": nrm(ks[2], (N_BUCKETS, N_ATT_HEADS), 0.3),
        "w_in": nrm(ks[3], (DEPTH, D_MODEL, IN_DIM), D_MODEL ** -0.5),
        "w_out": nrm(ks[4], (DEPTH, MIX_DIM, D_MODEL), MIX_DIM ** -0.5 * DEEPNORM_BETA),
        "w_ada": nrm(ks[5], (DEPTH, D_MODEL, 6 * D_MODEL), D_MODEL ** -0.5),
        "b_ada": nrm(ks[6], (DEPTH, 6 * D_MODEL), 0.02),
        "ln1_g": 1.0 + nrm(ks[7], (DEPTH, D_MODEL), 0.02),
        "ln1_b": nrm(ks[8], (DEPTH, D_MODEL), 0.02),
        "ln2_g": 1.0 + nrm(ks[9], (DEPTH, D_MODEL), 0.02),
        "ln2_b": nrm(ks[10], (DEPTH, D_MODEL), 0.02),
        "pool_w": nrm(ks[11], (DEPTH, len(POOL_WINDOWS), POOL_GROUP, POOL_GROUP), POOL_GROUP ** -0.5),
        "pool_scale": 1.0 + nrm(ks[12], (DEPTH, POOL_DIM), 0.02),
        "attn_sinks": nrm(ks[13], (DEPTH, N_ATT_HEADS), 1.0),
        "conv_w": nrm(ks[14], (DEPTH, CONV_WIDTH, 3 * GDN_DIM), CONV_WIDTH ** -0.5),
        "gdn_a_log": jnp.log(jax.random.uniform(ks[16], (DEPTH, N_GDN_HEADS), f32, 1.0, 16.0)),
        "gdn_dt_bias": dt + jnp.log(-jnp.expm1(-dt)),
        "gdn_norm_w": 1.0 + nrm(ks[17], (DEPTH, HEAD_DIM), 0.02),
        "router_w": nrm(ks[18], (DEPTH, D_MODEL, N_EXPERTS), D_MODEL ** -0.5),
        "router_b": nrm(ks[19], (DEPTH, N_EXPERTS), 0.01),
        "exp_w_up": nrm(ks[20], (DEPTH, N_EXPERTS, D_MODEL, 2 * EXPERT_DIM), D_MODEL ** -0.5),
        "exp_b_up": nrm(ks[21], (DEPTH, N_EXPERTS, 2 * EXPERT_DIM), 0.01),
        "exp_w_down": nrm(ks[22], (DEPTH, N_EXPERTS, EXPERT_DIM, D_MODEL), EXPERT_DIM ** -0.5 * DEEPNORM_BETA),
        "exp_b_down": nrm(ks[23], (DEPTH, N_EXPERTS, D_MODEL), 0.01),
    }


def reference(x, c, rel_bias, w_in, w_out, w_ada, b_ada, ln1_g, ln1_b, ln2_g, ln2_b,
              pool_w, pool_scale, attn_sinks, conv_w, gdn_a_log, gdn_dt_bias, gdn_norm_w,
              router_w, router_b, exp_w_up, exp_b_up, exp_w_down, exp_b_down):
    c_act = jax.nn.silu(c)
    for l in range(DEPTH):
        mod = (c_act @ w_ada[l] + b_ada[l]).astype(x.dtype)
        sh1, sc1, g1, sh2, sc2, g2 = (m[:, None, :] for m in jnp.split(mod, 6, axis=-1))
        h = x * (1 + sc1) + sh1
        y = hybrid_mixer(h, w_in[l], w_out[l], pool_w[l], pool_scale[l], attn_sinks[l], rel_bias,
                         conv_w[l], gdn_a_log[l], gdn_dt_bias[l], gdn_norm_w[l])
        x = layer_norm(DEEPNORM_ALPHA * x + g1 * y, ln1_g[l], ln1_b[l])
        h = x * (1 + sc2) + sh2
        y = moe_ffn(h, router_w[l], router_b[l], exp_w_up[l], exp_b_up[l], exp_w_down[l], exp_b_down[l])
        x = layer_norm(DEEPNORM_ALPHA * x + g2 * y, ln2_g[l], ln2_b[l])
    return x
```

```cpp
#include <hip/hip_runtime.h>
#include <hip/hip_cooperative_groups.h>
#include <cstdio>
#include <cstdint>
namespace cg = cooperative_groups;

#define LAS __attribute__((address_space(3)))
typedef unsigned short bf16_t;
typedef short bf16x8 __attribute__((ext_vector_type(8)));
typedef float f32x4 __attribute__((ext_vector_type(4)));
typedef float f32x2 __attribute__((ext_vector_type(2)));
typedef unsigned u32x4 __attribute__((ext_vector_type(4)));
typedef unsigned u32x2 __attribute__((ext_vector_type(2)));

constexpr int T_ = 16384, D_ = 1024, NB_ = 8, SEQ_ = 2048, DEPTH_ = 2;
constexpr int IN_DIM = 2444, NPROJ = 2560;
constexpr int C_POOL = 0, C_AQ = 256, C_AK = 640, C_AV = 768, C_GQ = 896, C_GK = 1280, C_GV = 1664, C_GZ = 2048, C_GB = 2432, C_GA = 2438;
constexpr int NE_ = 32, TOPK_ = 4, NASSIGN = T_ * TOPK_, NRB_MAX = NASSIGN / 256 + NE_, PROWS = NRB_MAX * 256;
constexpr float ALPHA_ = 1.41421356237309515f;
constexpr float LN_EPS_ = 1e-5f, NORM_EPS_ = 1e-6f;
constexpr int NTHREADS = 512, NWAVES = 8;
constexpr int LDS_BYTES = 147456;

constexpr size_t MiB = 1u << 20;
constexpr size_t WS_CTL = 0;
constexpr size_t WS_MOD = 1 * MiB;
constexpr size_t WS_ROUTE = 2 * MiB;
constexpr size_t WS_WIN = 4 * MiB;
constexpr size_t WS_WOUT = 14 * MiB;
constexpr size_t WS_WUP = 18 * MiB;
constexpr size_t WS_WDN = WS_WUP + 256 * MiB;
constexpr size_t WS_H = WS_WDN + 128 * MiB;
constexpr size_t WS_H2 = WS_H + 32 * MiB;
constexpr size_t WS_PROJ = WS_H2 + 32 * MiB;
constexpr size_t WS_MIX = WS_PROJ + 80 * MiB;
constexpr size_t WS_Z = WS_MIX + 32 * MiB;
constexpr size_t WS_X = WS_Z + 64 * MiB;
constexpr size_t WS_QN = WS_X + 64 * MiB;
constexpr size_t WS_KN = WS_QN + 24 * MiB;
constexpr size_t WS_VV = WS_KN + 24 * MiB;
constexpr size_t WS_OR = WS_VV + 24 * MiB;
constexpr size_t WS_GB = WS_OR + 24 * MiB;
constexpr size_t WS_TOPI = WS_GB + 1 * MiB;
constexpr size_t WS_TOPG = WS_TOPI + 1 * MiB;
constexpr size_t WS_XBUF = WS_TOPG + 1 * MiB;
constexpr size_t WS_ACT = WS_XBUF + 144 * MiB;
constexpr size_t WS_Y4 = WS_ACT + 144 * MiB;
constexpr size_t WS_END = WS_Y4 + 128 * MiB;
constexpr int R_COUNTS = 0;
constexpr int R_BLKE = 8192;
constexpr int R_NRB = 8192 + 512;
constexpr int R_ROWTOK = 16384;

__device__ __forceinline__ unsigned f2bf(float f) { unsigned u = __builtin_bit_cast(unsigned, f); return (u + 0x7fffu + ((u >> 16) & 1u)) >> 16; }
__device__ __forceinline__ unsigned pk2(float lo, float hi) { return f2bf(lo) | (f2bf(hi) << 16); }
__device__ __forceinline__ float bf2f(unsigned short b) { return __builtin_bit_cast(float, (unsigned)b << 16); }
__device__ __forceinline__ float bflo(unsigned w) { return __builtin_bit_cast(float, w << 16); }
__device__ __forceinline__ float bfhi(unsigned w) { return __builtin_bit_cast(float, w & 0xffff0000u); }
__device__ __forceinline__ float wave_sum(float v) {
#pragma unroll
    for (int o = 1; o < 64; o <<= 1) v += __shfl_xor(v, o);
    return v;
}
__device__ __forceinline__ float wave_max(float v) {
#pragma unroll
    for (int o = 1; o < 64; o <<= 1) v = fmaxf(v, __shfl_xor(v, o));
    return v;
}
__device__ __forceinline__ float silu_f(float x) { return x / (1.f + __expf(-x)); }
__device__ __forceinline__ float sigmoid_f(float x) { return 1.f / (1.f + __expf(-x)); }

namespace pg8 {
constexpr int BM = 256, BK = 64, HALF = 128, HTB = HALF * BK * 2, STAGE_BYTES = 8 * HTB, NXCD = 8, WGM = 8, KD = 1024;
__host__ __device__ __forceinline__ int lds_byte(int r, int c) { const int st = (r >> 4) * 2 + (c >> 5), rr = r & 15, cc = c & 31, ob = rr * 64 + cc * 2; return st * 1024 + (ob ^ (((ob >> 9) & 1) << 5)); }
__host__ __device__ __forceinline__ void stage_rc(int b, int& R, int& C) { const int st = b / 1024, sb = b % 1024, swz = sb ^ (((sb >> 9) & 1) << 5); R = (st >> 1) * 16 + swz / 64; C = (st & 1) * 32 + (swz % 64) / 2; }
__host__ __device__ __forceinline__ int perm32(int rho) { const int n = rho >> 4, i = rho & 15; return 8 * (i >> 2) + 4 * n + (i & 3); }

struct Unit { int pm, pn, e; const char* a; const char* b; };

__device__ __forceinline__ void tile_of(int L, int nM, int nN, int& pm, int& pn) {
    const int nwg = nM * nN; int wgid = L;
    { const int q = nwg / NXCD, r = nwg % NXCD, xcd = wgid % NXCD, off = wgid / NXCD; wgid = (xcd < r ? xcd * (q + 1) : r * (q + 1) + (xcd - r) * q) + off; }
    const int nig = WGM * nN, gid = wgid / nig, fm = gid * WGM, gsz = (nM - fm) < WGM ? (nM - fm) : WGM;
    pm = fm + ((wgid % nig) % gsz); pn = (wgid % nig) / gsz;
}

__device__ __forceinline__ unsigned cvt_pk_bf16(float lo, float hi) { unsigned r; asm volatile("v_cvt_pk_bf16_f32 %0, %1, %2" : "=v"(r) : "v"(lo), "v"(hi)); return r; }

template <class Epi, class Sched, bool ALIGN_EPI, bool SP2>
__device__ __forceinline__ void gemm_phase(LAS unsigned char* lds, const Sched& S, const Epi& E) {
    const int tid = threadIdx.x, wid = __builtin_amdgcn_readfirstlane(tid >> 6), lane = tid & 63, wr = wid >> 2, wc = wid & 3, fr = lane & 15, fq = lane >> 4;
    constexpr int K = KD, nt = K / BK;
    unsigned voffA[2], voffB[2];
#pragma unroll
    for (int i = 0; i < 2; ++i) { int R, C; stage_rc(tid * 16 + i * 8192, R, C); const int Rb = Epi::PERM ? ((R & ~31) + perm32(R & 31)) : R;
        voffA[i] = (unsigned)(R * K + C) * 2u; voffB[i] = (unsigned)(Rb * K + C) * 2u; }
    const size_t kstep = (size_t)(BK * 2);
    const size_t hstep = (size_t)HALF * K * 2;
    const unsigned ldsw = (unsigned)wid * 1024u;
    const int aoff = lds_byte(wr * 64 + fr, fq * 8), boff = lds_byte(wc * 32 + fr, fq * 8);
#define PG8_SA(b, h) (((b) * 2 + (h)) * HTB)
#define PG8_SB(b, h) ((4 + (b) * 2 + (h)) * HTB)
#define PG8_STAGE(bufoff, gbase, voff) do { _Pragma("unroll") for (int _i = 0; _i < 2; ++_i) \
        __builtin_amdgcn_global_load_lds((const unsigned*)((const char*)(gbase) + (voff)[_i]), (LAS unsigned*)(lds + (bufoff) + ldsw + _i * 8192), 16, 0, 0); } while (0)
#define PG8_LDA(dst, b, h) do { _Pragma("unroll") for (int m = 0; m < 4; ++m) _Pragma("unroll") for (int k = 0; k < 2; ++k) dst[m][k] = *(const LAS bf16x8*)(lds + PG8_SA(b, h) + aoff + m * 2048 + k * 1024); } while (0)
#define PG8_LDB(dst, b, h) do { _Pragma("unroll") for (int n = 0; n < 2; ++n) _Pragma("unroll") for (int k = 0; k < 2; ++k) dst[n][k] = *(const LAS bf16x8*)(lds + PG8_SB(b, h) + boff + n * 2048 + k * 1024); } while (0)
#define PG8_MMA(ai, bj, At, Bt) do { __builtin_amdgcn_s_setprio(1); _Pragma("unroll") for (int m = 0; m < 4; ++m) _Pragma("unroll") for (int n = 0; n < 2; ++n) _Pragma("unroll") for (int k = 0; k < 2; ++k) \
        acc[ai][bj][m][n] = __builtin_amdgcn_mfma_f32_16x16x32_bf16(Bt[n][k], At[m][k], acc[ai][bj][m][n], 0, 0, 0); __builtin_amdgcn_s_setprio(0); } while (0)
#define PG8_WAIT_V(n) asm volatile("s_waitcnt vmcnt(" #n ")" ::: "memory")
#define PG8_WAIT_L(n) asm volatile("s_waitcnt lgkmcnt(" #n ")" ::: "memory")
#define PG8_BAR __builtin_amdgcn_s_barrier()
#define PG8_SCHED __builtin_amdgcn_sched_barrier(0)
    Unit cur, nxt; int ui = 0;
    if (!S.next(0, cur)) return;
    f32x4 acc[2][2][4][2];
#pragma unroll
    for (int a = 0; a < 2; ++a)
#pragma unroll
        for (int b = 0; b < 2; ++b)
#pragma unroll
            for (int m = 0; m < 4; ++m)
#pragma unroll
                for (int n = 0; n < 2; ++n) acc[a][b][m][n] = (f32x4){0.f, 0.f, 0.f, 0.f};
    bf16x8 At[4][2], B0[2][2], B1[2][2];
    const char* cA = cur.a; const char* cB = cur.b;
    if constexpr (SP2) {
        PG8_STAGE(PG8_SB(0, 0), cB, voffB); PG8_STAGE(PG8_SB(0, 1), cB + hstep, voffB); PG8_STAGE(PG8_SA(0, 0), cA, voffA); PG8_STAGE(PG8_SA(0, 1), cA + hstep, voffA);
        if (wr == 1) PG8_BAR;
        PG8_WAIT_V(2); PG8_BAR;
        PG8_STAGE(PG8_SB(1, 0), cB + kstep, voffB); PG8_STAGE(PG8_SA(1, 0), cA + kstep, voffA); PG8_STAGE(PG8_SB(1, 1), cB + hstep + kstep, voffB);
        PG8_WAIT_V(6); PG8_BAR;
    } else {
        PG8_STAGE(PG8_SB(0, 0), cB, voffB); PG8_STAGE(PG8_SA(0, 0), cA, voffA); PG8_STAGE(PG8_SB(0, 1), cB + hstep, voffB); PG8_STAGE(PG8_SA(0, 1), cA + hstep, voffA);
        if (wr == 1) PG8_BAR;
        PG8_WAIT_V(4); PG8_BAR;
        PG8_STAGE(PG8_SB(1, 0), cB + kstep, voffB); PG8_STAGE(PG8_SA(1, 0), cA + kstep, voffA); PG8_STAGE(PG8_SB(1, 1), cB + hstep + kstep, voffB);
        PG8_WAIT_V(6); PG8_BAR;
    }
    for (;;) {
        const bool has_next = S.next(ui + 1, nxt);
        const char* nA = has_next ? nxt.a : cA; const char* nB = has_next ? nxt.b : cB;
        for (int t = 0; t < nt; t += 2) {
            const bool last = (t == nt - 2);
            const char* a1 = cA + (size_t)(t + 1) * kstep;
            const char* a2 = last ? nA : cA + (size_t)(t + 2) * kstep; const char* b2 = last ? nB : cB + (size_t)(t + 2) * kstep;
            const char* a3 = a2 + kstep; const char* b3 = b2 + kstep;
            if constexpr (SP2) {
            PG8_LDB(B0, 0, 0); PG8_LDB(B1, 0, 1); PG8_SCHED; PG8_LDA(At, 0, 0); PG8_STAGE(PG8_SA(1, 1), a1 + hstep, voffA);
            PG8_WAIT_V(8); PG8_WAIT_L(0); PG8_BAR; PG8_MMA(0, 0, At, B0); PG8_MMA(0, 1, At, B1); PG8_BAR; PG8_SCHED;
            PG8_LDA(At, 0, 1); PG8_STAGE(PG8_SB(0, 0), b2, voffB); PG8_STAGE(PG8_SB(0, 1), b2 + hstep, voffB); PG8_STAGE(PG8_SA(0, 0), a2, voffA);
            PG8_WAIT_V(8); PG8_WAIT_L(0); PG8_BAR; PG8_MMA(1, 0, At, B0); PG8_MMA(1, 1, At, B1); PG8_BAR; PG8_SCHED;
            PG8_LDB(B0, 1, 0); PG8_LDB(B1, 1, 1); PG8_SCHED; PG8_LDA(At, 1, 0); PG8_STAGE(PG8_SA(0, 1), a2 + hstep, voffA);
            PG8_WAIT_V(8); PG8_WAIT_L(0); PG8_BAR; PG8_MMA(0, 0, At, B0); PG8_MMA(0, 1, At, B1); PG8_BAR; PG8_SCHED;
            PG8_LDA(At, 1, 1); PG8_STAGE(PG8_SB(1, 0), b3, voffB); PG8_STAGE(PG8_SB(1, 1), b3 + hstep, voffB); PG8_STAGE(PG8_SA(1, 0), a3, voffA);
            PG8_WAIT_V(8); PG8_WAIT_L(0); PG8_BAR; PG8_MMA(1, 0, At, B0); PG8_MMA(1, 1, At, B1); PG8_BAR; PG8_SCHED;
            } else {
            PG8_LDB(B0, 0, 0); PG8_SCHED; PG8_LDA(At, 0, 0); PG8_STAGE(PG8_SA(1, 1), a1 + hstep, voffA);
            PG8_WAIT_L(8); PG8_BAR; PG8_WAIT_L(0); PG8_MMA(0, 0, At, B0); PG8_BAR; PG8_SCHED;
            PG8_LDB(B1, 0, 1); PG8_STAGE(PG8_SB(0, 0), b2, voffB);
            PG8_BAR; PG8_WAIT_L(0); PG8_MMA(0, 1, At, B1); PG8_BAR;
            PG8_LDA(At, 0, 1); PG8_STAGE(PG8_SA(0, 0), a2, voffA);
            PG8_BAR; PG8_WAIT_L(0); PG8_MMA(1, 0, At, B0); PG8_BAR; PG8_SCHED;
            PG8_STAGE(PG8_SB(0, 1), b2 + hstep, voffB);
            PG8_WAIT_V(6); PG8_BAR; PG8_MMA(1, 1, At, B1); PG8_BAR;
            PG8_LDB(B0, 1, 0); PG8_SCHED; PG8_LDA(At, 1, 0); PG8_STAGE(PG8_SA(0, 1), a2 + hstep, voffA);
            PG8_WAIT_L(8); PG8_BAR; PG8_WAIT_L(0); PG8_MMA(0, 0, At, B0); PG8_BAR; PG8_SCHED;
            PG8_LDB(B1, 1, 1); PG8_STAGE(PG8_SB(1, 0), b3, voffB);
            PG8_BAR; PG8_WAIT_L(0); PG8_MMA(0, 1, At, B1); PG8_BAR;
            PG8_LDA(At, 1, 1); PG8_STAGE(PG8_SA(1, 0), a3, voffA);
            PG8_BAR; PG8_WAIT_L(0); PG8_MMA(1, 0, At, B0); PG8_BAR; PG8_SCHED;
            PG8_STAGE(PG8_SB(1, 1), b3 + hstep, voffB);
            PG8_WAIT_V(6); PG8_BAR; PG8_MMA(1, 1, At, B1); PG8_BAR;
            }
        }
        if constexpr (ALIGN_EPI) { if (wr == 0) PG8_BAR; }
        E(acc, cur, wr, wc, fr, fq);
        if (!has_next) break;
#pragma unroll
        for (int a = 0; a < 2; ++a)
#pragma unroll
            for (int b = 0; b < 2; ++b)
#pragma unroll
                for (int m = 0; m < 4; ++m)
#pragma unroll
                    for (int n = 0; n < 2; ++n) acc[a][b][m][n] = (f32x4){0.f, 0.f, 0.f, 0.f};
        cur = nxt; cA = nA; cB = nB; ++ui;
        if constexpr (ALIGN_EPI) { if (wr == 1) PG8_BAR; }
    }
    PG8_WAIT_V(0);
    if constexpr (!ALIGN_EPI) { if (wr == 0) PG8_BAR; }
    PG8_BAR;
#undef PG8_SA
#undef PG8_SB
#undef PG8_STAGE
#undef PG8_LDA
#undef PG8_LDB
#undef PG8_MMA
#undef PG8_WAIT_V
#undef PG8_WAIT_L
#undef PG8_BAR
#undef PG8_SCHED
}
}

enum { I_X = 0, I_C, I_RELB, I_WIN, I_WOUT, I_WADA, I_BADA, I_LN1G, I_LN1B, I_LN2G, I_LN2B, I_POOLW, I_POOLS, I_SINKS, I_CONVW, I_ALOG, I_DTB, I_NORMW,
       I_RW, I_RB, I_WUP, I_BUP, I_WDN, I_BDN, N_IN };
struct Params { const float* in[N_IN]; float* out; unsigned char* ws; };

struct Ctx {
    const Params* P; unsigned char* lds; int tid, lane, wave, gw, ngw, bid, nblk;
};

enum { PH_CONV = 0, PH_MOD, PH_PREP0, PH_L0 };
enum { L_GEMM1 = 0, L_MIXA, L_GSCAN, L_GOUT, L_GEMM2, L_LN1, L_ROUTEA, L_ROUTEB, L_GATHER, L_UP, L_DOWN, L_COMBINE, L_NPH };
constexpr int N_PHASES = PH_L0 + DEPTH_ * L_NPH;

__device__ __forceinline__ void transpose_item(const float* W, int N, bf16_t* WT, int k0, int n0, int drow0, float* scr, int lane) {
    const int n = n0 + (lane & 31); const bool ok = n < N;
#pragma unroll 8
    for (int i = 0; i < 32; ++i) { const int kk = 2 * i + (lane >> 5); scr[kk * 33 + (lane & 31)] = ok ? W[(size_t)(k0 + kk) * N + n] : 0.f; }
    asm volatile("s_waitcnt lgkmcnt(0)" ::: "memory");
    const int c = lane & 7;
#pragma unroll
    for (int j = 0; j < 4; ++j) { const int nn = (lane >> 3) + 8 * j; const float* s = scr + (8 * c) * 33 + nn;
        u32x4 o; o.x = pk2(s[0 * 33], s[1 * 33]); o.y = pk2(s[2 * 33], s[3 * 33]); o.z = pk2(s[4 * 33], s[5 * 33]); o.w = pk2(s[6 * 33], s[7 * 33]);
        *(u32x4*)(WT + (size_t)(drow0 + nn) * 1024 + k0 + 8 * c) = o; }
    asm volatile("s_waitcnt lgkmcnt(0)" ::: "memory");
}
__device__ __forceinline__ void ph_conv(const Ctx& c) {
    const Params& P = *c.P;
    float* scr = (float*)(c.lds + c.wave * 16384);
    constexpr int I_IN = 16 * 80, I_OUT = 16 * 32, I_UP = 32 * 16 * 64, I_DN = 32 * 16 * 32, I_LAYER = I_IN + I_OUT + I_UP + I_DN;
    for (int it = c.gw; it < DEPTH_ * I_LAYER; it += c.ngw) {
        const int l = it / I_LAYER; int r = it % I_LAYER;
        if (r < I_IN) { const int kb = r / 80, nb = r % 80;
            transpose_item(P.in[I_WIN] + (size_t)l * 1024 * IN_DIM, IN_DIM, (bf16_t*)(P.ws + WS_WIN) + (size_t)l * NPROJ * 1024, 64 * kb, 32 * nb, 32 * nb, scr, c.lane); continue; }
        r -= I_IN;
        if (r < I_OUT) { const int kb = r / 32, nb = r % 32;
            transpose_item(P.in[I_WOUT] + (size_t)l * 1024 * 1024, 1024, (bf16_t*)(P.ws + WS_WOUT) + (size_t)l * 1024 * 1024, 64 * kb, 32 * nb, 32 * nb, scr, c.lane); continue; }
        r -= I_OUT;
        if (r < I_UP) { const int e = r / 1024, rr = r % 1024, kb = rr / 64, nb = rr % 64, n0 = 32 * nb, bj = n0 / 1024, rem = n0 % 1024, pn = rem / 128, c0 = rem % 128;
            transpose_item(P.in[I_WUP] + (size_t)(l * 32 + e) * 1024 * 2048, 2048, (bf16_t*)(P.ws + WS_WUP) + (size_t)(l * 32 + e) * 2048 * 1024, 64 * kb, n0, pn * 256 + bj * 128 + c0, scr, c.lane); continue; }
        r -= I_UP;
        { const int e = r / 512, rr = r % 512, kb = rr / 32, nb = rr % 32;
            transpose_item(P.in[I_WDN] + (size_t)(l * 32 + e) * 1024 * 1024, 1024, (bf16_t*)(P.ws + WS_WDN) + (size_t)(l * 32 + e) * 1024 * 1024, 64 * kb, 32 * nb, 32 * nb, scr, c.lane); }
    }
}

__device__ __forceinline__ void ph_mod(const Ctx& c) {
    const Params& P = *c.P;
    float* cs = (float*)c.lds;
    float* part = cs + 8192;
    for (int i = c.tid; i < 8192; i += NTHREADS) cs[i] = silu_f(P.in[I_C][i]);
    __syncthreads();
    float* mod = (float*)(P.ws + WS_MOD);
    for (int item = c.bid; item < DEPTH_ * 96; item += c.nblk) {
        const int l = item / 96, j = (item % 96) * 64 + c.lane;
        const float* w = P.in[I_WADA] + (size_t)l * 1024 * 6144 + j;
        float acc[8];
#pragma unroll
        for (int b = 0; b < 8; ++b) acc[b] = 0.f;
        const int k0 = c.wave * 128;
#pragma unroll 8
        for (int k = k0; k < k0 + 128; ++k) { const float wv = w[(size_t)k * 6144];
#pragma unroll
            for (int b = 0; b < 8; ++b) acc[b] += cs[b * 1024 + k] * wv; }
#pragma unroll
        for (int b = 0; b < 8; ++b) part[(c.wave * 8 + b) * 64 + c.lane] = acc[b];
        __syncthreads();
        { const int b = c.tid >> 6, col = c.tid & 63; float s = 0.f;
#pragma unroll
          for (int w8 = 0; w8 < 8; ++w8) s += part[(w8 * 8 + b) * 64 + col];
          const int jj = (item % 96) * 64 + col;
          mod[((size_t)l * 8 + b) * 6144 + jj] = s + P.in[I_BADA][l * 6144 + jj]; }
        __syncthreads();
    }
}

__device__ __forceinline__ void store_bf16_row(bf16_t* row, int lane, const f32x4 (&v)[4]) {
#pragma unroll
    for (int j = 0; j < 4; ++j) { u32x2 w; w.x = pk2(v[j][0], v[j][1]); w.y = pk2(v[j][2], v[j][3]); *(u32x2*)(row + 4 * lane + 256 * j) = w; }
}
__device__ __forceinline__ void modulate(f32x4 (&h)[4], const f32x4 (&x)[4], const float* sh, const float* sc, int lane) {
#pragma unroll
    for (int j = 0; j < 4; ++j) { const f32x4 a = *(const f32x4*)(sc + 4 * lane + 256 * j), b = *(const f32x4*)(sh + 4 * lane + 256 * j); h[j] = x[j] * (1.f + a) + b; }
}
__device__ __forceinline__ void ln_rows(f32x4 (&v)[4], const float* g, const float* b, int lane) {
    float s = 0.f;
#pragma unroll
    for (int j = 0; j < 4; ++j) s += (v[j][0] + v[j][1]) + (v[j][2] + v[j][3]);
    const float mean = wave_sum(s) * (1.f / 1024.f); float s2 = 0.f;
#pragma unroll
    for (int j = 0; j < 4; ++j) { v[j] = v[j] - mean; s2 += (v[j][0] * v[j][0] + v[j][1] * v[j][1]) + (v[j][2] * v[j][2] + v[j][3] * v[j][3]); }
    const float rstd = 1.f / sqrtf(wave_sum(s2) * (1.f / 1024.f) + LN_EPS_);
#pragma unroll
    for (int j = 0; j < 4; ++j) { const f32x4 gg = *(const f32x4*)(g + 4 * lane + 256 * j), bb = *(const f32x4*)(b + 4 * lane + 256 * j); v[j] = v[j] * rstd * gg + bb; }
}

__device__ __forceinline__ void ph_prep0(const Ctx& c) {
    const Params& P = *c.P; const float* mod = (const float*)(P.ws + WS_MOD);
    bf16_t* H = (bf16_t*)(P.ws + WS_H);
    for (int t = c.gw; t < T_; t += c.ngw) {
        const int b = t / SEQ_; const float* xr = P.in[I_X] + (size_t)t * 1024;
        f32x4 x[4], h[4];
#pragma unroll
        for (int j = 0; j < 4; ++j) x[j] = *(const f32x4*)(xr + 4 * c.lane + 256 * j);
        modulate(h, x, mod + (size_t)b * 6144, mod + (size_t)b * 6144 + 1024, c.lane);
        store_bf16_row(H + (size_t)t * 1024, c.lane, h);
    }
}

struct DenseSched {
    const char* A; const char* Bt; int nM, nN, G, c;
    __device__ __forceinline__ bool next(int i, pg8::Unit& u) const {
        const int L = i * G + c; if (L >= nM * nN) return false;
        pg8::tile_of(L, nM, nN, u.pm, u.pn); u.e = 0;
        u.a = A + (size_t)u.pm * 256 * 2048; u.b = Bt + (size_t)u.pn * 256 * 2048; return true; }
};
struct MoeSched {
    const char* A; const char* Bt; const int* blk_e; int nrb, nN, G, c; size_t estride;
    __device__ __forceinline__ bool next(int i, pg8::Unit& u) const {
        const int L = i * G + c; if (L >= nrb * nN) return false;
        pg8::tile_of(L, nrb, nN, u.pm, u.pn); u.e = blk_e[u.pm];
        u.a = A + (size_t)u.pm * 256 * 2048; u.b = Bt + (size_t)u.e * estride + (size_t)u.pn * 256 * 2048; return true; }
};
struct EpiStoreBf16 {
    static constexpr bool PERM = true;
    bf16_t* O; int ldc;
    __device__ __forceinline__ void operator()(const f32x4 (&acc)[2][2][4][2], const pg8::Unit& u, int wr, int wc, int fr, int fq) const {
        const int row0 = u.pm * 256 + wr * 64 + fr, col0 = u.pn * 256 + wc * 32 + 8 * fq;
#pragma unroll
        for (int ai = 0; ai < 2; ++ai)
#pragma unroll
            for (int m = 0; m < 4; ++m) { bf16_t* rowp = O + (size_t)(row0 + ai * 128 + m * 16) * ldc + col0;
#pragma unroll
                for (int bj = 0; bj < 2; ++bj) { const f32x4 v0 = acc[ai][bj][m][0], v1 = acc[ai][bj][m][1];
                    u32x4 w; w.x = pg8::cvt_pk_bf16(v0[0], v0[1]); w.y = pg8::cvt_pk_bf16(v0[2], v0[3]); w.z = pg8::cvt_pk_bf16(v1[0], v1[1]); w.w = pg8::cvt_pk_bf16(v1[2], v1[3]);
                    *(u32x4*)(rowp + bj * 128) = w; } }
    }
};
struct EpiResid {
    static constexpr bool PERM = false;
    const float* X; const float* gate; float* Z;
    __device__ __forceinline__ void operator()(const f32x4 (&acc)[2][2][4][2], const pg8::Unit& u, int wr, int wc, int fr, int fq) const {
        const int row0 = u.pm * 256 + wr * 64 + fr, col0 = u.pn * 256 + wc * 32 + 4 * fq;
        const float* gp = gate + (size_t)(u.pm >> 3) * 6144 + col0;
        f32x4 gv[2][2];
#pragma unroll
        for (int bj = 0; bj < 2; ++bj)
#pragma unroll
            for (int n = 0; n < 2; ++n) gv[bj][n] = *(const f32x4*)(gp + bj * 128 + n * 16);
#pragma unroll
        for (int ai = 0; ai < 2; ++ai)
#pragma unroll
            for (int m = 0; m < 4; ++m) { const size_t off = (size_t)(row0 + ai * 128 + m * 16) * 1024 + col0;
#pragma unroll
                for (int bj = 0; bj < 2; ++bj)
#pragma unroll
                    for (int n = 0; n < 2; ++n) { const f32x4 xv = *(const f32x4*)(X + off + bj * 128 + n * 16);
                        *(f32x4*)(Z + off + bj * 128 + n * 16) = xv * ALPHA_ + gv[bj][n] * acc[ai][bj][m][n]; } }
    }
};
struct EpiSwiglu {
    static constexpr bool PERM = true;
    bf16_t* ACT; const float* bup;
    __device__ __forceinline__ void operator()(const f32x4 (&acc)[2][2][4][2], const pg8::Unit& u, int wr, int wc, int fr, int fq) const {
        const int row0 = u.pm * 256 + wr * 64 + fr, j0 = u.pn * 128 + wc * 32 + 8 * fq;
        const float* bp = bup + (size_t)u.e * 2048 + j0;
        f32x4 bg[2], bl[2];
#pragma unroll
        for (int n = 0; n < 2; ++n) { bg[n] = *(const f32x4*)(bp + 4 * n); bl[n] = *(const f32x4*)(bp + 1024 + 4 * n); }
#pragma unroll
        for (int ai = 0; ai < 2; ++ai)
#pragma unroll
            for (int m = 0; m < 4; ++m) { float o[8];
#pragma unroll
                for (int n = 0; n < 2; ++n)
#pragma unroll
                    for (int q = 0; q < 4; ++q) { const float xg = fminf(acc[ai][0][m][n][q] + bg[n][q], 7.f); const float xl = fminf(fmaxf(acc[ai][1][m][n][q] + bl[n][q], -7.f), 7.f);
                        o[4 * n + q] = xg * sigmoid_f(1.702f * xg) * (xl + 1.f); }
                u32x4 w; w.x = pg8::cvt_pk_bf16(o[0], o[1]); w.y = pg8::cvt_pk_bf16(o[2], o[3]); w.z = pg8::cvt_pk_bf16(o[4], o[5]); w.w = pg8::cvt_pk_bf16(o[6], o[7]);
                *(u32x4*)(ACT + (size_t)(row0 + ai * 128 + m * 16) * 1024 + j0) = w; }
    }
};
struct EpiDown {
    static constexpr bool PERM = true;
    bf16_t* Y4; const float* bdn; const int* rowtok;
    __device__ __forceinline__ void operator()(const f32x4 (&acc)[2][2][4][2], const pg8::Unit& u, int wr, int wc, int fr, int fq) const {
        const int row0 = u.pm * 256 + wr * 64 + fr, col0 = u.pn * 256 + wc * 32 + 8 * fq;
        const float* bp = bdn + (size_t)u.e * 1024 + col0;
        f32x4 bv[2][2];
#pragma unroll
        for (int bj = 0; bj < 2; ++bj)
#pragma unroll
            for (int n = 0; n < 2; ++n) bv[bj][n] = *(const f32x4*)(bp + bj * 128 + 4 * n);
#pragma unroll
        for (int ai = 0; ai < 2; ++ai)
#pragma unroll
            for (int m = 0; m < 4; ++m) { const int a = rowtok[row0 + ai * 128 + m * 16];
                if (a >= 0) { bf16_t* rowp = Y4 + (size_t)a * 1024 + col0;
#pragma unroll
                    for (int bj = 0; bj < 2; ++bj) { const f32x4 v0 = acc[ai][bj][m][0] + bv[bj][0], v1 = acc[ai][bj][m][1] + bv[bj][1];
                        u32x4 w; w.x = pg8::cvt_pk_bf16(v0[0], v0[1]); w.y = pg8::cvt_pk_bf16(v0[2], v0[3]); w.z = pg8::cvt_pk_bf16(v1[0], v1[1]); w.w = pg8::cvt_pk_bf16(v1[2], v1[3]);
                        *(u32x4*)(rowp + bj * 128) = w; } } }
    }
};

__device__ __forceinline__ int t5_bucket(int n) { if (n < 16) return n; const int v = 16 + (int)(logf((float)n * (1.f / 16.f)) / logf(8.f) * 16.f); return v < 31 ? v : 31; }

__device__ __forceinline__ void pool_tile(const Ctx& c, int l, int tile) {
    const Params& P = *c.P; const bf16_t* proj = (const bf16_t*)(P.ws + WS_PROJ); bf16_t* mix = (bf16_t*)(P.ws + WS_MIX);
    float* us = (float*)c.lds;
    float* ps = us + 47 * 256;
    const int t0 = tile * 32, s0 = t0 % SEQ_;
    for (int i = c.tid; i < 47 * 256; i += NTHREADS) { const int r = i >> 8, ch = i & 255, s = s0 - 15 + r;
        us[i] = (s >= 0) ? bf2f(proj[(size_t)(t0 - 15 + r) * NPROJ + C_POOL + ch]) : 0.f; }
    __syncthreads();
    for (int i = c.tid; i < 32 * 256; i += NTHREADS) { const int r = i >> 8, ch = i & 255, gi = ch >> 6, w = 2 << gi, s = s0 + r;
        float sum = 0.f;
        for (int j = 0; j < w; ++j) sum += us[(15 + r - j) * 256 + ch];
        const float cnt = (float)((s + 1) < w ? (s + 1) : w);
        ps[i] = sum / cnt - us[(15 + r) * 256 + ch]; }
    __syncthreads();
    const float* pw = P.in[I_POOLW] + (size_t)l * 4 * 64 * 64; const float* psc = P.in[I_POOLS] + l * 256;
    for (int i = c.tid; i < 32 * 256; i += NTHREADS) { const int r = i >> 8, dd = i & 255, gi = dd >> 6, d = dd & 63;
        const float* pr = ps + r * 256 + gi * 64; const float* wp = pw + (size_t)gi * 4096 + d; float acc = 0.f;
#pragma unroll 8
        for (int k = 0; k < 64; ++k) acc += pr[k] * wp[k * 64];
        mix[(size_t)(t0 + r) * 1024 + dd] = (bf16_t)f2bf(acc * psc[dd]); }
    __syncthreads();
}
__device__ __forceinline__ void swa_item(const Ctx& c, int l, int item, float* wl) {
    const Params& P = *c.P; const bf16_t* proj = (const bf16_t*)(P.ws + WS_PROJ); bf16_t* mix = (bf16_t*)(P.ws + WS_MIX);
    float* qs = wl; float* pr = wl + 64;
    const int t = item / 6, hq = item % 6, kvh = hq / 3, s = t % SEQ_, lane = c.lane;
    qs[lane] = bf2f(proj[(size_t)t * NPROJ + C_AQ + hq * 64 + lane]);
    asm volatile("s_waitcnt lgkmcnt(0)" ::: "memory");
    const float sink = P.in[I_SINKS][l * 6 + hq];
    float sc[2];
#pragma unroll
    for (int h2 = 0; h2 < 2; ++h2) { const int kk = lane + 64 * h2, dist = 127 - kk, sk = s - dist;
        float dot = -1e30f;
        if (sk >= 0) { const bf16_t* kr = proj + (size_t)(t - dist) * NPROJ + C_AK + kvh * 64; float a = 0.f;
#pragma unroll
            for (int d8 = 0; d8 < 8; ++d8) { const u32x4 kv = *(const u32x4*)(kr + d8 * 8);
                a += qs[d8 * 8 + 0] * bflo(kv.x) + qs[d8 * 8 + 1] * bfhi(kv.x) + qs[d8 * 8 + 2] * bflo(kv.y) + qs[d8 * 8 + 3] * bfhi(kv.y)
                   + qs[d8 * 8 + 4] * bflo(kv.z) + qs[d8 * 8 + 5] * bfhi(kv.z) + qs[d8 * 8 + 6] * bflo(kv.w) + qs[d8 * 8 + 7] * bfhi(kv.w); }
            dot = a * 0.125f + P.in[I_RELB][t5_bucket(dist) * 6 + hq]; }
        sc[h2] = dot; }
    const float m = fmaxf(wave_max(fmaxf(sc[0], sc[1])), sink);
    const float p0 = (sc[0] > -1e29f) ? __expf(sc[0] - m) : 0.f, p1 = (sc[1] > -1e29f) ? __expf(sc[1] - m) : 0.f;
    const float den = wave_sum(p0 + p1) + __expf(sink - m);
    pr[lane] = p0; pr[lane + 64] = p1;
    asm volatile("s_waitcnt lgkmcnt(0)" ::: "memory");
    float o = 0.f;
    const int kk0 = (s >= 127) ? 0 : (127 - s);
    for (int kk = kk0; kk < 128; ++kk) o += pr[kk] * bf2f(proj[(size_t)(t - 127 + kk) * NPROJ + C_AV + kvh * 64 + lane]);
    mix[(size_t)t * 1024 + 256 + hq * 64 + lane] = (bf16_t)f2bf(o / den);
    asm volatile("s_waitcnt lgkmcnt(0)" ::: "memory");
}
__device__ __forceinline__ void gdn_prep_tok(const Ctx& c, int l, int t) {
    const Params& P = *c.P; const bf16_t* proj = (const bf16_t*)(P.ws + WS_PROJ); const int lane = c.lane, s = t % SEQ_;
    float* QN = (float*)(P.ws + WS_QN); float* KN = (float*)(P.ws + WS_KN); float* VV = (float*)(P.ws + WS_VV); float* GB = (float*)(P.ws + WS_GB);
    const float* cw = P.in[I_CONVW] + (size_t)l * 4 * 1152;
#pragma unroll 1
    for (int grp = 0; grp < 18; ++grp) { const int ch = grp * 64 + lane; float a = 0.f;
#pragma unroll
        for (int j = 0; j < 4; ++j) { const int sj = s - 3 + j; if (sj >= 0) a += cw[j * 1152 + ch] * bf2f(proj[(size_t)(t - 3 + j) * NPROJ + C_GQ + ch]); }
        a = silu_f(a);
        if (grp < 12) { const float ss = wave_sum(a * a); a = a * (1.f / sqrtf(ss + NORM_EPS_)); }
        if (grp < 6) QN[(size_t)t * 384 + ch] = a * 0.125f;
        else if (grp < 12) KN[(size_t)t * 384 + (ch - 384)] = a;
        else VV[(size_t)t * 384 + (ch - 768)] = a; }
    if (lane < 6) { const float braw = bf2f(proj[(size_t)t * NPROJ + C_GB + lane]), araw = bf2f(proj[(size_t)t * NPROJ + C_GA + lane]);
        const float xx = araw + P.in[I_DTB][l * 6 + lane]; const float sp = xx > 20.f ? xx : log1pf(__expf(xx));
        GB[(size_t)t * 12 + lane] = -__expf(P.in[I_ALOG][l * 6 + lane]) * sp; GB[(size_t)t * 12 + 6 + lane] = sigmoid_f(braw); }
}
__device__ __forceinline__ void ph_mixa(const Ctx& c, int l) {
    for (int tile = c.bid; tile < T_ / 32; tile += c.nblk) pool_tile(c, l, tile);
    float* wl = (float*)(c.lds + 131072) + c.wave * 256;
    for (int it = c.gw; it < T_ * 6; it += c.ngw) swa_item(c, l, it, wl);
    for (int t = c.gw; t < T_; t += c.ngw) gdn_prep_tok(c, l, t);
}
__device__ __forceinline__ void ph_gscan(const Ctx& c) {
    const Params& P = *c.P;
    const float* QN = (const float*)(P.ws + WS_QN); const float* KN = (const float*)(P.ws + WS_KN); const float* VV = (const float*)(P.ws + WS_VV); const float* GB = (const float*)(P.ws + WS_GB);
    float* OR = (float*)(P.ws + WS_OR);
    float* ks = (float*)c.lds; float* qs = ks + 4096; float* vs = qs + 4096; float* gs = vs + 4096; float* bs = gs + 64;
    const int j = c.tid >> 3, p = c.tid & 7;
    for (int item = c.bid; item < NB_ * 6; item += c.nblk) {
        const int b = item / 6, h = item % 6;
        float S[8];
#pragma unroll
        for (int i = 0; i < 8; ++i) S[i] = 0.f;
        for (int ch = 0; ch < SEQ_ / 64; ++ch) {
            const int tb = b * SEQ_ + ch * 64;
            __syncthreads();
            for (int i = c.tid; i < 4096; i += NTHREADS) { const int r = i >> 6, d = i & 63; const size_t g = (size_t)(tb + r) * 384 + h * 64 + d; ks[i] = KN[g]; qs[i] = QN[g]; vs[i] = VV[g]; }
            if (c.tid < 64) { gs[c.tid] = __expf(GB[(size_t)(tb + c.tid) * 12 + h]); bs[c.tid] = GB[(size_t)(tb + c.tid) * 12 + 6 + h]; }
            __syncthreads();
            for (int r = 0; r < 64; ++r) {
                const float eg = gs[r], be = bs[r]; float kk[8], qq[8];
#pragma unroll
                for (int i = 0; i < 8; ++i) { kk[i] = ks[r * 64 + p * 8 + i]; qq[i] = qs[r * 64 + p * 8 + i]; }
                float kS = 0.f;
#pragma unroll
                for (int i = 0; i < 8; ++i) { S[i] *= eg; kS += kk[i] * S[i]; }
                kS += __shfl_xor(kS, 1); kS += __shfl_xor(kS, 2); kS += __shfl_xor(kS, 4);
                const float dl = be * (vs[r * 64 + j] - kS); float o = 0.f;
#pragma unroll
                for (int i = 0; i < 8; ++i) { S[i] += kk[i] * dl; o += qq[i] * S[i]; }
                o += __shfl_xor(o, 1); o += __shfl_xor(o, 2); o += __shfl_xor(o, 4);
                if (p == 0) OR[(size_t)(tb + r) * 384 + h * 64 + j] = o;
            }
        }
    }
}
__device__ __forceinline__ void ph_gout(const Ctx& c, int l) {
    const Params& P = *c.P; const bf16_t* proj = (const bf16_t*)(P.ws + WS_PROJ); bf16_t* mix = (bf16_t*)(P.ws + WS_MIX); const float* OR = (const float*)(P.ws + WS_OR);
    const float nw = P.in[I_NORMW][l * 64 + c.lane];
    for (int t = c.gw; t < T_; t += c.ngw) {
#pragma unroll
        for (int h = 0; h < 6; ++h) { const float o = OR[(size_t)t * 384 + h * 64 + c.lane]; const float ms = wave_sum(o * o) * (1.f / 64.f);
            const float z = bf2f(proj[(size_t)t * NPROJ + C_GZ + h * 64 + c.lane]);
            mix[(size_t)t * 1024 + 640 + h * 64 + c.lane] = (bf16_t)f2bf(o * (1.f / sqrtf(ms + NORM_EPS_)) * nw * silu_f(z)); }
    }
}

__device__ __forceinline__ void ph_ln1(const Ctx& c, int l) {
    const Params& P = *c.P; const float* mod = (const float*)(P.ws + WS_MOD) + (size_t)l * 8 * 6144;
    float* Z = (float*)(P.ws + WS_Z); bf16_t* H2 = (bf16_t*)(P.ws + WS_H2); int* TI = (int*)(P.ws + WS_TOPI); float* TG = (float*)(P.ws + WS_TOPG);
    float* wr = (float*)c.lds;
    const float* rw = P.in[I_RW] + (size_t)l * 1024 * 32;
    for (int i = c.tid; i < 32768; i += NTHREADS) { const int k = i >> 5, e = i & 31; wr[e * 1024 + k] = rw[i]; }
    __syncthreads();
    const float* g = P.in[I_LN1G] + l * 1024; const float* bb = P.in[I_LN1B] + l * 1024; const float* rb = P.in[I_RB] + l * 32;
    for (int t = c.gw; t < T_; t += c.ngw) {
        const int b = t / SEQ_; float* zr = Z + (size_t)t * 1024;
        f32x4 v[4], h[4];
#pragma unroll
        for (int j = 0; j < 4; ++j) v[j] = *(const f32x4*)(zr + 4 * c.lane + 256 * j);
        ln_rows(v, g, bb, c.lane);
#pragma unroll
        for (int j = 0; j < 4; ++j) *(f32x4*)(zr + 4 * c.lane + 256 * j) = v[j];
        modulate(h, v, mod + (size_t)b * 6144 + 3072, mod + (size_t)b * 6144 + 4096, c.lane);
        store_bf16_row(H2 + (size_t)t * 1024, c.lane, h);
        float mylg = -3.0e38f;
#pragma unroll 2
        for (int e = 0; e < 32; ++e) { float a = 0.f;
#pragma unroll
            for (int j = 0; j < 4; ++j) { const f32x4 w = *(const f32x4*)(wr + e * 1024 + 4 * c.lane + 256 * j); a += (h[j][0] * w[0] + h[j][1] * w[1]) + (h[j][2] * w[2] + h[j][3] * w[3]); }
            const float s = wave_sum(a) + rb[e]; if (c.lane == e) mylg = s; }
        int bi[4]; float bv[4];
#pragma unroll
        for (int k = 0; k < 4; ++k) { const float best = wave_max(mylg); const unsigned long long bal = __ballot(mylg == best); const int id = __ffsll((long long)bal) - 1;
            if (c.lane == id) mylg = -3.0e38f;
            bi[k] = id; bv[k] = best; }
        const float e1 = __expf(bv[1] - bv[0]), e2 = __expf(bv[2] - bv[0]), e3 = __expf(bv[3] - bv[0]), inv = 1.f / (1.f + e1 + e2 + e3);
        if (c.lane == 0) { *(int4*)(TI + (size_t)t * 4) = make_int4(bi[0], bi[1], bi[2], bi[3]); *(f32x4*)(TG + (size_t)t * 4) = (f32x4){inv, e1 * inv, e2 * inv, e3 * inv}; }
    }
    __syncthreads();
}

__device__ __forceinline__ void ph_routea(const Ctx& c) {
    const Params& P = *c.P; const int* TI = (const int*)(P.ws + WS_TOPI); int* R = (int*)(P.ws + WS_ROUTE);
    int* hist = (int*)c.lds;
    for (int seg = c.bid; seg < 256; seg += c.nblk) {
        if (c.tid < 32) hist[c.tid] = 0;
        __syncthreads();
        if (c.tid < 256) atomicAdd(&hist[TI[seg * 256 + c.tid]], 1);
        __syncthreads();
        if (c.tid < 32) R[R_COUNTS + seg * 32 + c.tid] = hist[c.tid];
        __syncthreads();
    }
}
__device__ __forceinline__ void ph_routeb(const Ctx& c) {
    const Params& P = *c.P; const int* TI = (const int*)(P.ws + WS_TOPI); int* R = (int*)(P.ws + WS_ROUTE);
    int* tot = (int*)c.lds; int* off = tot + 32; int* pst = off + 32; int* eid = pst + 64;
    for (int seg = c.bid; seg < 256; seg += c.nblk) {
        if (c.tid < 32) { int a = 0, o = 0; for (int s2 = 0; s2 < 256; ++s2) { const int v = R[R_COUNTS + s2 * 32 + c.tid]; a += v; if (s2 < seg) o += v; } tot[c.tid] = a; off[c.tid] = o; }
        if (c.tid < 256) eid[c.tid] = TI[seg * 256 + c.tid];
        __syncthreads();
        if (c.tid == 0) { int ps = 0; for (int e = 0; e < 32; ++e) { pst[e] = ps; ps += ((tot[e] + 255) >> 8) << 8; } pst[32] = ps; }
        __syncthreads();
        if (c.tid < 256) { const int e = eid[c.tid]; int rank = 0; for (int q = 0; q < c.tid; ++q) rank += (eid[q] == e) ? 1 : 0;
            R[R_ROWTOK + pst[e] + off[e] + rank] = seg * 256 + c.tid; }
        if (seg == 0) {
            for (int e = 0; e < 32; ++e) { const int lo = pst[e] + tot[e], hi = pst[e + 1]; for (int q = lo + c.tid; q < hi; q += NTHREADS) R[R_ROWTOK + q] = -1; }
            const int nrb = pst[32] >> 8;
            for (int rb = c.tid; rb < nrb; rb += NTHREADS) { int e = 0; for (int q = 1; q < 32; ++q) if ((rb << 8) >= pst[q]) e = q; R[R_BLKE + rb] = e; }
            if (c.tid == 0) R[R_NRB] = nrb;
        }
        __syncthreads();
    }
}
__device__ __forceinline__ void ph_gather(const Ctx& c) {
    const Params& P = *c.P; const int* R = (const int*)(P.ws + WS_ROUTE); const bf16_t* H2 = (const bf16_t*)(P.ws + WS_H2); bf16_t* XB = (bf16_t*)(P.ws + WS_XBUF);
    const int nrows = R[R_NRB] * 256;
    for (int r = c.gw; r < nrows; r += c.ngw) { const int a = R[R_ROWTOK + r];
        u32x4 v0 = (u32x4){0u, 0u, 0u, 0u}, v1 = v0;
        if (a >= 0) { const bf16_t* src = H2 + (size_t)(a >> 2) * 1024; v0 = *(const u32x4*)(src + 8 * c.lane); v1 = *(const u32x4*)(src + 512 + 8 * c.lane); }
        *(u32x4*)(XB + (size_t)r * 1024 + 8 * c.lane) = v0; *(u32x4*)(XB + (size_t)r * 1024 + 512 + 8 * c.lane) = v1; }
}

__device__ __forceinline__ void ph_combine(const Ctx& c, int l) {
    const Params& P = *c.P; const float* mod = (const float*)(P.ws + WS_MOD) + (size_t)l * 8 * 6144;
    const float* X1 = (const float*)(P.ws + WS_Z); const bf16_t* Y4 = (const bf16_t*)(P.ws + WS_Y4); const float* TG = (const float*)(P.ws + WS_TOPG);
    float* XO = (l == DEPTH_ - 1) ? P.out : (float*)(P.ws + WS_X); bf16_t* H = (bf16_t*)(P.ws + WS_H);
    const float* g = P.in[I_LN2G] + l * 1024; const float* bb = P.in[I_LN2B] + l * 1024;
    for (int t = c.gw; t < T_; t += c.ngw) {
        const int b = t / SEQ_; const f32x4 gt = *(const f32x4*)(TG + (size_t)t * 4);
        f32x4 v[4];
#pragma unroll
        for (int j = 0; j < 4; ++j) { const int col = 4 * c.lane + 256 * j; f32x4 y = (f32x4){0.f, 0.f, 0.f, 0.f};
#pragma unroll
            for (int k = 0; k < 4; ++k) { const u32x2 w = *(const u32x2*)(Y4 + (size_t)(t * 4 + k) * 1024 + col); y += gt[k] * (f32x4){bflo(w.x), bfhi(w.x), bflo(w.y), bfhi(w.y)}; }
            const f32x4 x1 = *(const f32x4*)(X1 + (size_t)t * 1024 + col), g2 = *(const f32x4*)(mod + (size_t)b * 6144 + 5120 + col);
            v[j] = x1 * ALPHA_ + g2 * y; }
        ln_rows(v, g, bb, c.lane);
#pragma unroll
        for (int j = 0; j < 4; ++j) *(f32x4*)(XO + (size_t)t * 1024 + 4 * c.lane + 256 * j) = v[j];
        if (l + 1 < DEPTH_) { const float* m2 = (const float*)(P.ws + WS_MOD) + (size_t)(l + 1) * 8 * 6144 + (size_t)b * 6144; f32x4 h[4];
            modulate(h, v, m2, m2 + 1024, c.lane); store_bf16_row(H + (size_t)t * 1024, c.lane, h); }
    }
}

template <int KIND>
__device__ __forceinline__ void run_kind(const Ctx& c, int l) {
    const Params& P = *c.P; LAS unsigned char* lds3 = (LAS unsigned char*)c.lds;
    const int* R = (const int*)(P.ws + WS_ROUTE);
    if constexpr (KIND == 0) ph_conv(c);
    else if constexpr (KIND == 1) ph_mod(c);
    else if constexpr (KIND == 2) ph_prep0(c);
    else if constexpr (KIND == 3 + L_GEMM1) { DenseSched S{(const char*)(P.ws + WS_H), (const char*)(P.ws + WS_WIN) + (size_t)l * NPROJ * 2048, T_ / 256, NPROJ / 256, c.nblk, c.bid};
        EpiStoreBf16 E{(bf16_t*)(P.ws + WS_PROJ), NPROJ};
        pg8::gemm_phase<EpiStoreBf16, DenseSched, true, true>(lds3, S, E); }
    else if constexpr (KIND == 3 + L_MIXA) ph_mixa(c, l);
    else if constexpr (KIND == 3 + L_GSCAN) ph_gscan(c);
    else if constexpr (KIND == 3 + L_GOUT) ph_gout(c, l);
    else if constexpr (KIND == 3 + L_GEMM2) { DenseSched S{(const char*)(P.ws + WS_MIX), (const char*)(P.ws + WS_WOUT) + (size_t)l * 1024 * 2048, T_ / 256, 4, c.nblk, c.bid};
        EpiResid E{l == 0 ? P.in[I_X] : (const float*)(P.ws + WS_X), (const float*)(P.ws + WS_MOD) + (size_t)l * 8 * 6144 + 2048, (float*)(P.ws + WS_Z)};
        pg8::gemm_phase<EpiResid, DenseSched, true, true>(lds3, S, E); }
    else if constexpr (KIND == 3 + L_LN1) ph_ln1(c, l);
    else if constexpr (KIND == 3 + L_ROUTEA) ph_routea(c);
    else if constexpr (KIND == 3 + L_ROUTEB) ph_routeb(c);
    else if constexpr (KIND == 3 + L_GATHER) ph_gather(c);
    else if constexpr (KIND == 3 + L_UP) { MoeSched S{(const char*)(P.ws + WS_XBUF), (const char*)(P.ws + WS_WUP) + (size_t)l * 32 * 2048 * 2048, R + R_BLKE, R[R_NRB], 8, c.nblk, c.bid, (size_t)2048 * 2048};
        EpiSwiglu E{(bf16_t*)(P.ws + WS_ACT), P.in[I_BUP] + (size_t)l * 32 * 2048};
        pg8::gemm_phase<EpiSwiglu, MoeSched, true, true>(lds3, S, E); }
    else if constexpr (KIND == 3 + L_DOWN) { MoeSched S{(const char*)(P.ws + WS_ACT), (const char*)(P.ws + WS_WDN) + (size_t)l * 32 * 1024 * 2048, R + R_BLKE, R[R_NRB], 4, c.nblk, c.bid, (size_t)1024 * 2048};
        EpiDown E{(bf16_t*)(P.ws + WS_Y4), P.in[I_BDN] + (size_t)l * 32 * 1024, R + R_ROWTOK};
        pg8::gemm_phase<EpiDown, MoeSched, true, true>(lds3, S, E); }
    else if constexpr (KIND == 3 + L_COMBINE) ph_combine(c, l);
}

template <int KIND>
__global__ void __launch_bounds__(NTHREADS, 2) mk_phase(Params P, int l) {
    extern __shared__ __attribute__((aligned(16))) unsigned char lds[];
    Ctx c; c.P = &P; c.lds = lds; c.tid = threadIdx.x; c.lane = c.tid & 63; c.wave = __builtin_amdgcn_readfirstlane(c.tid >> 6);
    c.bid = blockIdx.x; c.nblk = gridDim.x; c.gw = c.bid * NWAVES + c.wave; c.ngw = c.nblk * NWAVES;
    run_kind<KIND>(c, l);
}

template <int KIND> static void launch_kind(const Params& p, int l, int grid, hipStream_t stream) {
    static bool attr = false;
    if (!attr) { (void)hipFuncSetAttribute((const void*)mk_phase<KIND>, hipFuncAttributeMaxDynamicSharedMemorySize, LDS_BYTES); attr = true; }
    hipLaunchKernelGGL(mk_phase<KIND>, dim3(grid), dim3(NTHREADS), LDS_BYTES, stream, p, l);
}

extern "C" void kernel_launch(void* const* d_in, const int* in_sizes, int n_in, void* d_out, int out_size, void* d_ws, size_t ws_size, hipStream_t stream) {
    static int grid = 0;
    if (grid == 0) {
        if (n_in != N_IN || out_size != T_ * D_ || ws_size < WS_END) { fprintf(stderr, "kernel_launch: unexpected shapes (n_in %d out %d ws %zu need %zu)\n", n_in, out_size, ws_size, (size_t)WS_END); grid = -1; return; }
        int dev = 0, cus = 0;
        (void)hipGetDevice(&dev); (void)hipDeviceGetAttribute(&cus, hipDeviceAttributeMultiprocessorCount, dev);
        grid = cus > 0 ? cus : 256;
    }
    if (grid < 0) return;
    (void)hipMemsetAsync((char*)d_ws + WS_CTL, 0, 1 * MiB, stream);
    Params p{};
    for (int i = 0; i < N_IN; ++i) p.in[i] = (const float*)d_in[i];
    p.out = (float*)d_out; p.ws = (unsigned char*)d_ws;
    launch_kind<0>(p, 0, grid, stream); launch_kind<1>(p, 0, grid, stream); launch_kind<2>(p, 0, grid, stream);
    for (int l = 0; l < DEPTH_; ++l) {
        launch_kind<3 + L_GEMM1>(p, l, grid, stream); launch_kind<3 + L_MIXA>(p, l, grid, stream); launch_kind<3 + L_GSCAN>(p, l, grid, stream); launch_kind<3 + L_GOUT>(p, l, grid, stream);
        launch_kind<3 + L_GEMM2>(p, l, grid, stream); launch_kind<3 + L_LN1>(p, l, grid, stream); launch_kind<3 + L_ROUTEA>(p, l, grid, stream); launch_kind<3 + L_ROUTEB>(p, l, grid, stream);
        launch_kind<3 + L_GATHER>(p, l, grid, stream); launch_kind<3 + L_UP>(p, l, grid, stream); launch_kind<3 + L_DOWN>(p, l, grid, stream); launch_kind<3 + L_COMBINE>(p, l, grid, stream);
    }
}
```

```cpp
#include <hip/hip_runtime.h>
#include <hip/hip_cooperative_groups.h>
#include <cstdio>
#include <cstdint>
namespace cg = cooperative_groups;

#define LAS __attribute__((address_space(3)))
typedef unsigned short bf16_t;
typedef short bf16x8 __attribute__((ext_vector_type(8)));
typedef float f32x4 __attribute__((ext_vector_type(4)));
typedef float f32x2 __attribute__((ext_vector_type(2)));
typedef unsigned u32x4 __attribute__((ext_vector_type(4)));
typedef unsigned u32x2 __attribute__((ext_vector_type(2)));

constexpr int T_ = 16384, D_ = 1024, NB_ = 8, SEQ_ = 2048, DEPTH_ = 2;
constexpr int IN_DIM = 2444, NPROJ = 2560;
constexpr int C_POOL = 0, C_AQ = 256, C_AK = 640, C_AV = 768, C_GQ = 896, C_GK = 1280, C_GV = 1664, C_GZ = 2048, C_GB = 2432, C_GA = 2438;
constexpr int NE_ = 32, TOPK_ = 4, NASSIGN = T_ * TOPK_, NRB_MAX = NASSIGN / 256 + NE_, PROWS = NRB_MAX * 256;
constexpr float ALPHA_ = 1.41421356237309515f;
constexpr float LN_EPS_ = 1e-5f, NORM_EPS_ = 1e-6f;
constexpr int NTHREADS = 512, NWAVES = 8;
constexpr int LDS_BYTES = 147456;

constexpr size_t MiB = 1u << 20;
constexpr size_t WS_CTL = 0;
constexpr size_t WS_MOD = 1 * MiB;
constexpr size_t WS_ROUTE = 2 * MiB;
constexpr size_t WS_WIN = 4 * MiB;
constexpr size_t WS_WOUT = 14 * MiB;
constexpr size_t WS_WUP = 18 * MiB;
constexpr size_t WS_WDN = WS_WUP + 256 * MiB;
constexpr size_t WS_H = WS_WDN + 128 * MiB;
constexpr size_t WS_H2 = WS_H + 32 * MiB;
constexpr size_t WS_PROJ = WS_H2 + 32 * MiB;
constexpr size_t WS_MIX = WS_PROJ + 80 * MiB;
constexpr size_t WS_Z = WS_MIX + 32 * MiB;
constexpr size_t WS_X = WS_Z + 64 * MiB;
constexpr size_t WS_QN = WS_X + 64 * MiB;
constexpr size_t WS_KN = WS_QN + 24 * MiB;
constexpr size_t WS_VV = WS_KN + 24 * MiB;
constexpr size_t WS_OR = WS_VV + 24 * MiB;
constexpr size_t WS_GB = WS_OR + 24 * MiB;
constexpr size_t WS_TOPI = WS_GB + 1 * MiB;
constexpr size_t WS_TOPG = WS_TOPI + 1 * MiB;
constexpr size_t WS_XBUF = WS_TOPG + 1 * MiB;
constexpr size_t WS_ACT = WS_XBUF + 144 * MiB;
constexpr size_t WS_Y4 = WS_ACT + 144 * MiB;
constexpr size_t WS_END = WS_Y4 + 128 * MiB;
constexpr int R_COUNTS = 0;
constexpr int R_BLKE = 8192;
constexpr int R_NRB = 8192 + 512;
constexpr int R_ROWTOK = 16384;

__device__ __forceinline__ unsigned f2bf(float f) { unsigned u = __builtin_bit_cast(unsigned, f); return (u + 0x7fffu + ((u >> 16) & 1u)) >> 16; }
__device__ __forceinline__ unsigned pk2(float lo, float hi) { return f2bf(lo) | (f2bf(hi) << 16); }
__device__ __forceinline__ float bf2f(unsigned short b) { return __builtin_bit_cast(float, (unsigned)b << 16); }
__device__ __forceinline__ float bflo(unsigned w) { return __builtin_bit_cast(float, w << 16); }
__device__ __forceinline__ float bfhi(unsigned w) { return __builtin_bit_cast(float, w & 0xffff0000u); }
__device__ __forceinline__ float wave_sum(float v) {
#pragma unroll
    for (int o = 1; o < 64; o <<= 1) v += __shfl_xor(v, o);
    return v;
}
__device__ __forceinline__ float wave_max(float v) {
#pragma unroll
    for (int o = 1; o < 64; o <<= 1) v = fmaxf(v, __shfl_xor(v, o));
    return v;
}
__device__ __forceinline__ float silu_f(float x) { return x / (1.f + __expf(-x)); }
__device__ __forceinline__ float sigmoid_f(float x) { return 1.f / (1.f + __expf(-x)); }

namespace pg8 {
constexpr int BM = 256, BK = 64, HALF = 128, HTB = HALF * BK * 2, STAGE_BYTES = 8 * HTB, NXCD = 8, WGM = 8, KD = 1024;
__host__ __device__ __forceinline__ int lds_byte(int r, int c) { const int st = (r >> 4) * 2 + (c >> 5), rr = r & 15, cc = c & 31, ob = rr * 64 + cc * 2; return st * 1024 + (ob ^ (((ob >> 9) & 1) << 5)); }
__host__ __device__ __forceinline__ void stage_rc(int b, int& R, int& C) { const int st = b / 1024, sb = b % 1024, swz = sb ^ (((sb >> 9) & 1) << 5); R = (st >> 1) * 16 + swz / 64; C = (st & 1) * 32 + (swz % 64) / 2; }
__host__ __device__ __forceinline__ int perm32(int rho) { const int n = rho >> 4, i = rho & 15; return 8 * (i >> 2) + 4 * n + (i & 3); }

struct Unit { int pm, pn, e; const char* a; const char* b; };

__device__ __forceinline__ void tile_of(int L, int nM, int nN, int& pm, int& pn) {
    const int nwg = nM * nN; int wgid = L;
    { const int q = nwg / NXCD, r = nwg % NXCD, xcd = wgid % NXCD, off = wgid / NXCD; wgid = (xcd < r ? xcd * (q + 1) : r * (q + 1) + (xcd - r) * q) + off; }
    const int nig = WGM * nN, gid = wgid / nig, fm = gid * WGM, gsz = (nM - fm) < WGM ? (nM - fm) : WGM;
    pm = fm + ((wgid % nig) % gsz); pn = (wgid % nig) / gsz;
}

__device__ __forceinline__ unsigned cvt_pk_bf16(float lo, float hi) { unsigned r; asm volatile("v_cvt_pk_bf16_f32 %0, %1, %2" : "=v"(r) : "v"(lo), "v"(hi)); return r; }

template <class Epi, class Sched, bool ALIGN_EPI, bool SP2>
__device__ __forceinline__ void gemm_phase(LAS unsigned char* lds, const Sched& S, const Epi& E, const int tid) {
    const int wid = __builtin_amdgcn_readfirstlane(tid >> 6), lane = tid & 63, wr = wid >> 2, wc = wid & 3, fr = lane & 15, fq = lane >> 4;
    constexpr int K = KD, nt = K / BK;
    unsigned voffA[2], voffB[2];
#pragma unroll
    for (int i = 0; i < 2; ++i) { int R, C; stage_rc(tid * 16 + i * 8192, R, C); const int Rb = Epi::PERM ? ((R & ~31) + perm32(R & 31)) : R;
        voffA[i] = (unsigned)(R * K + C) * 2u; voffB[i] = (unsigned)(Rb * K + C) * 2u; }
    const size_t kstep = (size_t)(BK * 2);
    const size_t hstep = (size_t)HALF * K * 2;
    const unsigned ldsw = (unsigned)wid * 1024u;
    const int aoff = lds_byte(wr * 64 + fr, fq * 8), boff = lds_byte(wc * 32 + fr, fq * 8);
#define PG8_SA(b, h) (((b) * 2 + (h)) * HTB)
#define PG8_SB(b, h) ((4 + (b) * 2 + (h)) * HTB)
#define PG8_STAGE(bufoff, gbase, voff) do { _Pragma("unroll") for (int _i = 0; _i < 2; ++_i) \
        __builtin_amdgcn_global_load_lds((const unsigned*)((const char*)(gbase) + (voff)[_i]), (LAS unsigned*)(lds + (bufoff) + ldsw + _i * 8192), 16, 0, 0); } while (0)
#define PG8_LDA(dst, b, h) do { _Pragma("unroll") for (int m = 0; m < 4; ++m) _Pragma("unroll") for (int k = 0; k < 2; ++k) dst[m][k] = *(const LAS bf16x8*)(lds + PG8_SA(b, h) + aoff + m * 2048 + k * 1024); } while (0)
#define PG8_LDB(dst, b, h) do { _Pragma("unroll") for (int n = 0; n < 2; ++n) _Pragma("unroll") for (int k = 0; k < 2; ++k) dst[n][k] = *(const LAS bf16x8*)(lds + PG8_SB(b, h) + boff + n * 2048 + k * 1024); } while (0)
#define PG8_MMA(ai, bj, At, Bt) do { __builtin_amdgcn_s_setprio(1); _Pragma("unroll") for (int m = 0; m < 4; ++m) _Pragma("unroll") for (int n = 0; n < 2; ++n) _Pragma("unroll") for (int k = 0; k < 2; ++k) \
        acc[ai][bj][m][n] = __builtin_amdgcn_mfma_f32_16x16x32_bf16(Bt[n][k], At[m][k], acc[ai][bj][m][n], 0, 0, 0); __builtin_amdgcn_s_setprio(0); } while (0)
#define PG8_WAIT_V(n) asm volatile("s_waitcnt vmcnt(" #n ")" ::: "memory")
#define PG8_WAIT_L(n) asm volatile("s_waitcnt lgkmcnt(" #n ")" ::: "memory")
#define PG8_BAR __builtin_amdgcn_s_barrier()
#define PG8_SCHED __builtin_amdgcn_sched_barrier(0)
    Unit cur, nxt; int ui = 0;
    if (!S.next(0, cur)) return;
    f32x4 acc[2][2][4][2];
#pragma unroll
    for (int a = 0; a < 2; ++a)
#pragma unroll
        for (int b = 0; b < 2; ++b)
#pragma unroll
            for (int m = 0; m < 4; ++m)
#pragma unroll
                for (int n = 0; n < 2; ++n) acc[a][b][m][n] = (f32x4){0.f, 0.f, 0.f, 0.f};
    bf16x8 At[4][2], B0[2][2], B1[2][2];
    const char* cA = cur.a; const char* cB = cur.b;
    if constexpr (SP2) {
        PG8_STAGE(PG8_SB(0, 0), cB, voffB); PG8_STAGE(PG8_SB(0, 1), cB + hstep, voffB); PG8_STAGE(PG8_SA(0, 0), cA, voffA); PG8_STAGE(PG8_SA(0, 1), cA + hstep, voffA);
        if (wr == 1) PG8_BAR;
        PG8_WAIT_V(2); PG8_BAR;
        PG8_STAGE(PG8_SB(1, 0), cB + kstep, voffB); PG8_STAGE(PG8_SA(1, 0), cA + kstep, voffA); PG8_STAGE(PG8_SB(1, 1), cB + hstep + kstep, voffB);
        PG8_WAIT_V(6); PG8_BAR;
    } else {
        PG8_STAGE(PG8_SB(0, 0), cB, voffB); PG8_STAGE(PG8_SA(0, 0), cA, voffA); PG8_STAGE(PG8_SB(0, 1), cB + hstep, voffB); PG8_STAGE(PG8_SA(0, 1), cA + hstep, voffA);
        if (wr == 1) PG8_BAR;
        PG8_WAIT_V(4); PG8_BAR;
        PG8_STAGE(PG8_SB(1, 0), cB + kstep, voffB); PG8_STAGE(PG8_SA(1, 0), cA + kstep, voffA); PG8_STAGE(PG8_SB(1, 1), cB + hstep + kstep, voffB);
        PG8_WAIT_V(6); PG8_BAR;
    }
    for (;;) {
        const bool has_next = S.next(ui + 1, nxt);
        const char* nA = has_next ? nxt.a : cA; const char* nB = has_next ? nxt.b : cB;
        for (int t = 0; t < nt; t += 2) {
            const bool last = (t == nt - 2);
            const char* a1 = cA + (size_t)(t + 1) * kstep;
            const char* a2 = last ? nA : cA + (size_t)(t + 2) * kstep; const char* b2 = last ? nB : cB + (size_t)(t + 2) * kstep;
            const char* a3 = a2 + kstep; const char* b3 = b2 + kstep;
            if constexpr (SP2) {
            PG8_LDB(B0, 0, 0); PG8_LDB(B1, 0, 1); PG8_SCHED; PG8_LDA(At, 0, 0); PG8_STAGE(PG8_SA(1, 1), a1 + hstep, voffA);
            PG8_WAIT_V(8); PG8_WAIT_L(0); PG8_BAR; PG8_MMA(0, 0, At, B0); PG8_MMA(0, 1, At, B1); PG8_BAR; PG8_SCHED;
            PG8_LDA(At, 0, 1); PG8_STAGE(PG8_SB(0, 0), b2, voffB); PG8_STAGE(PG8_SB(0, 1), b2 + hstep, voffB); PG8_STAGE(PG8_SA(0, 0), a2, voffA);
            PG8_WAIT_V(8); PG8_WAIT_L(0); PG8_BAR; PG8_MMA(1, 0, At, B0); PG8_MMA(1, 1, At, B1); PG8_BAR; PG8_SCHED;
            PG8_LDB(B0, 1, 0); PG8_LDB(B1, 1, 1); PG8_SCHED; PG8_LDA(At, 1, 0); PG8_STAGE(PG8_SA(0, 1), a2 + hstep, voffA);
            PG8_WAIT_V(8); PG8_WAIT_L(0); PG8_BAR; PG8_MMA(0, 0, At, B0); PG8_MMA(0, 1, At, B1); PG8_BAR; PG8_SCHED;
            PG8_LDA(At, 1, 1); PG8_STAGE(PG8_SB(1, 0), b3, voffB); PG8_STAGE(PG8_SB(1, 1), b3 + hstep, voffB); PG8_STAGE(PG8_SA(1, 0), a3, voffA);
            PG8_WAIT_V(8); PG8_WAIT_L(0); PG8_BAR; PG8_MMA(1, 0, At, B0); PG8_MMA(1, 1, At, B1); PG8_BAR; PG8_SCHED;
            } else {
            PG8_LDB(B0, 0, 0); PG8_SCHED; PG8_LDA(At, 0, 0); PG8_STAGE(PG8_SA(1, 1), a1 + hstep, voffA);
            PG8_WAIT_L(8); PG8_BAR; PG8_WAIT_L(0); PG8_MMA(0, 0, At, B0); PG8_BAR; PG8_SCHED;
            PG8_LDB(B1, 0, 1); PG8_STAGE(PG8_SB(0, 0), b2, voffB);
            PG8_BAR; PG8_WAIT_L(0); PG8_MMA(0, 1, At, B1); PG8_BAR;
            PG8_LDA(At, 0, 1); PG8_STAGE(PG8_SA(0, 0), a2, voffA);
            PG8_BAR; PG8_WAIT_L(0); PG8_MMA(1, 0, At, B0); PG8_BAR; PG8_SCHED;
            PG8_STAGE(PG8_SB(0, 1), b2 + hstep, voffB);
            PG8_WAIT_V(6); PG8_BAR; PG8_MMA(1, 1, At, B1); PG8_BAR;
            PG8_LDB(B0, 1, 0); PG8_SCHED; PG8_LDA(At, 1, 0); PG8_STAGE(PG8_SA(0, 1), a2 + hstep, voffA);
            PG8_WAIT_L(8); PG8_BAR; PG8_WAIT_L(0); PG8_MMA(0, 0, At, B0); PG8_BAR; PG8_SCHED;
            PG8_LDB(B1, 1, 1); PG8_STAGE(PG8_SB(1, 0), b3, voffB);
            PG8_BAR; PG8_WAIT_L(0); PG8_MMA(0, 1, At, B1); PG8_BAR;
            PG8_LDA(At, 1, 1); PG8_STAGE(PG8_SA(1, 0), a3, voffA);
            PG8_BAR; PG8_WAIT_L(0); PG8_MMA(1, 0, At, B0); PG8_BAR; PG8_SCHED;
            PG8_STAGE(PG8_SB(1, 1), b3 + hstep, voffB);
            PG8_WAIT_V(6); PG8_BAR; PG8_MMA(1, 1, At, B1); PG8_BAR;
            }
        }
        if constexpr (ALIGN_EPI) { if (wr == 0) PG8_BAR; }
        E(acc, cur, wr, wc, fr, fq);
        if (!has_next) break;
#pragma unroll
        for (int a = 0; a < 2; ++a)
#pragma unroll
            for (int b = 0; b < 2; ++b)
#pragma unroll
                for (int m = 0; m < 4; ++m)
#pragma unroll
                    for (int n = 0; n < 2; ++n) acc[a][b][m][n] = (f32x4){0.f, 0.f, 0.f, 0.f};
        cur = nxt; cA = nA; cB = nB; ++ui;
        if constexpr (ALIGN_EPI) { if (wr == 1) PG8_BAR; }
    }
    PG8_WAIT_V(0);
    if constexpr (!ALIGN_EPI) { if (wr == 0) PG8_BAR; }
    PG8_BAR;
#undef PG8_SA
#undef PG8_SB
#undef PG8_STAGE
#undef PG8_LDA
#undef PG8_LDB
#undef PG8_MMA
#undef PG8_WAIT_V
#undef PG8_WAIT_L
#undef PG8_BAR
#undef PG8_SCHED
}
}

enum { I_X = 0, I_C, I_RELB, I_WIN, I_WOUT, I_WADA, I_BADA, I_LN1G, I_LN1B, I_LN2G, I_LN2B, I_POOLW, I_POOLS, I_SINKS, I_CONVW, I_ALOG, I_DTB, I_NORMW,
       I_RW, I_RB, I_WUP, I_BUP, I_WDN, I_BDN, N_IN };
struct Params { const float* in[N_IN]; float* out; unsigned char* ws; };

struct Ctx {
    const Params* P; unsigned char* lds; int tid, lane, wave, gw, ngw, bid, nblk;
};

enum { PH_CONV = 0, PH_MOD, PH_PREP0, PH_L0 };
enum { L_GEMM1 = 0, L_MIXA, L_GSCAN, L_GOUT, L_GEMM2, L_LN1, L_ROUTEA, L_ROUTEB, L_GATHER, L_UP, L_DOWN, L_COMBINE, L_NPH };
constexpr int N_PHASES = PH_L0 + DEPTH_ * L_NPH;

__device__ __forceinline__ void transpose_item(const float* W, int N, bf16_t* WT, int k0, int n0, int drow0, float* scr, int lane) {
    const int n = n0 + (lane & 31); const bool ok = n < N;
#pragma unroll 8
    for (int i = 0; i < 32; ++i) { const int kk = 2 * i + (lane >> 5); scr[kk * 33 + (lane & 31)] = ok ? W[(size_t)(k0 + kk) * N + n] : 0.f; }
    asm volatile("s_waitcnt lgkmcnt(0)" ::: "memory");
    const int c = lane & 7;
#pragma unroll
    for (int j = 0; j < 4; ++j) { const int nn = (lane >> 3) + 8 * j; const float* s = scr + (8 * c) * 33 + nn;
        u32x4 o; o.x = pk2(s[0 * 33], s[1 * 33]); o.y = pk2(s[2 * 33], s[3 * 33]); o.z = pk2(s[4 * 33], s[5 * 33]); o.w = pk2(s[6 * 33], s[7 * 33]);
        *(u32x4*)(WT + (size_t)(drow0 + nn) * 1024 + k0 + 8 * c) = o; }
    asm volatile("s_waitcnt lgkmcnt(0)" ::: "memory");
}
__device__ __forceinline__ void ph_conv(const Ctx& c) {
    const Params& P = *c.P;
    float* scr = (float*)(c.lds + c.wave * 16384);
    constexpr int I_IN = 16 * 80, I_OUT = 16 * 32, I_UP = 32 * 16 * 64, I_DN = 32 * 16 * 32, I_LAYER = I_IN + I_OUT + I_UP + I_DN;
    for (int it = c.gw; it < DEPTH_ * I_LAYER; it += c.ngw) {
        const int l = it / I_LAYER; int r = it % I_LAYER;
        if (r < I_IN) { const int kb = r / 80, nb = r % 80;
            transpose_item(P.in[I_WIN] + (size_t)l * 1024 * IN_DIM, IN_DIM, (bf16_t*)(P.ws + WS_WIN) + (size_t)l * NPROJ * 1024, 64 * kb, 32 * nb, 32 * nb, scr, c.lane); continue; }
        r -= I_IN;
        if (r < I_OUT) { const int kb = r / 32, nb = r % 32;
            transpose_item(P.in[I_WOUT] + (size_t)l * 1024 * 1024, 1024, (bf16_t*)(P.ws + WS_WOUT) + (size_t)l * 1024 * 1024, 64 * kb, 32 * nb, 32 * nb, scr, c.lane); continue; }
        r -= I_OUT;
        if (r < I_UP) { const int e = r / 1024, rr = r % 1024, kb = rr / 64, nb = rr % 64, n0 = 32 * nb, bj = n0 / 1024, rem = n0 % 1024, pn = rem / 128, c0 = rem % 128;
            transpose_item(P.in[I_WUP] + (size_t)(l * 32 + e) * 1024 * 2048, 2048, (bf16_t*)(P.ws + WS_WUP) + (size_t)(l * 32 + e) * 2048 * 1024, 64 * kb, n0, pn * 256 + bj * 128 + c0, scr, c.lane); continue; }
        r -= I_UP;
        { const int e = r / 512, rr = r % 512, kb = rr / 32, nb = rr % 32;
            transpose_item(P.in[I_WDN] + (size_t)(l * 32 + e) * 1024 * 1024, 1024, (bf16_t*)(P.ws + WS_WDN) + (size_t)(l * 32 + e) * 1024 * 1024, 64 * kb, 32 * nb, 32 * nb, scr, c.lane); }
    }
}

__device__ __forceinline__ void ph_mod(const Ctx& c) {
    const Params& P = *c.P;
    float* cs = (float*)c.lds;
    float* part = cs + 8192;
    for (int i = c.tid; i < 8192; i += NTHREADS) cs[i] = silu_f(P.in[I_C][i]);
    __syncthreads();
    float* mod = (float*)(P.ws + WS_MOD);
    for (int item = c.bid; item < DEPTH_ * 96; item += c.nblk) {
        const int l = item / 96, j = (item % 96) * 64 + c.lane;
        const float* w = P.in[I_WADA] + (size_t)l * 1024 * 6144 + j;
        float acc[8];
#pragma unroll
        for (int b = 0; b < 8; ++b) acc[b] = 0.f;
        const int k0 = c.wave * 128;
#pragma unroll 8
        for (int k = k0; k < k0 + 128; ++k) { const float wv = w[(size_t)k * 6144];
#pragma unroll
            for (int b = 0; b < 8; ++b) acc[b] += cs[b * 1024 + k] * wv; }
#pragma unroll
        for (int b = 0; b < 8; ++b) part[(c.wave * 8 + b) * 64 + c.lane] = acc[b];
        __syncthreads();
        { const int b = c.tid >> 6, col = c.tid & 63; float s = 0.f;
#pragma unroll
          for (int w8 = 0; w8 < 8; ++w8) s += part[(w8 * 8 + b) * 64 + col];
          const int jj = (item % 96) * 64 + col;
          mod[((size_t)l * 8 + b) * 6144 + jj] = s + P.in[I_BADA][l * 6144 + jj]; }
        __syncthreads();
    }
}

__device__ __forceinline__ void store_bf16_row(bf16_t* row, int lane, const f32x4 (&v)[4]) {
#pragma unroll
    for (int j = 0; j < 4; ++j) { u32x2 w; w.x = pk2(v[j][0], v[j][1]); w.y = pk2(v[j][2], v[j][3]); *(u32x2*)(row + 4 * lane + 256 * j) = w; }
}
__device__ __forceinline__ void modulate(f32x4 (&h)[4], const f32x4 (&x)[4], const float* sh, const float* sc, int lane) {
#pragma unroll
    for (int j = 0; j < 4; ++j) { const f32x4 a = *(const f32x4*)(sc + 4 * lane + 256 * j), b = *(const f32x4*)(sh + 4 * lane + 256 * j); h[j] = x[j] * (1.f + a) + b; }
}
__device__ __forceinline__ void ln_rows(f32x4 (&v)[4], const float* g, const float* b, int lane) {
    float s = 0.f;
#pragma unroll
    for (int j = 0; j < 4; ++j) s += (v[j][0] + v[j][1]) + (v[j][2] + v[j][3]);
    const float mean = wave_sum(s) * (1.f / 1024.f); float s2 = 0.f;
#pragma unroll
    for (int j = 0; j < 4; ++j) { v[j] = v[j] - mean; s2 += (v[j][0] * v[j][0] + v[j][1] * v[j][1]) + (v[j][2] * v[j][2] + v[j][3] * v[j][3]); }
    const float rstd = 1.f / sqrtf(wave_sum(s2) * (1.f / 1024.f) + LN_EPS_);
#pragma unroll
    for (int j = 0; j < 4; ++j) { const f32x4 gg = *(const f32x4*)(g + 4 * lane + 256 * j), bb = *(const f32x4*)(b + 4 * lane + 256 * j); v[j] = v[j] * rstd * gg + bb; }
}

__device__ __forceinline__ void ph_prep0(const Ctx& c) {
    const Params& P = *c.P; const float* mod = (const float*)(P.ws + WS_MOD);
    bf16_t* H = (bf16_t*)(P.ws + WS_H);
    for (int t = c.gw; t < T_; t += c.ngw) {
        const int b = t / SEQ_; const float* xr = P.in[I_X] + (size_t)t * 1024;
        f32x4 x[4], h[4];
#pragma unroll
        for (int j = 0; j < 4; ++j) x[j] = *(const f32x4*)(xr + 4 * c.lane + 256 * j);
        modulate(h, x, mod + (size_t)b * 6144, mod + (size_t)b * 6144 + 1024, c.lane);
        store_bf16_row(H + (size_t)t * 1024, c.lane, h);
    }
}

struct DenseSched {
    const char* A; const char* Bt; int nM, nN, G, c;
    __device__ __forceinline__ bool next(int i, pg8::Unit& u) const {
        const int L = i * G + c; if (L >= nM * nN) return false;
        pg8::tile_of(L, nM, nN, u.pm, u.pn); u.e = 0;
        u.a = A + (size_t)u.pm * 256 * 2048; u.b = Bt + (size_t)u.pn * 256 * 2048; return true; }
};
struct MoeSched {
    const char* A; const char* Bt; const int* blk_e; int nrb, nN, G, c; size_t estride;
    __device__ __forceinline__ bool next(int i, pg8::Unit& u) const {
        const int L = i * G + c; if (L >= nrb * nN) return false;
        pg8::tile_of(L, nrb, nN, u.pm, u.pn); u.e = blk_e[u.pm];
        u.a = A + (size_t)u.pm * 256 * 2048; u.b = Bt + (size_t)u.e * estride + (size_t)u.pn * 256 * 2048; return true; }
};
struct EpiStoreBf16 {
    static constexpr bool PERM = true;
    bf16_t* O; int ldc;
    __device__ __forceinline__ void operator()(const f32x4 (&acc)[2][2][4][2], const pg8::Unit& u, int wr, int wc, int fr, int fq) const {
        const int row0 = u.pm * 256 + wr * 64 + fr, col0 = u.pn * 256 + wc * 32 + 8 * fq;
#pragma unroll
        for (int ai = 0; ai < 2; ++ai)
#pragma unroll
            for (int m = 0; m < 4; ++m) { bf16_t* rowp = O + (size_t)(row0 + ai * 128 + m * 16) * ldc + col0;
#pragma unroll
                for (int bj = 0; bj < 2; ++bj) { const f32x4 v0 = acc[ai][bj][m][0], v1 = acc[ai][bj][m][1];
                    u32x4 w; w.x = pg8::cvt_pk_bf16(v0[0], v0[1]); w.y = pg8::cvt_pk_bf16(v0[2], v0[3]); w.z = pg8::cvt_pk_bf16(v1[0], v1[1]); w.w = pg8::cvt_pk_bf16(v1[2], v1[3]);
                    *(u32x4*)(rowp + bj * 128) = w; } }
    }
};
struct EpiResid {
    static constexpr bool PERM = false;
    const float* X; const float* gate; float* Z;
    __device__ __forceinline__ void operator()(const f32x4 (&acc)[2][2][4][2], const pg8::Unit& u, int wr, int wc, int fr, int fq) const {
        const int row0 = u.pm * 256 + wr * 64 + fr, col0 = u.pn * 256 + wc * 32 + 4 * fq;
        const float* gp = gate + (size_t)(u.pm >> 3) * 6144 + col0;
        f32x4 gv[2][2];
#pragma unroll
        for (int bj = 0; bj < 2; ++bj)
#pragma unroll
            for (int n = 0; n < 2; ++n) gv[bj][n] = *(const f32x4*)(gp + bj * 128 + n * 16);
#pragma unroll
        for (int ai = 0; ai < 2; ++ai)
#pragma unroll
            for (int m = 0; m < 4; ++m) { const size_t off = (size_t)(row0 + ai * 128 + m * 16) * 1024 + col0;
#pragma unroll
                for (int bj = 0; bj < 2; ++bj)
#pragma unroll
                    for (int n = 0; n < 2; ++n) { const f32x4 xv = *(const f32x4*)(X + off + bj * 128 + n * 16);
                        *(f32x4*)(Z + off + bj * 128 + n * 16) = xv * ALPHA_ + gv[bj][n] * acc[ai][bj][m][n]; } }
    }
};
struct EpiSwiglu {
    static constexpr bool PERM = true;
    bf16_t* ACT; const float* bup;
    __device__ __forceinline__ void operator()(const f32x4 (&acc)[2][2][4][2], const pg8::Unit& u, int wr, int wc, int fr, int fq) const {
        const int row0 = u.pm * 256 + wr * 64 + fr, j0 = u.pn * 128 + wc * 32 + 8 * fq;
        const float* bp = bup + (size_t)u.e * 2048 + j0;
        f32x4 bg[2], bl[2];
#pragma unroll
        for (int n = 0; n < 2; ++n) { bg[n] = *(const f32x4*)(bp + 4 * n); bl[n] = *(const f32x4*)(bp + 1024 + 4 * n); }
#pragma unroll
        for (int ai = 0; ai < 2; ++ai)
#pragma unroll
            for (int m = 0; m < 4; ++m) { float o[8];
#pragma unroll
                for (int n = 0; n < 2; ++n)
#pragma unroll
                    for (int q = 0; q < 4; ++q) { const float xg = fminf(acc[ai][0][m][n][q] + bg[n][q], 7.f); const float xl = fminf(fmaxf(acc[ai][1][m][n][q] + bl[n][q], -7.f), 7.f);
                        o[4 * n + q] = xg * sigmoid_f(1.702f * xg) * (xl + 1.f); }
                u32x4 w; w.x = pg8::cvt_pk_bf16(o[0], o[1]); w.y = pg8::cvt_pk_bf16(o[2], o[3]); w.z = pg8::cvt_pk_bf16(o[4], o[5]); w.w = pg8::cvt_pk_bf16(o[6], o[7]);
                *(u32x4*)(ACT + (size_t)(row0 + ai * 128 + m * 16) * 1024 + j0) = w; }
    }
};
struct EpiDown {
    static constexpr bool PERM = true;
    bf16_t* Y4; const float* bdn; const int* rowtok;
    __device__ __forceinline__ void operator()(const f32x4 (&acc)[2][2][4][2], const pg8::Unit& u, int wr, int wc, int fr, int fq) const {
        const int row0 = u.pm * 256 + wr * 64 + fr, col0 = u.pn * 256 + wc * 32 + 8 * fq;
        const float* bp = bdn + (size_t)u.e * 1024 + col0;
        f32x4 bv[2][2];
#pragma unroll
        for (int bj = 0; bj < 2; ++bj)
#pragma unroll
            for (int n = 0; n < 2; ++n) bv[bj][n] = *(const f32x4*)(bp + bj * 128 + 4 * n);
#pragma unroll
        for (int ai = 0; ai < 2; ++ai)
#pragma unroll
            for (int m = 0; m < 4; ++m) { const int a = rowtok[row0 + ai * 128 + m * 16];
                if (a >= 0) { bf16_t* rowp = Y4 + (size_t)a * 1024 + col0;
#pragma unroll
                    for (int bj = 0; bj < 2; ++bj) { const f32x4 v0 = acc[ai][bj][m][0] + bv[bj][0], v1 = acc[ai][bj][m][1] + bv[bj][1];
                        u32x4 w; w.x = pg8::cvt_pk_bf16(v0[0], v0[1]); w.y = pg8::cvt_pk_bf16(v0[2], v0[3]); w.z = pg8::cvt_pk_bf16(v1[0], v1[1]); w.w = pg8::cvt_pk_bf16(v1[2], v1[3]);
                        *(u32x4*)(rowp + bj * 128) = w; } } }
    }
};

__device__ __forceinline__ int t5_bucket(int n) { if (n < 16) return n; const int v = 16 + (int)(logf((float)n * (1.f / 16.f)) / logf(8.f) * 16.f); return v < 31 ? v : 31; }

__device__ __forceinline__ void pool_tile(const Ctx& c, int l, int tile) {
    const Params& P = *c.P; const bf16_t* proj = (const bf16_t*)(P.ws + WS_PROJ); bf16_t* mix = (bf16_t*)(P.ws + WS_MIX);
    float* us = (float*)c.lds;
    float* ps = us + 47 * 256;
    const int t0 = tile * 32, s0 = t0 % SEQ_;
    for (int i = c.tid; i < 47 * 256; i += NTHREADS) { const int r = i >> 8, ch = i & 255, s = s0 - 15 + r;
        us[i] = (s >= 0) ? bf2f(proj[(size_t)(t0 - 15 + r) * NPROJ + C_POOL + ch]) : 0.f; }
    __syncthreads();
    for (int i = c.tid; i < 32 * 256; i += NTHREADS) { const int r = i >> 8, ch = i & 255, gi = ch >> 6, w = 2 << gi, s = s0 + r;
        float sum = 0.f;
        for (int j = 0; j < w; ++j) sum += us[(15 + r - j) * 256 + ch];
        const float cnt = (float)((s + 1) < w ? (s + 1) : w);
        ps[i] = sum / cnt - us[(15 + r) * 256 + ch]; }
    __syncthreads();
    const float* pw = P.in[I_POOLW] + (size_t)l * 4 * 64 * 64; const float* psc = P.in[I_POOLS] + l * 256;
    for (int i = c.tid; i < 32 * 256; i += NTHREADS) { const int r = i >> 8, dd = i & 255, gi = dd >> 6, d = dd & 63;
        const float* pr = ps + r * 256 + gi * 64; const float* wp = pw + (size_t)gi * 4096 + d; float acc = 0.f;
#pragma unroll 8
        for (int k = 0; k < 64; ++k) acc += pr[k] * wp[k * 64];
        mix[(size_t)(t0 + r) * 1024 + dd] = (bf16_t)f2bf(acc * psc[dd]); }
    __syncthreads();
}
__device__ __forceinline__ void swa_item(const Ctx& c, int l, int item, float* wl) {
    const Params& P = *c.P; const bf16_t* proj = (const bf16_t*)(P.ws + WS_PROJ); bf16_t* mix = (bf16_t*)(P.ws + WS_MIX);
    float* qs = wl; float* pr = wl + 64;
    const int t = item / 6, hq = item % 6, kvh = hq / 3, s = t % SEQ_, lane = c.lane;
    qs[lane] = bf2f(proj[(size_t)t * NPROJ + C_AQ + hq * 64 + lane]);
    asm volatile("s_waitcnt lgkmcnt(0)" ::: "memory");
    const float sink = P.in[I_SINKS][l * 6 + hq];
    float sc[2];
#pragma unroll
    for (int h2 = 0; h2 < 2; ++h2) { const int kk = lane + 64 * h2, dist = 127 - kk, sk = s - dist;
        float dot = -1e30f;
        if (sk >= 0) { const bf16_t* kr = proj + (size_t)(t - dist) * NPROJ + C_AK + kvh * 64; float a = 0.f;
#pragma unroll
            for (int d8 = 0; d8 < 8; ++d8) { const u32x4 kv = *(const u32x4*)(kr + d8 * 8);
                a += qs[d8 * 8 + 0] * bflo(kv.x) + qs[d8 * 8 + 1] * bfhi(kv.x) + qs[d8 * 8 + 2] * bflo(kv.y) + qs[d8 * 8 + 3] * bfhi(kv.y)
                   + qs[d8 * 8 + 4] * bflo(kv.z) + qs[d8 * 8 + 5] * bfhi(kv.z) + qs[d8 * 8 + 6] * bflo(kv.w) + qs[d8 * 8 + 7] * bfhi(kv.w); }
            dot = a * 0.125f + P.in[I_RELB][t5_bucket(dist) * 6 + hq]; }
        sc[h2] = dot; }
    const float m = fmaxf(wave_max(fmaxf(sc[0], sc[1])), sink);
    const float p0 = (sc[0] > -1e29f) ? __expf(sc[0] - m) : 0.f, p1 = (sc[1] > -1e29f) ? __expf(sc[1] - m) : 0.f;
    const float den = wave_sum(p0 + p1) + __expf(sink - m);
    pr[lane] = p0; pr[lane + 64] = p1;
    asm volatile("s_waitcnt lgkmcnt(0)" ::: "memory");
    float o = 0.f;
    const int kk0 = (s >= 127) ? 0 : (127 - s);
    for (int kk = kk0; kk < 128; ++kk) o += pr[kk] * bf2f(proj[(size_t)(t - 127 + kk) * NPROJ + C_AV + kvh * 64 + lane]);
    mix[(size_t)t * 1024 + 256 + hq * 64 + lane] = (bf16_t)f2bf(o / den);
    asm volatile("s_waitcnt lgkmcnt(0)" ::: "memory");
}
__device__ __forceinline__ void gdn_prep_tok(const Ctx& c, int l, int t) {
    const Params& P = *c.P; const bf16_t* proj = (const bf16_t*)(P.ws + WS_PROJ); const int lane = c.lane, s = t % SEQ_;
    float* QN = (float*)(P.ws + WS_QN); float* KN = (float*)(P.ws + WS_KN); float* VV = (float*)(P.ws + WS_VV); float* GB = (float*)(P.ws + WS_GB);
    const float* cw = P.in[I_CONVW] + (size_t)l * 4 * 1152;
#pragma unroll 1
    for (int grp = 0; grp < 18; ++grp) { const int ch = grp * 64 + lane; float a = 0.f;
#pragma unroll
        for (int j = 0; j < 4; ++j) { const int sj = s - 3 + j; if (sj >= 0) a += cw[j * 1152 + ch] * bf2f(proj[(size_t)(t - 3 + j) * NPROJ + C_GQ + ch]); }
        a = silu_f(a);
        if (grp < 12) { const float ss = wave_sum(a * a); a = a * (1.f / sqrtf(ss + NORM_EPS_)); }
        if (grp < 6) QN[(size_t)t * 384 + ch] = a * 0.125f;
        else if (grp < 12) KN[(size_t)t * 384 + (ch - 384)] = a;
        else VV[(size_t)t * 384 + (ch - 768)] = a; }
    if (lane < 6) { const float braw = bf2f(proj[(size_t)t * NPROJ + C_GB + lane]), araw = bf2f(proj[(size_t)t * NPROJ + C_GA + lane]);
        const float xx = araw + P.in[I_DTB][l * 6 + lane]; const float sp = xx > 20.f ? xx : log1pf(__expf(xx));
        GB[(size_t)t * 12 + lane] = -__expf(P.in[I_ALOG][l * 6 + lane]) * sp; GB[(size_t)t * 12 + 6 + lane] = sigmoid_f(braw); }
}
__device__ __forceinline__ void ph_mixa(const Ctx& c, int l) {
    for (int tile = c.bid; tile < T_ / 32; tile += c.nblk) pool_tile(c, l, tile);
    float* wl = (float*)(c.lds + 131072) + c.wave * 256;
    for (int it = c.gw; it < T_ * 6; it += c.ngw) swa_item(c, l, it, wl);
    for (int t = c.gw; t < T_; t += c.ngw) gdn_prep_tok(c, l, t);
}
__device__ __forceinline__ void ph_gscan(const Ctx& c) {
    const Params& P = *c.P;
    const float* QN = (const float*)(P.ws + WS_QN); const float* KN = (const float*)(P.ws + WS_KN); const float* VV = (const float*)(P.ws + WS_VV); const float* GB = (const float*)(P.ws + WS_GB);
    float* OR = (float*)(P.ws + WS_OR);
    float* ks = (float*)c.lds; float* qs = ks + 4096; float* vs = qs + 4096; float* gs = vs + 4096; float* bs = gs + 64;
    const int j = c.tid >> 3, p = c.tid & 7;
    for (int item = c.bid; item < NB_ * 6; item += c.nblk) {
        const int b = item / 6, h = item % 6;
        float S[8];
#pragma unroll
        for (int i = 0; i < 8; ++i) S[i] = 0.f;
        for (int ch = 0; ch < SEQ_ / 64; ++ch) {
            const int tb = b * SEQ_ + ch * 64;
            __syncthreads();
            for (int i = c.tid; i < 4096; i += NTHREADS) { const int r = i >> 6, d = i & 63; const size_t g = (size_t)(tb + r) * 384 + h * 64 + d; ks[i] = KN[g]; qs[i] = QN[g]; vs[i] = VV[g]; }
            if (c.tid < 64) { gs[c.tid] = __expf(GB[(size_t)(tb + c.tid) * 12 + h]); bs[c.tid] = GB[(size_t)(tb + c.tid) * 12 + 6 + h]; }
            __syncthreads();
            for (int r = 0; r < 64; ++r) {
                const float eg = gs[r], be = bs[r]; float kk[8], qq[8];
#pragma unroll
                for (int i = 0; i < 8; ++i) { kk[i] = ks[r * 64 + p * 8 + i]; qq[i] = qs[r * 64 + p * 8 + i]; }
                float kS = 0.f;
#pragma unroll
                for (int i = 0; i < 8; ++i) { S[i] *= eg; kS += kk[i] * S[i]; }
                kS += __shfl_xor(kS, 1); kS += __shfl_xor(kS, 2); kS += __shfl_xor(kS, 4);
                const float dl = be * (vs[r * 64 + j] - kS); float o = 0.f;
#pragma unroll
                for (int i = 0; i < 8; ++i) { S[i] += kk[i] * dl; o += qq[i] * S[i]; }
                o += __shfl_xor(o, 1); o += __shfl_xor(o, 2); o += __shfl_xor(o, 4);
                if (p == 0) OR[(size_t)(tb + r) * 384 + h * 64 + j] = o;
            }
        }
    }
}
__device__ __forceinline__ void ph_gout(const Ctx& c, int l) {
    const Params& P = *c.P; const bf16_t* proj = (const bf16_t*)(P.ws + WS_PROJ); bf16_t* mix = (bf16_t*)(P.ws + WS_MIX); const float* OR = (const float*)(P.ws + WS_OR);
    const float nw = P.in[I_NORMW][l * 64 + c.lane];
    for (int t = c.gw; t < T_; t += c.ngw) {
#pragma unroll
        for (int h = 0; h < 6; ++h) { const float o = OR[(size_t)t * 384 + h * 64 + c.lane]; const float ms = wave_sum(o * o) * (1.f / 64.f);
            const float z = bf2f(proj[(size_t)t * NPROJ + C_GZ + h * 64 + c.lane]);
            mix[(size_t)t * 1024 + 640 + h * 64 + c.lane] = (bf16_t)f2bf(o * (1.f / sqrtf(ms + NORM_EPS_)) * nw * silu_f(z)); }
    }
}

__device__ __forceinline__ void ph_ln1(const Ctx& c, int l) {
    const Params& P = *c.P; const float* mod = (const float*)(P.ws + WS_MOD) + (size_t)l * 8 * 6144;
    float* Z = (float*)(P.ws + WS_Z); bf16_t* H2 = (bf16_t*)(P.ws + WS_H2); int* TI = (int*)(P.ws + WS_TOPI); float* TG = (float*)(P.ws + WS_TOPG);
    float* wr = (float*)c.lds;
    const float* rw = P.in[I_RW] + (size_t)l * 1024 * 32;
    for (int i = c.tid; i < 32768; i += NTHREADS) { const int k = i >> 5, e = i & 31; wr[e * 1024 + k] = rw[i]; }
    __syncthreads();
    const float* g = P.in[I_LN1G] + l * 1024; const float* bb = P.in[I_LN1B] + l * 1024; const float* rb = P.in[I_RB] + l * 32;
    for (int t = c.gw; t < T_; t += c.ngw) {
        const int b = t / SEQ_; float* zr = Z + (size_t)t * 1024;
        f32x4 v[4], h[4];
#pragma unroll
        for (int j = 0; j < 4; ++j) v[j] = *(const f32x4*)(zr + 4 * c.lane + 256 * j);
        ln_rows(v, g, bb, c.lane);
#pragma unroll
        for (int j = 0; j < 4; ++j) *(f32x4*)(zr + 4 * c.lane + 256 * j) = v[j];
        modulate(h, v, mod + (size_t)b * 6144 + 3072, mod + (size_t)b * 6144 + 4096, c.lane);
        store_bf16_row(H2 + (size_t)t * 1024, c.lane, h);
        float mylg = -3.0e38f;
#pragma unroll 2
        for (int e = 0; e < 32; ++e) { float a = 0.f;
#pragma unroll
            for (int j = 0; j < 4; ++j) { const f32x4 w = *(const f32x4*)(wr + e * 1024 + 4 * c.lane + 256 * j); a += (h[j][0] * w[0] + h[j][1] * w[1]) + (h[j][2] * w[2] + h[j][3] * w[3]); }
            const float s = wave_sum(a) + rb[e]; if (c.lane == e) mylg = s; }
        int bi[4]; float bv[4];
#pragma unroll
        for (int k = 0; k < 4; ++k) { const float best = wave_max(mylg); const unsigned long long bal = __ballot(mylg == best); const int id = __ffsll((long long)bal) - 1;
            if (c.lane == id) mylg = -3.0e38f;
            bi[k] = id; bv[k] = best; }
        const float e1 = __expf(bv[1] - bv[0]), e2 = __expf(bv[2] - bv[0]), e3 = __expf(bv[3] - bv[0]), inv = 1.f / (1.f + e1 + e2 + e3);
        if (c.lane == 0) { *(int4*)(TI + (size_t)t * 4) = make_int4(bi[0], bi[1], bi[2], bi[3]); *(f32x4*)(TG + (size_t)t * 4) = (f32x4){inv, e1 * inv, e2 * inv, e3 * inv}; }
    }
    __syncthreads();
}

__device__ __forceinline__ void ph_routea(const Ctx& c) {
    const Params& P = *c.P; const int* TI = (const int*)(P.ws + WS_TOPI); int* R = (int*)(P.ws + WS_ROUTE);
    int* hist = (int*)c.lds;
    for (int seg = c.bid; seg < 256; seg += c.nblk) {
        if (c.tid < 32) hist[c.tid] = 0;
        __syncthreads();
        if (c.tid < 256) atomicAdd(&hist[TI[seg * 256 + c.tid]], 1);
        __syncthreads();
        if (c.tid < 32) R[R_COUNTS + seg * 32 + c.tid] = hist[c.tid];
        __syncthreads();
    }
}
__device__ __forceinline__ void ph_routeb(const Ctx& c) {
    const Params& P = *c.P; const int* TI = (const int*)(P.ws + WS_TOPI); int* R = (int*)(P.ws + WS_ROUTE);
    int* tot = (int*)c.lds; int* off = tot + 32; int* pst = off + 32; int* eid = pst + 64;
    for (int seg = c.bid; seg < 256; seg += c.nblk) {
        if (c.tid < 32) { int a = 0, o = 0; for (int s2 = 0; s2 < 256; ++s2) { const int v = R[R_COUNTS + s2 * 32 + c.tid]; a += v; if (s2 < seg) o += v; } tot[c.tid] = a; off[c.tid] = o; }
        if (c.tid < 256) eid[c.tid] = TI[seg * 256 + c.tid];
        __syncthreads();
        if (c.tid == 0) { int ps = 0; for (int e = 0; e < 32; ++e) { pst[e] = ps; ps += ((tot[e] + 255) >> 8) << 8; } pst[32] = ps; }
        __syncthreads();
        if (c.tid < 256) { const int e = eid[c.tid]; int rank = 0; for (int q = 0; q < c.tid; ++q) rank += (eid[q] == e) ? 1 : 0;
            R[R_ROWTOK + pst[e] + off[e] + rank] = seg * 256 + c.tid; }
        if (seg == 0) {
            for (int e = 0; e < 32; ++e) { const int lo = pst[e] + tot[e], hi = pst[e + 1]; for (int q = lo + c.tid; q < hi; q += NTHREADS) R[R_ROWTOK + q] = -1; }
            const int nrb = pst[32] >> 8;
            for (int rb = c.tid; rb < nrb; rb += NTHREADS) { int e = 0; for (int q = 1; q < 32; ++q) if ((rb << 8) >= pst[q]) e = q; R[R_BLKE + rb] = e; }
            if (c.tid == 0) R[R_NRB] = nrb;
        }
        __syncthreads();
    }
}
__device__ __forceinline__ void ph_gather(const Ctx& c) {
    const Params& P = *c.P; const int* R = (const int*)(P.ws + WS_ROUTE); const bf16_t* H2 = (const bf16_t*)(P.ws + WS_H2); bf16_t* XB = (bf16_t*)(P.ws + WS_XBUF);
    const int nrows = R[R_NRB] * 256;
    for (int r = c.gw; r < nrows; r += c.ngw) { const int a = R[R_ROWTOK + r];
        u32x4 v0 = (u32x4){0u, 0u, 0u, 0u}, v1 = v0;
        if (a >= 0) { const bf16_t* src = H2 + (size_t)(a >> 2) * 1024; v0 = *(const u32x4*)(src + 8 * c.lane); v1 = *(const u32x4*)(src + 512 + 8 * c.lane); }
        *(u32x4*)(XB + (size_t)r * 1024 + 8 * c.lane) = v0; *(u32x4*)(XB + (size_t)r * 1024 + 512 + 8 * c.lane) = v1; }
}

__device__ __forceinline__ void ph_combine(const Ctx& c, int l) {
    const Params& P = *c.P; const float* mod = (const float*)(P.ws + WS_MOD) + (size_t)l * 8 * 6144;
    const float* X1 = (const float*)(P.ws + WS_Z); const bf16_t* Y4 = (const bf16_t*)(P.ws + WS_Y4); const float* TG = (const float*)(P.ws + WS_TOPG);
    float* XO = (l == DEPTH_ - 1) ? P.out : (float*)(P.ws + WS_X); bf16_t* H = (bf16_t*)(P.ws + WS_H);
    const float* g = P.in[I_LN2G] + l * 1024; const float* bb = P.in[I_LN2B] + l * 1024;
    for (int t = c.gw; t < T_; t += c.ngw) {
        const int b = t / SEQ_; const f32x4 gt = *(const f32x4*)(TG + (size_t)t * 4);
        f32x4 v[4];
#pragma unroll
        for (int j = 0; j < 4; ++j) { const int col = 4 * c.lane + 256 * j; f32x4 y = (f32x4){0.f, 0.f, 0.f, 0.f};
#pragma unroll
            for (int k = 0; k < 4; ++k) { const u32x2 w = *(const u32x2*)(Y4 + (size_t)(t * 4 + k) * 1024 + col); y += gt[k] * (f32x4){bflo(w.x), bfhi(w.x), bflo(w.y), bfhi(w.y)}; }
            const f32x4 x1 = *(const f32x4*)(X1 + (size_t)t * 1024 + col), g2 = *(const f32x4*)(mod + (size_t)b * 6144 + 5120 + col);
            v[j] = x1 * ALPHA_ + g2 * y; }
        ln_rows(v, g, bb, c.lane);
#pragma unroll
        for (int j = 0; j < 4; ++j) *(f32x4*)(XO + (size_t)t * 1024 + 4 * c.lane + 256 * j) = v[j];
        if (l + 1 < DEPTH_) { const float* m2 = (const float*)(P.ws + WS_MOD) + (size_t)(l + 1) * 8 * 6144 + (size_t)b * 6144; f32x4 h[4];
            modulate(h, v, m2, m2 + 1024, c.lane); store_bf16_row(H + (size_t)t * 1024, c.lane, h); }
    }
}

template <int KIND>
__device__ __forceinline__ void run_kind(const Ctx& c0, int l) {
    Ctx c = c0;
    { int t = c0.tid; asm volatile("" : "+v"(t)); c.tid = t; c.lane = t & 63; c.wave = __builtin_amdgcn_readfirstlane(t >> 6); }
    { int b = c0.bid, n = c0.nblk; asm volatile("" : "+s"(b), "+s"(n)); c.bid = b; c.nblk = n; c.gw = b * NWAVES + c.wave; c.ngw = n * NWAVES; }
    { long z = 0; asm volatile("" : "+s"(z)); c.P = (const Params*)((const char*)c0.P + z); }
    const Params& P = *c.P; LAS unsigned char* lds3 = (LAS unsigned char*)c.lds;
    const int* R = (const int*)(P.ws + WS_ROUTE);
    if constexpr (KIND == 0) ph_conv(c);
    else if constexpr (KIND == 1) ph_mod(c);
    else if constexpr (KIND == 2) ph_prep0(c);
    else if constexpr (KIND == 3 + L_GEMM1) { DenseSched S{(const char*)(P.ws + WS_H), (const char*)(P.ws + WS_WIN) + (size_t)l * NPROJ * 2048, T_ / 256, NPROJ / 256, c.nblk, c.bid};
        EpiStoreBf16 E{(bf16_t*)(P.ws + WS_PROJ), NPROJ};
        pg8::gemm_phase<EpiStoreBf16, DenseSched, true, true>(lds3, S, E, c.tid); }
    else if constexpr (KIND == 3 + L_MIXA) ph_mixa(c, l);
    else if constexpr (KIND == 3 + L_GSCAN) ph_gscan(c);
    else if constexpr (KIND == 3 + L_GOUT) ph_gout(c, l);
    else if constexpr (KIND == 3 + L_GEMM2) { DenseSched S{(const char*)(P.ws + WS_MIX), (const char*)(P.ws + WS_WOUT) + (size_t)l * 1024 * 2048, T_ / 256, 4, c.nblk, c.bid};
        EpiResid E{l == 0 ? P.in[I_X] : (const float*)(P.ws + WS_X), (const float*)(P.ws + WS_MOD) + (size_t)l * 8 * 6144 + 2048, (float*)(P.ws + WS_Z)};
        pg8::gemm_phase<EpiResid, DenseSched, true, true>(lds3, S, E, c.tid); }
    else if constexpr (KIND == 3 + L_LN1) ph_ln1(c, l);
    else if constexpr (KIND == 3 + L_ROUTEA) ph_routea(c);
    else if constexpr (KIND == 3 + L_ROUTEB) ph_routeb(c);
    else if constexpr (KIND == 3 + L_GATHER) ph_gather(c);
    else if constexpr (KIND == 3 + L_UP) { MoeSched S{(const char*)(P.ws + WS_XBUF), (const char*)(P.ws + WS_WUP) + (size_t)l * 32 * 2048 * 2048, R + R_BLKE, R[R_NRB], 8, c.nblk, c.bid, (size_t)2048 * 2048};
        EpiSwiglu E{(bf16_t*)(P.ws + WS_ACT), P.in[I_BUP] + (size_t)l * 32 * 2048};
        pg8::gemm_phase<EpiSwiglu, MoeSched, true, true>(lds3, S, E, c.tid); }
    else if constexpr (KIND == 3 + L_DOWN) { MoeSched S{(const char*)(P.ws + WS_ACT), (const char*)(P.ws + WS_WDN) + (size_t)l * 32 * 1024 * 2048, R + R_BLKE, R[R_NRB], 4, c.nblk, c.bid, (size_t)1024 * 2048};
        EpiDown E{(bf16_t*)(P.ws + WS_Y4), P.in[I_BDN] + (size_t)l * 32 * 1024, R + R_ROWTOK};
        pg8::gemm_phase<EpiDown, MoeSched, true, true>(lds3, S, E, c.tid); }
    else if constexpr (KIND == 3 + L_COMBINE) ph_combine(c, l);
}

#define SEAM() grid.sync()
template <int L> __device__ __forceinline__ void run_layer(const Ctx& c, cg::grid_group& grid) {
    run_kind<3 + L_GEMM1>(c, L); SEAM();
    run_kind<3 + L_MIXA>(c, L); SEAM();
    run_kind<3 + L_GSCAN>(c, L); SEAM();
    run_kind<3 + L_GOUT>(c, L); SEAM();
    run_kind<3 + L_GEMM2>(c, L); SEAM();
    run_kind<3 + L_LN1>(c, L); SEAM();
    run_kind<3 + L_ROUTEA>(c, L); SEAM();
    run_kind<3 + L_ROUTEB>(c, L); SEAM();
    run_kind<3 + L_GATHER>(c, L); SEAM();
    run_kind<3 + L_UP>(c, L); SEAM();
    run_kind<3 + L_DOWN>(c, L); SEAM();
    run_kind<3 + L_COMBINE>(c, L);
}
__global__ void __launch_bounds__(NTHREADS, 2) mk_fwd(Params P) {
    extern __shared__ __attribute__((aligned(16))) unsigned char lds[];
    Ctx c; c.P = &P; c.lds = lds; c.tid = threadIdx.x; c.lane = c.tid & 63; c.wave = __builtin_amdgcn_readfirstlane(c.tid >> 6);
    c.bid = blockIdx.x; c.nblk = gridDim.x; c.gw = c.bid * NWAVES + c.wave; c.ngw = c.nblk * NWAVES;
    cg::grid_group grid = cg::this_grid();
    run_kind<0>(c, 0); __syncthreads(); run_kind<1>(c, 0); SEAM();
    run_kind<2>(c, 0); SEAM();
    run_layer<0>(c, grid); SEAM();
    run_layer<1>(c, grid);
}

extern "C" void kernel_launch(void* const* d_in, const int* in_sizes, int n_in, void* d_out, int out_size, void* d_ws, size_t ws_size, hipStream_t stream) {
    static int grid = 0;
    if (grid == 0) {
        if (n_in != N_IN || out_size != T_ * D_ || ws_size < WS_END) { fprintf(stderr, "kernel_launch: unexpected shapes (n_in %d out %d ws %zu need %zu)\n", n_in, out_size, ws_size, (size_t)WS_END); grid = -1; return; }
        int dev = 0, cus = 0, per_cu = 0;
        (void)hipGetDevice(&dev); (void)hipDeviceGetAttribute(&cus, hipDeviceAttributeMultiprocessorCount, dev);
        (void)hipFuncSetAttribute((const void*)mk_fwd, hipFuncAttributeMaxDynamicSharedMemorySize, LDS_BYTES);
        if (hipOccupancyMaxActiveBlocksPerMultiprocessor(&per_cu, (const void*)mk_fwd, NTHREADS, LDS_BYTES) != hipSuccess || per_cu < 1) { fprintf(stderr, "kernel_launch: occupancy query says %d blocks/CU\n", per_cu); (void)hipGetLastError(); grid = -1; return; }
        grid = cus > 0 ? cus : 256;
    }
    if (grid < 0) return;
    (void)hipMemsetAsync((char*)d_ws + WS_CTL, 0, 1 * MiB, stream);
    Params p{};
    for (int i = 0; i < N_IN; ++i) p.in[i] = (const float*)d_in[i];
    p.out = (float*)d_out; p.ws = (unsigned char*)d_ws;
    void* args[] = {&p};
    hipError_t e = hipLaunchCooperativeKernel((const void*)mk_fwd, dim3(grid), dim3(NTHREADS), args, LDS_BYTES, stream);
    if (e != hipSuccess) fprintf(stderr, "cooperative launch failed: %s (grid %d)\n", hipGetErrorString(e), grid);
}
```

```cpp
#include <hip/hip_runtime.h>
#include <hip/hip_cooperative_groups.h>
#include <cstdio>
#include <cstdint>
namespace cg = cooperative_groups;

#define LAS __attribute__((address_space(3)))
typedef unsigned short bf16_t;
typedef short bf16x8 __attribute__((ext_vector_type(8)));
typedef float f32x4 __attribute__((ext_vector_type(4)));
typedef float f32x2 __attribute__((ext_vector_type(2)));
typedef unsigned u32x4 __attribute__((ext_vector_type(4)));
typedef unsigned u32x2 __attribute__((ext_vector_type(2)));

constexpr int T_ = 16384, D_ = 1024, NB_ = 8, SEQ_ = 2048, DEPTH_ = 2;
constexpr int IN_DIM = 2444, NPROJ = 2560;
constexpr int C_POOL = 0, C_AQ = 256, C_AK = 640, C_AV = 768, C_GQ = 896, C_GK = 1280, C_GV = 1664, C_GZ = 2048, C_GB = 2432, C_GA = 2438;
constexpr int NE_ = 32, TOPK_ = 4, NASSIGN = T_ * TOPK_, NRB_MAX = NASSIGN / 256 + NE_, PROWS = NRB_MAX * 256;
constexpr float ALPHA_ = 1.41421356237309515f;
constexpr float LN_EPS_ = 1e-5f, NORM_EPS_ = 1e-6f;
constexpr int NTHREADS = 512, NWAVES = 8;
constexpr int LDS_BYTES = 147456;

constexpr size_t MiB = 1u << 20;
constexpr size_t WS_CTL = 0;
constexpr size_t WS_MOD = 1 * MiB;
constexpr size_t WS_ROUTE = 2 * MiB;
constexpr size_t WS_WIN = 4 * MiB;
constexpr size_t WS_WOUT = 14 * MiB;
constexpr size_t WS_WUP = 18 * MiB;
constexpr size_t WS_WDN = WS_WUP + 256 * MiB;
constexpr size_t WS_H = WS_WDN + 128 * MiB;
constexpr size_t WS_H2 = WS_H + 32 * MiB;
constexpr size_t WS_PROJ = WS_H2 + 32 * MiB;
constexpr size_t WS_MIX = WS_PROJ + 80 * MiB;
constexpr size_t WS_Z = WS_MIX + 32 * MiB;
constexpr size_t WS_X = WS_Z + 64 * MiB;
constexpr size_t WS_QN = WS_X + 64 * MiB;
constexpr size_t WS_KN = WS_QN + 24 * MiB;
constexpr size_t WS_VV = WS_KN + 24 * MiB;
constexpr size_t WS_OR = WS_VV + 24 * MiB;
constexpr size_t WS_GB = WS_OR + 24 * MiB;
constexpr size_t WS_TOPI = WS_GB + 1 * MiB;
constexpr size_t WS_TOPG = WS_TOPI + 1 * MiB;
constexpr size_t WS_XBUF = WS_TOPG + 1 * MiB;
constexpr size_t WS_ACT = WS_XBUF + 144 * MiB;
constexpr size_t WS_Y4 = WS_ACT + 144 * MiB;
constexpr size_t WS_X1 = WS_Y4 + 128 * MiB;
constexpr size_t WS_END = WS_X1 + 64 * MiB;
constexpr int R_COUNTS = 0;
constexpr int R_BLKE = 8192;
constexpr int R_NRB = 8192 + 512;
constexpr int R_ROWTOK = 16384;

__device__ __forceinline__ unsigned f2bf(float f) { unsigned u = __builtin_bit_cast(unsigned, f); return (u + 0x7fffu + ((u >> 16) & 1u)) >> 16; }
__device__ __forceinline__ unsigned pk2(float lo, float hi) { return f2bf(lo) | (f2bf(hi) << 16); }
__device__ __forceinline__ float bf2f(unsigned short b) { return __builtin_bit_cast(float, (unsigned)b << 16); }
__device__ __forceinline__ float bflo(unsigned w) { return __builtin_bit_cast(float, w << 16); }
__device__ __forceinline__ float bfhi(unsigned w) { return __builtin_bit_cast(float, w & 0xffff0000u); }
__device__ __forceinline__ float wave_sum(float v) {
#pragma unroll
    for (int o = 1; o < 64; o <<= 1) v += __shfl_xor(v, o);
    return v;
}
__device__ __forceinline__ float wave_max(float v) {
#pragma unroll
    for (int o = 1; o < 64; o <<= 1) v = fmaxf(v, __shfl_xor(v, o));
    return v;
}
__device__ __forceinline__ float silu_f(float x) { return x / (1.f + __expf(-x)); }
__device__ __forceinline__ float sigmoid_f(float x) { return 1.f / (1.f + __expf(-x)); }

namespace pg8 {
constexpr int BM = 256, BK = 64, HALF = 128, HTB = HALF * BK * 2, STAGE_BYTES = 8 * HTB, NXCD = 8, WGM = 8, KD = 1024;
__host__ __device__ __forceinline__ int lds_byte(int r, int c) { const int st = (r >> 4) * 2 + (c >> 5), rr = r & 15, cc = c & 31, ob = rr * 64 + cc * 2; return st * 1024 + (ob ^ (((ob >> 9) & 1) << 5)); }
__host__ __device__ __forceinline__ void stage_rc(int b, int& R, int& C) { const int st = b / 1024, sb = b % 1024, swz = sb ^ (((sb >> 9) & 1) << 5); R = (st >> 1) * 16 + swz / 64; C = (st & 1) * 32 + (swz % 64) / 2; }
__host__ __device__ __forceinline__ int perm32(int rho) { const int n = rho >> 4, i = rho & 15; return 8 * (i >> 2) + 4 * n + (i & 3); }

struct Unit { int pm, pn, e; const char* a; const char* b; };

__device__ __forceinline__ void tile_of(int L, int nM, int nN, int& pm, int& pn) {
    const int nwg = nM * nN; int wgid = L;
    { const int q = nwg / NXCD, r = nwg % NXCD, xcd = wgid % NXCD, off = wgid / NXCD; wgid = (xcd < r ? xcd * (q + 1) : r * (q + 1) + (xcd - r) * q) + off; }
    const int nig = WGM * nN, gid = wgid / nig, fm = gid * WGM, gsz = (nM - fm) < WGM ? (nM - fm) : WGM;
    pm = fm + ((wgid % nig) % gsz); pn = (wgid % nig) / gsz;
}

__device__ __forceinline__ unsigned cvt_pk_bf16(float lo, float hi) { unsigned r; asm volatile("v_cvt_pk_bf16_f32 %0, %1, %2" : "=v"(r) : "v"(lo), "v"(hi)); return r; }

template <class Epi, class Sched, bool ALIGN_EPI, bool SP2>
__device__ __forceinline__ void gemm_phase(LAS unsigned char* lds, const Sched& S, const Epi& E, const int tid) {
    const int wid = __builtin_amdgcn_readfirstlane(tid >> 6), lane = tid & 63, wr = wid >> 2, wc = wid & 3, fr = lane & 15, fq = lane >> 4;
    constexpr int K = KD, nt = K / BK;
    unsigned voffA[2], voffB[2];
#pragma unroll
    for (int i = 0; i < 2; ++i) { int R, C; stage_rc(tid * 16 + i * 8192, R, C); const int Rb = Epi::PERM ? ((R & ~31) + perm32(R & 31)) : R;
        voffA[i] = (unsigned)(R * K + C) * 2u; voffB[i] = (unsigned)(Rb * K + C) * 2u; }
    const size_t kstep = (size_t)(BK * 2);
    const size_t hstep = (size_t)HALF * K * 2;
    const unsigned ldsw = (unsigned)wid * 1024u;
    const int aoff = lds_byte(wr * 64 + fr, fq * 8), boff = lds_byte(wc * 32 + fr, fq * 8);
#define PG8_SA(b, h) (((b) * 2 + (h)) * HTB)
#define PG8_SB(b, h) ((4 + (b) * 2 + (h)) * HTB)
#define PG8_STAGE(bufoff, gbase, voff) do { _Pragma("unroll") for (int _i = 0; _i < 2; ++_i) \
        __builtin_amdgcn_global_load_lds((const unsigned*)((const char*)(gbase) + (voff)[_i]), (LAS unsigned*)(lds + (bufoff) + ldsw + _i * 8192), 16, 0, 0); } while (0)
#define PG8_LDA(dst, b, h) do { _Pragma("unroll") for (int m = 0; m < 4; ++m) _Pragma("unroll") for (int k = 0; k < 2; ++k) dst[m][k] = *(const LAS bf16x8*)(lds + PG8_SA(b, h) + aoff + m * 2048 + k * 1024); } while (0)
#define PG8_LDB(dst, b, h) do { _Pragma("unroll") for (int n = 0; n < 2; ++n) _Pragma("unroll") for (int k = 0; k < 2; ++k) dst[n][k] = *(const LAS bf16x8*)(lds + PG8_SB(b, h) + boff + n * 2048 + k * 1024); } while (0)
#define PG8_MMA(ai, bj, At, Bt) do { __builtin_amdgcn_s_setprio(1); _Pragma("unroll") for (int m = 0; m < 4; ++m) _Pragma("unroll") for (int n = 0; n < 2; ++n) _Pragma("unroll") for (int k = 0; k < 2; ++k) \
        acc[ai][bj][m][n] = __builtin_amdgcn_mfma_f32_16x16x32_bf16(Bt[n][k], At[m][k], acc[ai][bj][m][n], 0, 0, 0); __builtin_amdgcn_s_setprio(0); } while (0)
#define PG8_WAIT_V(n) asm volatile("s_waitcnt vmcnt(" #n ")" ::: "memory")
#define PG8_WAIT_L(n) asm volatile("s_waitcnt lgkmcnt(" #n ")" ::: "memory")
#define PG8_BAR __builtin_amdgcn_s_barrier()
#define PG8_SCHED __builtin_amdgcn_sched_barrier(0)
    Unit cur, nxt; int ui = 0;
    if (!S.next(0, cur)) return;
    f32x4 acc[2][2][4][2];
#pragma unroll
    for (int a = 0; a < 2; ++a)
#pragma unroll
        for (int b = 0; b < 2; ++b)
#pragma unroll
            for (int m = 0; m < 4; ++m)
#pragma unroll
                for (int n = 0; n < 2; ++n) acc[a][b][m][n] = (f32x4){0.f, 0.f, 0.f, 0.f};
    bf16x8 At[4][2], B0[2][2], B1[2][2];
    const char* cA = cur.a; const char* cB = cur.b;
    if constexpr (SP2) {
        PG8_STAGE(PG8_SB(0, 0), cB, voffB); PG8_STAGE(PG8_SB(0, 1), cB + hstep, voffB); PG8_STAGE(PG8_SA(0, 0), cA, voffA); PG8_STAGE(PG8_SA(0, 1), cA + hstep, voffA);
        if (wr == 1) PG8_BAR;
        PG8_WAIT_V(2); PG8_BAR;
        PG8_STAGE(PG8_SB(1, 0), cB + kstep, voffB); PG8_STAGE(PG8_SA(1, 0), cA + kstep, voffA); PG8_STAGE(PG8_SB(1, 1), cB + hstep + kstep, voffB);
        PG8_WAIT_V(6); PG8_BAR;
    } else {
        PG8_STAGE(PG8_SB(0, 0), cB, voffB); PG8_STAGE(PG8_SA(0, 0), cA, voffA); PG8_STAGE(PG8_SB(0, 1), cB + hstep, voffB); PG8_STAGE(PG8_SA(0, 1), cA + hstep, voffA);
        if (wr == 1) PG8_BAR;
        PG8_WAIT_V(4); PG8_BAR;
        PG8_STAGE(PG8_SB(1, 0), cB + kstep, voffB); PG8_STAGE(PG8_SA(1, 0), cA + kstep, voffA); PG8_STAGE(PG8_SB(1, 1), cB + hstep + kstep, voffB);
        PG8_WAIT_V(6); PG8_BAR;
    }
    for (;;) {
        const bool has_next = S.next(ui + 1, nxt);
        const char* nA = has_next ? nxt.a : cA; const char* nB = has_next ? nxt.b : cB;
        for (int t = 0; t < nt; t += 2) {
            const bool last = (t == nt - 2);
            const char* a1 = cA + (size_t)(t + 1) * kstep;
            const char* a2 = last ? nA : cA + (size_t)(t + 2) * kstep; const char* b2 = last ? nB : cB + (size_t)(t + 2) * kstep;
            const char* a3 = a2 + kstep; const char* b3 = b2 + kstep;
            if constexpr (SP2) {
            PG8_LDB(B0, 0, 0); PG8_LDB(B1, 0, 1); PG8_SCHED; PG8_LDA(At, 0, 0); PG8_STAGE(PG8_SA(1, 1), a1 + hstep, voffA);
            PG8_WAIT_V(8); PG8_WAIT_L(0); PG8_BAR; PG8_MMA(0, 0, At, B0); PG8_MMA(0, 1, At, B1); PG8_BAR; PG8_SCHED;
            PG8_LDA(At, 0, 1); PG8_STAGE(PG8_SB(0, 0), b2, voffB); PG8_STAGE(PG8_SB(0, 1), b2 + hstep, voffB); PG8_STAGE(PG8_SA(0, 0), a2, voffA);
            PG8_WAIT_V(8); PG8_WAIT_L(0); PG8_BAR; PG8_MMA(1, 0, At, B0); PG8_MMA(1, 1, At, B1); PG8_BAR; PG8_SCHED;
            PG8_LDB(B0, 1, 0); PG8_LDB(B1, 1, 1); PG8_SCHED; PG8_LDA(At, 1, 0); PG8_STAGE(PG8_SA(0, 1), a2 + hstep, voffA);
            PG8_WAIT_V(8); PG8_WAIT_L(0); PG8_BAR; PG8_MMA(0, 0, At, B0); PG8_MMA(0, 1, At, B1); PG8_BAR; PG8_SCHED;
            PG8_LDA(At, 1, 1); PG8_STAGE(PG8_SB(1, 0), b3, voffB); PG8_STAGE(PG8_SB(1, 1), b3 + hstep, voffB); PG8_STAGE(PG8_SA(1, 0), a3, voffA);
            PG8_WAIT_V(8); PG8_WAIT_L(0); PG8_BAR; PG8_MMA(1, 0, At, B0); PG8_MMA(1, 1, At, B1); PG8_BAR; PG8_SCHED;
            } else {
            PG8_LDB(B0, 0, 0); PG8_SCHED; PG8_LDA(At, 0, 0); PG8_STAGE(PG8_SA(1, 1), a1 + hstep, voffA);
            PG8_WAIT_L(8); PG8_BAR; PG8_WAIT_L(0); PG8_MMA(0, 0, At, B0); PG8_BAR; PG8_SCHED;
            PG8_LDB(B1, 0, 1); PG8_STAGE(PG8_SB(0, 0), b2, voffB);
            PG8_BAR; PG8_WAIT_L(0); PG8_MMA(0, 1, At, B1); PG8_BAR;
            PG8_LDA(At, 0, 1); PG8_STAGE(PG8_SA(0, 0), a2, voffA);
            PG8_BAR; PG8_WAIT_L(0); PG8_MMA(1, 0, At, B0); PG8_BAR; PG8_SCHED;
            PG8_STAGE(PG8_SB(0, 1), b2 + hstep, voffB);
            PG8_WAIT_V(6); PG8_BAR; PG8_MMA(1, 1, At, B1); PG8_BAR;
            PG8_LDB(B0, 1, 0); PG8_SCHED; PG8_LDA(At, 1, 0); PG8_STAGE(PG8_SA(0, 1), a2 + hstep, voffA);
            PG8_WAIT_L(8); PG8_BAR; PG8_WAIT_L(0); PG8_MMA(0, 0, At, B0); PG8_BAR; PG8_SCHED;
            PG8_LDB(B1, 1, 1); PG8_STAGE(PG8_SB(1, 0), b3, voffB);
            PG8_BAR; PG8_WAIT_L(0); PG8_MMA(0, 1, At, B1); PG8_BAR;
            PG8_LDA(At, 1, 1); PG8_STAGE(PG8_SA(1, 0), a3, voffA);
            PG8_BAR; PG8_WAIT_L(0); PG8_MMA(1, 0, At, B0); PG8_BAR; PG8_SCHED;
            PG8_STAGE(PG8_SB(1, 1), b3 + hstep, voffB);
            PG8_WAIT_V(6); PG8_BAR; PG8_MMA(1, 1, At, B1); PG8_BAR;
            }
        }
        if constexpr (ALIGN_EPI) { if (wr == 0) PG8_BAR; }
        E(acc, cur, wr, wc, fr, fq);
        if (!has_next) break;
#pragma unroll
        for (int a = 0; a < 2; ++a)
#pragma unroll
            for (int b = 0; b < 2; ++b)
#pragma unroll
                for (int m = 0; m < 4; ++m)
#pragma unroll
                    for (int n = 0; n < 2; ++n) acc[a][b][m][n] = (f32x4){0.f, 0.f, 0.f, 0.f};
        cur = nxt; cA = nA; cB = nB; ++ui;
        if constexpr (ALIGN_EPI) { if (wr == 1) PG8_BAR; }
    }
    PG8_WAIT_V(0);
    if constexpr (!ALIGN_EPI) { if (wr == 0) PG8_BAR; }
    PG8_BAR;
#undef PG8_SA
#undef PG8_SB
#undef PG8_STAGE
#undef PG8_LDA
#undef PG8_LDB
#undef PG8_MMA
#undef PG8_WAIT_V
#undef PG8_WAIT_L
#undef PG8_BAR
#undef PG8_SCHED
}
}

enum { I_X = 0, I_C, I_RELB, I_WIN, I_WOUT, I_WADA, I_BADA, I_LN1G, I_LN1B, I_LN2G, I_LN2B, I_POOLW, I_POOLS, I_SINKS, I_CONVW, I_ALOG, I_DTB, I_NORMW,
       I_RW, I_RB, I_WUP, I_BUP, I_WDN, I_BDN, N_IN };
struct Params { const float* in[N_IN]; float* out; unsigned char* ws; };

struct Ctx {
    const Params* P; unsigned char* lds; int tid, lane, wave, gw, ngw, bid, nblk;
};

enum { PH_CONV = 0, PH_MOD, PH_PREP0, PH_L0 };
enum { L_GEMM1 = 0, L_MIXA, L_GSCAN, L_GOUT, L_GEMM2, L_LN1, L_ROUTEA, L_ROUTEB, L_GATHER, L_UP, L_DOWN, L_COMBINE, L_NPH };
constexpr int N_PHASES = PH_L0 + DEPTH_ * L_NPH;

__device__ __forceinline__ void transpose_item(const float* W, int N, bf16_t* WT, int k0, int n0, int drow0, float* scr, int lane) {
    const int n = n0 + (lane & 31); const bool ok = n < N;
#pragma unroll 8
    for (int i = 0; i < 32; ++i) { const int kk = 2 * i + (lane >> 5); scr[kk * 33 + (lane & 31)] = ok ? W[(size_t)(k0 + kk) * N + n] : 0.f; }
    asm volatile("s_waitcnt lgkmcnt(0)" ::: "memory");
    const int c = lane & 7;
#pragma unroll
    for (int j = 0; j < 4; ++j) { const int nn = (lane >> 3) + 8 * j; const float* s = scr + (8 * c) * 33 + nn;
        u32x4 o; o.x = pk2(s[0 * 33], s[1 * 33]); o.y = pk2(s[2 * 33], s[3 * 33]); o.z = pk2(s[4 * 33], s[5 * 33]); o.w = pk2(s[6 * 33], s[7 * 33]);
        *(u32x4*)(WT + (size_t)(drow0 + nn) * 1024 + k0 + 8 * c) = o; }
    asm volatile("s_waitcnt lgkmcnt(0)" ::: "memory");
}
__device__ __forceinline__ void ph_conv(const Ctx& c) {
    const Params& P = *c.P;
    float* scr = (float*)(c.lds + c.wave * 16384);
    constexpr int I_IN = 16 * 80, I_OUT = 16 * 32, I_UP = 32 * 16 * 64, I_DN = 32 * 16 * 32, I_LAYER = I_IN + I_OUT + I_UP + I_DN;
    for (int it = c.gw; it < DEPTH_ * I_LAYER; it += c.ngw) {
        const int l = it / I_LAYER; int r = it % I_LAYER;
        if (r < I_IN) { const int kb = r / 80, nb = r % 80;
            transpose_item(P.in[I_WIN] + (size_t)l * 1024 * IN_DIM, IN_DIM, (bf16_t*)(P.ws + WS_WIN) + (size_t)l * NPROJ * 1024, 64 * kb, 32 * nb, 32 * nb, scr, c.lane); continue; }
        r -= I_IN;
        if (r < I_OUT) { const int kb = r / 32, nb = r % 32;
            transpose_item(P.in[I_WOUT] + (size_t)l * 1024 * 1024, 1024, (bf16_t*)(P.ws + WS_WOUT) + (size_t)l * 1024 * 1024, 64 * kb, 32 * nb, 32 * nb, scr, c.lane); continue; }
        r -= I_OUT;
        if (r < I_UP) { const int e = r / 1024, rr = r % 1024, kb = rr / 64, nb = rr % 64, n0 = 32 * nb, bj = n0 / 1024, rem = n0 % 1024, pn = rem / 128, c0 = rem % 128;
            transpose_item(P.in[I_WUP] + (size_t)(l * 32 + e) * 1024 * 2048, 2048, (bf16_t*)(P.ws + WS_WUP) + (size_t)(l * 32 + e) * 2048 * 1024, 64 * kb, n0, pn * 256 + bj * 128 + c0, scr, c.lane); continue; }
        r -= I_UP;
        { const int e = r / 512, rr = r % 512, kb = rr / 32, nb = rr % 32;
            transpose_item(P.in[I_WDN] + (size_t)(l * 32 + e) * 1024 * 1024, 1024, (bf16_t*)(P.ws + WS_WDN) + (size_t)(l * 32 + e) * 1024 * 1024, 64 * kb, 32 * nb, 32 * nb, scr, c.lane); }
    }
}

__device__ __forceinline__ void ph_mod(const Ctx& c) {
    const Params& P = *c.P;
    float* cs = (float*)c.lds;
    float* part = cs + 8192;
    for (int i = c.tid; i < 8192; i += NTHREADS) cs[i] = silu_f(P.in[I_C][i]);
    __syncthreads();
    float* mod = (float*)(P.ws + WS_MOD);
    for (int item = c.bid; item < DEPTH_ * 96; item += c.nblk) {
        const int l = item / 96, j = (item % 96) * 64 + c.lane;
        const float* w = P.in[I_WADA] + (size_t)l * 1024 * 6144 + j;
        float acc[8];
#pragma unroll
        for (int b = 0; b < 8; ++b) acc[b] = 0.f;
        const int k0 = c.wave * 128;
#pragma unroll 8
        for (int k = k0; k < k0 + 128; ++k) { const float wv = w[(size_t)k * 6144];
#pragma unroll
            for (int b = 0; b < 8; ++b) acc[b] += cs[b * 1024 + k] * wv; }
#pragma unroll
        for (int b = 0; b < 8; ++b) part[(c.wave * 8 + b) * 64 + c.lane] = acc[b];
        __syncthreads();
        { const int b = c.tid >> 6, col = c.tid & 63; float s = 0.f;
#pragma unroll
          for (int w8 = 0; w8 < 8; ++w8) s += part[(w8 * 8 + b) * 64 + col];
          const int jj = (item % 96) * 64 + col;
          mod[((size_t)l * 8 + b) * 6144 + jj] = s + P.in[I_BADA][l * 6144 + jj]; }
        __syncthreads();
    }
}

__device__ __forceinline__ void store_bf16_row(bf16_t* row, int lane, const f32x4 (&v)[4]) {
#pragma unroll
    for (int j = 0; j < 4; ++j) { u32x2 w; w.x = pk2(v[j][0], v[j][1]); w.y = pk2(v[j][2], v[j][3]); *(u32x2*)(row + 4 * lane + 256 * j) = w; }
}
__device__ __forceinline__ void modulate(f32x4 (&h)[4], const f32x4 (&x)[4], const float* sh, const float* sc, int lane) {
#pragma unroll
    for (int j = 0; j < 4; ++j) { const f32x4 a = *(const f32x4*)(sc + 4 * lane + 256 * j), b = *(const f32x4*)(sh + 4 * lane + 256 * j); h[j] = x[j] * (1.f + a) + b; }
}
__device__ __forceinline__ void ln_rows(f32x4 (&v)[4], const float* g, const float* b, int lane) {
    float s = 0.f;
#pragma unroll
    for (int j = 0; j < 4; ++j) s += (v[j][0] + v[j][1]) + (v[j][2] + v[j][3]);
    const float mean = wave_sum(s) * (1.f / 1024.f); float s2 = 0.f;
#pragma unroll
    for (int j = 0; j < 4; ++j) { v[j] = v[j] - mean; s2 += (v[j][0] * v[j][0] + v[j][1] * v[j][1]) + (v[j][2] * v[j][2] + v[j][3] * v[j][3]); }
    const float rstd = 1.f / sqrtf(wave_sum(s2) * (1.f / 1024.f) + LN_EPS_);
#pragma unroll
    for (int j = 0; j < 4; ++j) { const f32x4 gg = *(const f32x4*)(g + 4 * lane + 256 * j), bb = *(const f32x4*)(b + 4 * lane + 256 * j); v[j] = v[j] * rstd * gg + bb; }
}

__device__ __forceinline__ void ph_prep0(const Ctx& c) {
    const Params& P = *c.P; const float* mod = (const float*)(P.ws + WS_MOD);
    bf16_t* H = (bf16_t*)(P.ws + WS_H);
    for (int t = c.gw; t < T_; t += c.ngw) {
        const int b = t / SEQ_; const float* xr = P.in[I_X] + (size_t)t * 1024;
        f32x4 x[4], h[4];
#pragma unroll
        for (int j = 0; j < 4; ++j) x[j] = *(const f32x4*)(xr + 4 * c.lane + 256 * j);
        modulate(h, x, mod + (size_t)b * 6144, mod + (size_t)b * 6144 + 1024, c.lane);
        store_bf16_row(H + (size_t)t * 1024, c.lane, h);
    }
}

struct DenseSched {
    const char* A; const char* Bt; int nM, nN, G, c;
    __device__ __forceinline__ bool next(int i, pg8::Unit& u) const {
        const int L = i * G + c; if (L >= nM * nN) return false;
        pg8::tile_of(L, nM, nN, u.pm, u.pn); u.e = 0;
        u.a = A + (size_t)u.pm * 256 * 2048; u.b = Bt + (size_t)u.pn * 256 * 2048; return true; }
};
struct MoeSched {
    const char* A; const char* Bt; const int* blk_e; int nrb, nN, G, c; size_t estride;
    __device__ __forceinline__ bool next(int i, pg8::Unit& u) const {
        const int L = i * G + c; if (L >= nrb * nN) return false;
        pg8::tile_of(L, nrb, nN, u.pm, u.pn); u.e = blk_e[u.pm];
        u.a = A + (size_t)u.pm * 256 * 2048; u.b = Bt + (size_t)u.e * estride + (size_t)u.pn * 256 * 2048; return true; }
};
struct EpiStoreBf16 {
    static constexpr bool PERM = true;
    bf16_t* O; int ldc;
    __device__ __forceinline__ void operator()(const f32x4 (&acc)[2][2][4][2], const pg8::Unit& u, int wr, int wc, int fr, int fq) const {
        const int row0 = u.pm * 256 + wr * 64 + fr, col0 = u.pn * 256 + wc * 32 + 8 * fq;
#pragma unroll
        for (int ai = 0; ai < 2; ++ai)
#pragma unroll
            for (int m = 0; m < 4; ++m) { bf16_t* rowp = O + (size_t)(row0 + ai * 128 + m * 16) * ldc + col0;
#pragma unroll
                for (int bj = 0; bj < 2; ++bj) { const f32x4 v0 = acc[ai][bj][m][0], v1 = acc[ai][bj][m][1];
                    u32x4 w; w.x = pg8::cvt_pk_bf16(v0[0], v0[1]); w.y = pg8::cvt_pk_bf16(v0[2], v0[3]); w.z = pg8::cvt_pk_bf16(v1[0], v1[1]); w.w = pg8::cvt_pk_bf16(v1[2], v1[3]);
                    *(u32x4*)(rowp + bj * 128) = w; } }
    }
};
struct EpiResid {
    static constexpr bool PERM = false;
    const float* X; const float* gate; float* Z;
    __device__ __forceinline__ void operator()(const f32x4 (&acc)[2][2][4][2], const pg8::Unit& u, int wr, int wc, int fr, int fq) const {
        const int row0 = u.pm * 256 + wr * 64 + fr, col0 = u.pn * 256 + wc * 32 + 4 * fq;
        const float* gp = gate + (size_t)(u.pm >> 3) * 6144 + col0;
        f32x4 gv[2][2];
#pragma unroll
        for (int bj = 0; bj < 2; ++bj)
#pragma unroll
            for (int n = 0; n < 2; ++n) gv[bj][n] = *(const f32x4*)(gp + bj * 128 + n * 16);
#pragma unroll
        for (int ai = 0; ai < 2; ++ai)
#pragma unroll
            for (int m = 0; m < 4; ++m) { const size_t off = (size_t)(row0 + ai * 128 + m * 16) * 1024 + col0;
#pragma unroll
                for (int bj = 0; bj < 2; ++bj)
#pragma unroll
                    for (int n = 0; n < 2; ++n) { const f32x4 xv = *(const f32x4*)(X + off + bj * 128 + n * 16);
                        *(f32x4*)(Z + off + bj * 128 + n * 16) = xv * ALPHA_ + gv[bj][n] * acc[ai][bj][m][n]; } }
    }
};
struct EpiSwiglu {
    static constexpr bool PERM = true;
    bf16_t* ACT; const float* bup;
    __device__ __forceinline__ void operator()(const f32x4 (&acc)[2][2][4][2], const pg8::Unit& u, int wr, int wc, int fr, int fq) const {
        const int row0 = u.pm * 256 + wr * 64 + fr, j0 = u.pn * 128 + wc * 32 + 8 * fq;
        const float* bp = bup + (size_t)u.e * 2048 + j0;
        f32x4 bg[2], bl[2];
#pragma unroll
        for (int n = 0; n < 2; ++n) { bg[n] = *(const f32x4*)(bp + 4 * n); bl[n] = *(const f32x4*)(bp + 1024 + 4 * n); }
#pragma unroll
        for (int ai = 0; ai < 2; ++ai)
#pragma unroll
            for (int m = 0; m < 4; ++m) { float o[8];
#pragma unroll
                for (int n = 0; n < 2; ++n)
#pragma unroll
                    for (int q = 0; q < 4; ++q) { const float xg = fminf(acc[ai][0][m][n][q] + bg[n][q], 7.f); const float xl = fminf(fmaxf(acc[ai][1][m][n][q] + bl[n][q], -7.f), 7.f);
                        o[4 * n + q] = xg * sigmoid_f(1.702f * xg) * (xl + 1.f); }
                u32x4 w; w.x = pg8::cvt_pk_bf16(o[0], o[1]); w.y = pg8::cvt_pk_bf16(o[2], o[3]); w.z = pg8::cvt_pk_bf16(o[4], o[5]); w.w = pg8::cvt_pk_bf16(o[6], o[7]);
                *(u32x4*)(ACT + (size_t)(row0 + ai * 128 + m * 16) * 1024 + j0) = w; }
    }
};
struct EpiDown {
    static constexpr bool PERM = true;
    bf16_t* Y4; const float* bdn; const int* rowtok;
    __device__ __forceinline__ void operator()(const f32x4 (&acc)[2][2][4][2], const pg8::Unit& u, int wr, int wc, int fr, int fq) const {
        const int row0 = u.pm * 256 + wr * 64 + fr, col0 = u.pn * 256 + wc * 32 + 8 * fq;
        const float* bp = bdn + (size_t)u.e * 1024 + col0;
        f32x4 bv[2][2];
#pragma unroll
        for (int bj = 0; bj < 2; ++bj)
#pragma unroll
            for (int n = 0; n < 2; ++n) bv[bj][n] = *(const f32x4*)(bp + bj * 128 + 4 * n);
#pragma unroll
        for (int ai = 0; ai < 2; ++ai)
#pragma unroll
            for (int m = 0; m < 4; ++m) { const int a = rowtok[row0 + ai * 128 + m * 16];
                if (a >= 0) { bf16_t* rowp = Y4 + (size_t)a * 1024 + col0;
#pragma unroll
                    for (int bj = 0; bj < 2; ++bj) { const f32x4 v0 = acc[ai][bj][m][0] + bv[bj][0], v1 = acc[ai][bj][m][1] + bv[bj][1];
                        u32x4 w; w.x = pg8::cvt_pk_bf16(v0[0], v0[1]); w.y = pg8::cvt_pk_bf16(v0[2], v0[3]); w.z = pg8::cvt_pk_bf16(v1[0], v1[1]); w.w = pg8::cvt_pk_bf16(v1[2], v1[3]);
                        *(u32x4*)(rowp + bj * 128) = w; } } }
    }
};

__device__ __forceinline__ int t5_bucket(int n) { if (n < 16) return n; const int v = 16 + (int)(logf((float)n * (1.f / 16.f)) / logf(8.f) * 16.f); return v < 31 ? v : 31; }

__device__ __forceinline__ void pool_tile(const Ctx& c, int l, int tile) {
    const Params& P = *c.P; const bf16_t* proj = (const bf16_t*)(P.ws + WS_PROJ); bf16_t* mix = (bf16_t*)(P.ws + WS_MIX);
    float* us = (float*)c.lds;
    float* ps = us + 47 * 256;
    const int t0 = tile * 32, s0 = t0 % SEQ_;
    for (int i = c.tid; i < 47 * 256; i += NTHREADS) { const int r = i >> 8, ch = i & 255, s = s0 - 15 + r;
        us[i] = (s >= 0) ? bf2f(proj[(size_t)(t0 - 15 + r) * NPROJ + C_POOL + ch]) : 0.f; }
    __syncthreads();
    for (int i = c.tid; i < 32 * 256; i += NTHREADS) { const int r = i >> 8, ch = i & 255, gi = ch >> 6, w = 2 << gi, s = s0 + r;
        float sum = 0.f;
        for (int j = 0; j < w; ++j) sum += us[(15 + r - j) * 256 + ch];
        const float cnt = (float)((s + 1) < w ? (s + 1) : w);
        ps[i] = sum / cnt - us[(15 + r) * 256 + ch]; }
    __syncthreads();
    const float* pw = P.in[I_POOLW] + (size_t)l * 4 * 64 * 64; const float* psc = P.in[I_POOLS] + l * 256;
    for (int i = c.tid; i < 32 * 256; i += NTHREADS) { const int r = i >> 8, dd = i & 255, gi = dd >> 6, d = dd & 63;
        const float* pr = ps + r * 256 + gi * 64; const float* wp = pw + (size_t)gi * 4096 + d; float acc = 0.f;
#pragma unroll 8
        for (int k = 0; k < 64; ++k) acc += pr[k] * wp[k * 64];
        mix[(size_t)(t0 + r) * 1024 + dd] = (bf16_t)f2bf(acc * psc[dd]); }
    __syncthreads();
}
__device__ __forceinline__ void swa_item(const Ctx& c, int l, int item, float* wl) {
    const Params& P = *c.P; const bf16_t* proj = (const bf16_t*)(P.ws + WS_PROJ); bf16_t* mix = (bf16_t*)(P.ws + WS_MIX);
    float* qs = wl; float* pr = wl + 64;
    const int t = item / 6, hq = item % 6, kvh = hq / 3, s = t % SEQ_, lane = c.lane;
    qs[lane] = bf2f(proj[(size_t)t * NPROJ + C_AQ + hq * 64 + lane]);
    asm volatile("s_waitcnt lgkmcnt(0)" ::: "memory");
    const float sink = P.in[I_SINKS][l * 6 + hq];
    float sc[2];
#pragma unroll
    for (int h2 = 0; h2 < 2; ++h2) { const int kk = lane + 64 * h2, dist = 127 - kk, sk = s - dist;
        float dot = -1e30f;
        if (sk >= 0) { const bf16_t* kr = proj + (size_t)(t - dist) * NPROJ + C_AK + kvh * 64; float a = 0.f;
#pragma unroll
            for (int d8 = 0; d8 < 8; ++d8) { const u32x4 kv = *(const u32x4*)(kr + d8 * 8);
                a += qs[d8 * 8 + 0] * bflo(kv.x) + qs[d8 * 8 + 1] * bfhi(kv.x) + qs[d8 * 8 + 2] * bflo(kv.y) + qs[d8 * 8 + 3] * bfhi(kv.y)
                   + qs[d8 * 8 + 4] * bflo(kv.z) + qs[d8 * 8 + 5] * bfhi(kv.z) + qs[d8 * 8 + 6] * bflo(kv.w) + qs[d8 * 8 + 7] * bfhi(kv.w); }
            dot = a * 0.125f + P.in[I_RELB][t5_bucket(dist) * 6 + hq]; }
        sc[h2] = dot; }
    const float m = fmaxf(wave_max(fmaxf(sc[0], sc[1])), sink);
    const float p0 = (sc[0] > -1e29f) ? __expf(sc[0] - m) : 0.f, p1 = (sc[1] > -1e29f) ? __expf(sc[1] - m) : 0.f;
    const float den = wave_sum(p0 + p1) + __expf(sink - m);
    pr[lane] = p0; pr[lane + 64] = p1;
    asm volatile("s_waitcnt lgkmcnt(0)" ::: "memory");
    float o = 0.f;
    const int kk0 = (s >= 127) ? 0 : (127 - s);
    for (int kk = kk0; kk < 128; ++kk) o += pr[kk] * bf2f(proj[(size_t)(t - 127 + kk) * NPROJ + C_AV + kvh * 64 + lane]);
    mix[(size_t)t * 1024 + 256 + hq * 64 + lane] = (bf16_t)f2bf(o / den);
    asm volatile("s_waitcnt lgkmcnt(0)" ::: "memory");
}
constexpr int SW_KS = 0, SW_KROW = 144, SW_VT = 272 * 144, SW_VROW = 552, SW_BIAS = SW_VT + 64 * SW_VROW, SW_END = SW_BIAS + 3 * 128 * 4;
__device__ __forceinline__ void swa_mfma_item(const Ctx& c, int l, int item) {
    const Params& P = *c.P; const bf16_t* proj = (const bf16_t*)(P.ws + WS_PROJ); bf16_t* mix = (bf16_t*)(P.ws + WS_MIX);
    unsigned char* Ks = c.lds + SW_KS; unsigned char* Vt = c.lds + SW_VT; float* bias_s = (float*)(c.lds + SW_BIAS);
    const int b = item >> 5, n = (item >> 1) & 15, kvh = item & 1;
    const int tok0 = b * SEQ_ + n * 128;
    __syncthreads();
#pragma unroll
    for (int i = 0; i < 4; ++i) { const int idx = c.tid + i * NTHREADS, j = idx >> 3, ch = idx & 7; const bool ok = (n > 0) || (j >= 128);
        u32x4 kv = (u32x4){0u, 0u, 0u, 0u}, vv = kv;
        if (ok) { const bf16_t* rp = proj + (size_t)(tok0 - 128 + j) * NPROJ; kv = *(const u32x4*)(rp + C_AK + kvh * 64 + 8 * ch); vv = *(const u32x4*)(rp + C_AV + kvh * 64 + 8 * ch); }
        *(u32x4*)(Ks + j * SW_KROW + 16 * ch) = kv;
        unsigned short* vt = (unsigned short*)(Vt + (8 * ch) * SW_VROW + 2 * j);
        vt[0 * (SW_VROW / 2)] = (unsigned short)(vv.x & 0xffff); vt[1 * (SW_VROW / 2)] = (unsigned short)(vv.x >> 16);
        vt[2 * (SW_VROW / 2)] = (unsigned short)(vv.y & 0xffff); vt[3 * (SW_VROW / 2)] = (unsigned short)(vv.y >> 16);
        vt[4 * (SW_VROW / 2)] = (unsigned short)(vv.z & 0xffff); vt[5 * (SW_VROW / 2)] = (unsigned short)(vv.z >> 16);
        vt[6 * (SW_VROW / 2)] = (unsigned short)(vv.w & 0xffff); vt[7 * (SW_VROW / 2)] = (unsigned short)(vv.w >> 16); }
    if (c.tid < 144) *(u32x4*)(Ks + 256 * SW_KROW + 16 * c.tid) = (u32x4){0u, 0u, 0u, 0u};
    if (c.tid < 128) { const int d = c.tid >> 1, hf = c.tid & 1; *(u32x4*)(Vt + d * SW_VROW + 512 + 16 * hf) = (u32x4){0u, 0u, 0u, 0u}; }
    if (c.tid < 384) { const int g = c.tid >> 7, dist = c.tid & 127; bias_s[c.tid] = P.in[I_RELB][t5_bucket(dist) * 6 + kvh * 3 + g]; }
    __syncthreads();
    const int lane = c.lane, qc = lane & 15, q4 = lane >> 4, i0 = 16 * c.wave, jw = i0;
    const int iq0 = i0 + qc;
#pragma unroll 1
    for (int g = 0; g < 3; ++g) {
        asm volatile("" ::: "memory");
        int iq = iq0; asm volatile("" : "+v"(iq));
        const int hq = kvh * 3 + g; const float sink = P.in[I_SINKS][l * 6 + hq];
        const bf16_t* qp = proj + (size_t)(tok0 + iq) * NPROJ + C_AQ + hq * 64 + 8 * q4;
        const bf16x8 bq0 = *(const bf16x8*)(qp), bq1 = *(const bf16x8*)(qp + 32);
        f32x4 s[10];
#pragma unroll
        for (int kt = 0; kt < 10; ++kt) { const unsigned char* kp = Ks + (jw + 16 * kt + qc) * SW_KROW + 16 * q4;
            const bf16x8 a0 = *(const bf16x8*)(kp), a1 = *(const bf16x8*)(kp + 64);
            f32x4 acc = (f32x4){0.f, 0.f, 0.f, 0.f};
            acc = __builtin_amdgcn_mfma_f32_16x16x32_bf16(a0, bq0, acc, 0, 0, 0);
            acc = __builtin_amdgcn_mfma_f32_16x16x32_bf16(a1, bq1, acc, 0, 0, 0);
            s[kt] = acc; }
        float m = -1e30f;
#pragma unroll
        for (int kt = 0; kt < 10; ++kt)
#pragma unroll
            for (int r = 0; r < 4; ++r) { const int j = jw + 16 * kt + 4 * q4 + r, dist = iq + 128 - j; const bool ok = (dist >= 0) && (dist < 128) && ((n > 0) || (j >= 128));
                const float v = ok ? s[kt][r] * 0.125f + bias_s[g * 128 + (dist & 127)] : -1e30f; s[kt][r] = v; m = fmaxf(m, v); }
        m = fmaxf(m, __shfl_xor(m, 16)); m = fmaxf(m, __shfl_xor(m, 32)); m = fmaxf(m, sink);
        float sum = 0.f;
#pragma unroll
        for (int kt = 0; kt < 10; ++kt)
#pragma unroll
            for (int r = 0; r < 4; ++r) { const float pv = (s[kt][r] > -1e29f) ? __expf(s[kt][r] - m) : 0.f; s[kt][r] = pv; sum += pv; }
        sum += __shfl_xor(sum, 16); sum += __shfl_xor(sum, 32);
        const float rden = 1.f / (sum + __expf(sink - m));
        f32x4 o[4];
#pragma unroll
        for (int dt = 0; dt < 4; ++dt) o[dt] = (f32x4){0.f, 0.f, 0.f, 0.f};
#pragma unroll
        for (int k5 = 0; k5 < 5; ++k5) {
            u32x4 pw; pw.x = pk2(s[2 * k5][0], s[2 * k5][1]); pw.y = pk2(s[2 * k5][2], s[2 * k5][3]); pw.z = pk2(s[2 * k5 + 1][0], s[2 * k5 + 1][1]); pw.w = pk2(s[2 * k5 + 1][2], s[2 * k5 + 1][3]);
            const bf16x8 pb = __builtin_bit_cast(bf16x8, pw);
#pragma unroll
            for (int dt = 0; dt < 4; ++dt) { const unsigned char* vp = Vt + (16 * dt + qc) * SW_VROW + 2 * (jw + 32 * k5 + 4 * q4);
                const u32x2 lo = *(const u32x2*)(vp), hi = *(const u32x2*)(vp + 32);
                const bf16x8 av = __builtin_bit_cast(bf16x8, (u32x4){lo.x, lo.y, hi.x, hi.y});
                o[dt] = __builtin_amdgcn_mfma_f32_16x16x32_bf16(av, pb, o[dt], 0, 0, 0); } }
        bf16_t* op = mix + (size_t)(tok0 + iq) * 1024 + 256 + hq * 64 + 4 * q4;
#pragma unroll
        for (int dt = 0; dt < 4; ++dt) { u32x2 w; w.x = pk2(o[dt][0] * rden, o[dt][1] * rden); w.y = pk2(o[dt][2] * rden, o[dt][3] * rden); *(u32x2*)(op + 16 * dt) = w; }
    }
}
__device__ __forceinline__ void gdn_prep_tok(const Ctx& c, int l, int t) {
    const Params& P = *c.P; const bf16_t* proj = (const bf16_t*)(P.ws + WS_PROJ); const int lane = c.lane, s = t % SEQ_;
    float* QN = (float*)(P.ws + WS_QN); float* KN = (float*)(P.ws + WS_KN); float* VV = (float*)(P.ws + WS_VV); float* GB = (float*)(P.ws + WS_GB);
    const float* cw = P.in[I_CONVW] + (size_t)l * 4 * 1152;
#pragma unroll 1
    for (int grp = 0; grp < 18; ++grp) { const int ch = grp * 64 + lane; float a = 0.f;
#pragma unroll
        for (int j = 0; j < 4; ++j) { const int sj = s - 3 + j; if (sj >= 0) a += cw[j * 1152 + ch] * bf2f(proj[(size_t)(t - 3 + j) * NPROJ + C_GQ + ch]); }
        a = silu_f(a);
        if (grp < 12) { const float ss = wave_sum(a * a); a = a * (1.f / sqrtf(ss + NORM_EPS_)); }
        if (grp < 6) QN[(size_t)t * 384 + ch] = a * 0.125f;
        else if (grp < 12) KN[(size_t)t * 384 + (ch - 384)] = a;
        else VV[(size_t)t * 384 + (ch - 768)] = a; }
    if (lane < 6) { const float braw = bf2f(proj[(size_t)t * NPROJ + C_GB + lane]), araw = bf2f(proj[(size_t)t * NPROJ + C_GA + lane]);
        const float xx = araw + P.in[I_DTB][l * 6 + lane]; const float sp = xx > 20.f ? xx : log1pf(__expf(xx));
        GB[(size_t)t * 12 + lane] = -__expf(P.in[I_ALOG][l * 6 + lane]) * sp; GB[(size_t)t * 12 + 6 + lane] = sigmoid_f(braw); }
}
__device__ __forceinline__ void ph_mixa(const Ctx& c, int l) {
    for (int tile = c.bid; tile < T_ / 32; tile += c.nblk) pool_tile(c, l, tile);
    for (int it = c.bid; it < NB_ * 16 * 2; it += c.nblk) swa_mfma_item(c, l, it);
    __syncthreads();
    for (int t = c.gw; t < T_; t += c.ngw) gdn_prep_tok(c, l, t);
}
__device__ __forceinline__ void ph_gscan(const Ctx& c) {
    const Params& P = *c.P;
    const float* QN = (const float*)(P.ws + WS_QN); const float* KN = (const float*)(P.ws + WS_KN); const float* VV = (const float*)(P.ws + WS_VV); const float* GB = (const float*)(P.ws + WS_GB);
    float* OR = (float*)(P.ws + WS_OR);
    float* ks = (float*)c.lds; float* qs = ks + 4096; float* vs = qs + 4096; float* gs = vs + 4096; float* bs = gs + 64;
    const int j = c.tid >> 3, p = c.tid & 7;
    for (int item = c.bid; item < NB_ * 6; item += c.nblk) {
        const int b = item / 6, h = item % 6;
        float S[8];
#pragma unroll
        for (int i = 0; i < 8; ++i) S[i] = 0.f;
        for (int ch = 0; ch < SEQ_ / 64; ++ch) {
            const int tb = b * SEQ_ + ch * 64;
            __syncthreads();
            for (int i = c.tid; i < 4096; i += NTHREADS) { const int r = i >> 6, d = i & 63; const size_t g = (size_t)(tb + r) * 384 + h * 64 + d; ks[i] = KN[g]; qs[i] = QN[g]; vs[i] = VV[g]; }
            if (c.tid < 64) { gs[c.tid] = __expf(GB[(size_t)(tb + c.tid) * 12 + h]); bs[c.tid] = GB[(size_t)(tb + c.tid) * 12 + 6 + h]; }
            __syncthreads();
            for (int r = 0; r < 64; ++r) {
                const float eg = gs[r], be = bs[r]; float kk[8], qq[8];
#pragma unroll
                for (int i = 0; i < 8; ++i) { kk[i] = ks[r * 64 + p * 8 + i]; qq[i] = qs[r * 64 + p * 8 + i]; }
                float kS = 0.f;
#pragma unroll
                for (int i = 0; i < 8; ++i) { S[i] *= eg; kS += kk[i] * S[i]; }
                kS += __shfl_xor(kS, 1); kS += __shfl_xor(kS, 2); kS += __shfl_xor(kS, 4);
                const float dl = be * (vs[r * 64 + j] - kS); float o = 0.f;
#pragma unroll
                for (int i = 0; i < 8; ++i) { S[i] += kk[i] * dl; o += qq[i] * S[i]; }
                o += __shfl_xor(o, 1); o += __shfl_xor(o, 2); o += __shfl_xor(o, 4);
                if (p == 0) OR[(size_t)(tb + r) * 384 + h * 64 + j] = o;
            }
        }
    }
}
__device__ __forceinline__ void ph_gout(const Ctx& c, int l) {
    const Params& P = *c.P; const bf16_t* proj = (const bf16_t*)(P.ws + WS_PROJ); bf16_t* mix = (bf16_t*)(P.ws + WS_MIX); const float* OR = (const float*)(P.ws + WS_OR);
    const float nw = P.in[I_NORMW][l * 64 + c.lane];
    for (int t = c.gw; t < T_; t += c.ngw) {
#pragma unroll
        for (int h = 0; h < 6; ++h) { const float o = OR[(size_t)t * 384 + h * 64 + c.lane]; const float ms = wave_sum(o * o) * (1.f / 64.f);
            const float z = bf2f(proj[(size_t)t * NPROJ + C_GZ + h * 64 + c.lane]);
            mix[(size_t)t * 1024 + 640 + h * 64 + c.lane] = (bf16_t)f2bf(o * (1.f / sqrtf(ms + NORM_EPS_)) * nw * silu_f(z)); }
    }
}

__device__ __forceinline__ void ph_ln1(const Ctx& c, int l) {
    const Params& P = *c.P; const float* mod = (const float*)(P.ws + WS_MOD) + (size_t)l * 8 * 6144;
    float* Z = (float*)(P.ws + WS_Z); bf16_t* H2 = (bf16_t*)(P.ws + WS_H2); int* TI = (int*)(P.ws + WS_TOPI); float* TG = (float*)(P.ws + WS_TOPG);
    float* wr = (float*)c.lds;
    const float* rw = P.in[I_RW] + (size_t)l * 1024 * 32;
    for (int i = c.tid; i < 32768; i += NTHREADS) { const int k = i >> 5, e = i & 31; wr[e * 1024 + k] = rw[i]; }
    __syncthreads();
    const float* g = P.in[I_LN1G] + l * 1024; const float* bb = P.in[I_LN1B] + l * 1024; const float* rb = P.in[I_RB] + l * 32;
    for (int t = c.gw; t < T_; t += c.ngw) {
        const int b = t / SEQ_; float* zr = Z + (size_t)t * 1024;
        f32x4 v[4], h[4];
#pragma unroll
        for (int j = 0; j < 4; ++j) v[j] = *(const f32x4*)(zr + 4 * c.lane + 256 * j);
        ln_rows(v, g, bb, c.lane);
        { float* xr = (float*)(P.ws + WS_X1) + (size_t)t * 1024;
#pragma unroll
        for (int j = 0; j < 4; ++j) *(f32x4*)(xr + 4 * c.lane + 256 * j) = v[j]; }
        modulate(h, v, mod + (size_t)b * 6144 + 3072, mod + (size_t)b * 6144 + 4096, c.lane);
        store_bf16_row(H2 + (size_t)t * 1024, c.lane, h);
        float mylg = -3.0e38f;
#pragma unroll 2
        for (int e = 0; e < 32; ++e) { float a = 0.f;
#pragma unroll
            for (int j = 0; j < 4; ++j) { const f32x4 w = *(const f32x4*)(wr + e * 1024 + 4 * c.lane + 256 * j); a += (h[j][0] * w[0] + h[j][1] * w[1]) + (h[j][2] * w[2] + h[j][3] * w[3]); }
            const float s = wave_sum(a) + rb[e]; if (c.lane == e) mylg = s; }
        int bi[4]; float bv[4];
#pragma unroll
        for (int k = 0; k < 4; ++k) { const float best = wave_max(mylg); const unsigned long long bal = __ballot(mylg == best); const int id = __ffsll((long long)bal) - 1;
            if (c.lane == id) mylg = -3.0e38f;
            bi[k] = id; bv[k] = best; }
        const float e1 = __expf(bv[1] - bv[0]), e2 = __expf(bv[2] - bv[0]), e3 = __expf(bv[3] - bv[0]), inv = 1.f / (1.f + e1 + e2 + e3);
        if (c.lane == 0) { *(int4*)(TI + (size_t)t * 4) = make_int4(bi[0], bi[1], bi[2], bi[3]); *(f32x4*)(TG + (size_t)t * 4) = (f32x4){inv, e1 * inv, e2 * inv, e3 * inv}; }
    }
    __syncthreads();
}

__device__ __forceinline__ void ph_routea(const Ctx& c) {
    const Params& P = *c.P; const int* TI = (const int*)(P.ws + WS_TOPI); int* R = (int*)(P.ws + WS_ROUTE);
    int* hist = (int*)c.lds;
    for (int seg = c.bid; seg < 256; seg += c.nblk) {
        if (c.tid < 32) hist[c.tid] = 0;
        __syncthreads();
        if (c.tid < 256) atomicAdd(&hist[TI[seg * 256 + c.tid]], 1);
        __syncthreads();
        if (c.tid < 32) R[R_COUNTS + seg * 32 + c.tid] = hist[c.tid];
        __syncthreads();
    }
}
__device__ __forceinline__ void ph_routeb(const Ctx& c) {
    const Params& P = *c.P; const int* TI = (const int*)(P.ws + WS_TOPI); int* R = (int*)(P.ws + WS_ROUTE);
    int* tot = (int*)c.lds; int* off = tot + 32; int* pst = off + 32; int* eid = pst + 64;
    for (int seg = c.bid; seg < 256; seg += c.nblk) {
        if (c.tid < 32) { int a = 0, o = 0; for (int s2 = 0; s2 < 256; ++s2) { const int v = R[R_COUNTS + s2 * 32 + c.tid]; a += v; if (s2 < seg) o += v; } tot[c.tid] = a; off[c.tid] = o; }
        if (c.tid < 256) eid[c.tid] = TI[seg * 256 + c.tid];
        __syncthreads();
        if (c.tid == 0) { int ps = 0; for (int e = 0; e < 32; ++e) { pst[e] = ps; ps += ((tot[e] + 255) >> 8) << 8; } pst[32] = ps; }
        __syncthreads();
        if (c.tid < 256) { const int e = eid[c.tid]; int rank = 0; for (int q = 0; q < c.tid; ++q) rank += (eid[q] == e) ? 1 : 0;
            R[R_ROWTOK + pst[e] + off[e] + rank] = seg * 256 + c.tid; }
        if (seg == 0) {
            for (int e = 0; e < 32; ++e) { const int lo = pst[e] + tot[e], hi = pst[e + 1]; for (int q = lo + c.tid; q < hi; q += NTHREADS) R[R_ROWTOK + q] = -1; }
            const int nrb = pst[32] >> 8;
            for (int rb = c.tid; rb < nrb; rb += NTHREADS) { int e = 0; for (int q = 1; q < 32; ++q) if ((rb << 8) >= pst[q]) e = q; R[R_BLKE + rb] = e; }
            if (c.tid == 0) R[R_NRB] = nrb;
        }
        __syncthreads();
    }
}
__device__ __forceinline__ void ph_gather(const Ctx& c) {
    const Params& P = *c.P; const int* R = (const int*)(P.ws + WS_ROUTE); const bf16_t* H2 = (const bf16_t*)(P.ws + WS_H2); bf16_t* XB = (bf16_t*)(P.ws + WS_XBUF);
    const int nrows = R[R_NRB] * 256;
    for (int r = c.gw; r < nrows; r += c.ngw) { const int a = R[R_ROWTOK + r];
        u32x4 v0 = (u32x4){0u, 0u, 0u, 0u}, v1 = v0;
        if (a >= 0) { const bf16_t* src = H2 + (size_t)(a >> 2) * 1024; v0 = *(const u32x4*)(src + 8 * c.lane); v1 = *(const u32x4*)(src + 512 + 8 * c.lane); }
        *(u32x4*)(XB + (size_t)r * 1024 + 8 * c.lane) = v0; *(u32x4*)(XB + (size_t)r * 1024 + 512 + 8 * c.lane) = v1; }
}

__device__ __forceinline__ void ph_combine(const Ctx& c, int l) {
    const Params& P = *c.P; const float* mod = (const float*)(P.ws + WS_MOD) + (size_t)l * 8 * 6144;
    const float* X1 = (const float*)(P.ws + WS_X1); const bf16_t* Y4 = (const bf16_t*)(P.ws + WS_Y4); const float* TG = (const float*)(P.ws + WS_TOPG);
    float* XO = (l == DEPTH_ - 1) ? P.out : (float*)(P.ws + WS_X); bf16_t* H = (bf16_t*)(P.ws + WS_H);
    const float* g = P.in[I_LN2G] + l * 1024; const float* bb = P.in[I_LN2B] + l * 1024;
    for (int t = c.gw; t < T_; t += c.ngw) {
        const int b = t / SEQ_; const f32x4 gt = *(const f32x4*)(TG + (size_t)t * 4);
        f32x4 v[4];
#pragma unroll
        for (int j = 0; j < 4; ++j) { const int col = 4 * c.lane + 256 * j; f32x4 y = (f32x4){0.f, 0.f, 0.f, 0.f};
#pragma unroll
            for (int k = 0; k < 4; ++k) { const u32x2 w = *(const u32x2*)(Y4 + (size_t)(t * 4 + k) * 1024 + col); y += gt[k] * (f32x4){bflo(w.x), bfhi(w.x), bflo(w.y), bfhi(w.y)}; }
            const f32x4 x1 = *(const f32x4*)(X1 + (size_t)t * 1024 + col), g2 = *(const f32x4*)(mod + (size_t)b * 6144 + 5120 + col);
            v[j] = x1 * ALPHA_ + g2 * y; }
        ln_rows(v, g, bb, c.lane);
#pragma unroll
        for (int j = 0; j < 4; ++j) *(f32x4*)(XO + (size_t)t * 1024 + 4 * c.lane + 256 * j) = v[j];
        if (l + 1 < DEPTH_) { const float* m2 = (const float*)(P.ws + WS_MOD) + (size_t)(l + 1) * 8 * 6144 + (size_t)b * 6144; f32x4 h[4];
            modulate(h, v, m2, m2 + 1024, c.lane); store_bf16_row(H + (size_t)t * 1024, c.lane, h); }
    }
}

#define XB_TMO      128
#define XB_XCNT(j)  (256  + 64 * (j))
#define XB_XSUB(j)  (1280 + 64 * (j))
#define XB_XGEN(j)  (2304 + 64 * (j))
#define XB_TOP      3328
#define XB_TOPGEN   3392
#define XCD_BAR_WORDS 3456
#define XB_SPIN_CAP (1u << 18)
constexpr int CW_BAR = 4096;
constexpr int MISC_OFF = LDS_BYTES - 256;
__device__ __forceinline__ unsigned xb_ld(unsigned* p)              { return __hip_atomic_load(p, __ATOMIC_RELAXED, __HIP_MEMORY_SCOPE_AGENT); }
__device__ __forceinline__ unsigned xb_add(unsigned* p, unsigned v) { return __hip_atomic_fetch_add(p, v, __ATOMIC_RELAXED, __HIP_MEMORY_SCOPE_AGENT); }
__device__ __forceinline__ unsigned xb_xcc_id() { return (unsigned)__builtin_amdgcn_s_getreg((3 << 11) | 20) & 0xFu; }
#define XB_SPIN(cond, bar) do { unsigned _sp = 0; while (cond) { __builtin_amdgcn_s_sleep(1); \
    if ((++_sp & 255u) == 0u) { if (xb_ld(&(bar)[XB_TMO])) break; if (_sp > XB_SPIN_CAP) { atomicAdd(&(bar)[XB_TMO], 1u); break; } } } } while (0)
struct XcdBarrier { unsigned* bar; unsigned x; volatile LAS unsigned* st; };
__device__ __forceinline__ XcdBarrier xcd_barrier_post(unsigned* bar, volatile LAS unsigned* st) {
    XcdBarrier b; b.bar = bar; b.x = xb_xcc_id(); b.st = st;
    if (threadIdx.x == 0) (void)xb_add(&bar[XB_XCNT(b.x)], 1u);
    return b;
}
__device__ __forceinline__ void xcd_barrier_complete(unsigned* bar, unsigned x, unsigned& nloc, unsigned& nx) {
    const unsigned G = gridDim.x * gridDim.y * gridDim.z;
    unsigned sum, cnt, mine, sp = 0u;
    for (;;) {
        sum = 0u; cnt = 0u; mine = 0u;
#pragma unroll
        for (unsigned j = 0; j < 16; ++j) { const unsigned c = xb_ld(&bar[XB_XCNT(j)]); sum += c; cnt += (c > 0u) ? 1u : 0u; mine = (j == x) ? c : mine; }
        if (sum == G) break;
        __builtin_amdgcn_s_sleep(1);
        if ((++sp & 255u) == 0u) { if (xb_ld(&bar[XB_TMO])) break; if (sp > XB_SPIN_CAP) { atomicAdd(&bar[XB_TMO], 1u); break; } }
    }
    nloc = mine > 0u ? mine : 1u; nx = cnt > 0u ? cnt : 1u;
}
__device__ __forceinline__ void xcd_barrier(const XcdBarrier& b) {
    asm volatile("s_waitcnt vmcnt(0)" ::: "memory");
    __syncthreads();
    if (threadIdx.x == 0) {
        unsigned* bar = b.bar;
        __builtin_amdgcn_s_waitcnt(0);
        unsigned nloc = b.st[0], nx = b.st[1];
        if (nloc == 0u) { xcd_barrier_complete(bar, b.x, nloc, nx); b.st[0] = nloc; b.st[1] = nx; }
        const unsigned old = xb_add(&bar[XB_XSUB(b.x)], 1u);
        const unsigned gen = old / nloc;
        if (old + 1u == (gen + 1u) * nloc) {
            __builtin_amdgcn_fence(__ATOMIC_RELEASE, "agent");
            asm volatile("s_waitcnt vmcnt(0)" ::: "memory");
            const unsigned og = xb_add(&bar[XB_TOP], 1u);
            const unsigned tg = og / nx;
            if (og + 1u == (tg + 1u) * nx) xb_add(&bar[XB_TOPGEN], 1u);
            else XB_SPIN(xb_ld(&bar[XB_TOPGEN]) == tg, bar);
            __builtin_amdgcn_fence(__ATOMIC_ACQUIRE, "agent");
            xb_add(&bar[XB_XGEN(b.x)], 1u);
            asm volatile("s_waitcnt vmcnt(0)" ::: "memory");
        } else {
            XB_SPIN(xb_ld(&bar[XB_XGEN(b.x)]) == gen, bar);
            __builtin_amdgcn_fence(__ATOMIC_ACQUIRE, "agent");
            asm volatile("s_waitcnt vmcnt(0)" ::: "memory");
        }
    }
    __syncthreads();
}

template <int KIND>
__device__ __forceinline__ void run_kind(const Ctx& c0, int l) {
    Ctx c = c0;
    { int t = c0.tid; asm volatile("" : "+v"(t)); c.tid = t; c.lane = t & 63; c.wave = __builtin_amdgcn_readfirstlane(t >> 6); }
    { int b = c0.bid, n = c0.nblk; asm volatile("" : "+s"(b), "+s"(n)); c.bid = b; c.nblk = n; c.gw = b * NWAVES + c.wave; c.ngw = n * NWAVES; }
    { long z = 0; asm volatile("" : "+s"(z)); c.P = (const Params*)((const char*)c0.P + z); }
    const Params& P = *c.P; LAS unsigned char* lds3 = (LAS unsigned char*)c.lds;
    const int* R = (const int*)(P.ws + WS_ROUTE);
    if constexpr (KIND == 0) ph_conv(c);
    else if constexpr (KIND == 1) ph_mod(c);
    else if constexpr (KIND == 2) ph_prep0(c);
    else if constexpr (KIND == 3 + L_GEMM1) { DenseSched S{(const char*)(P.ws + WS_H), (const char*)(P.ws + WS_WIN) + (size_t)l * NPROJ * 2048, T_ / 256, NPROJ / 256, c.nblk, c.bid};
        EpiStoreBf16 E{(bf16_t*)(P.ws + WS_PROJ), NPROJ};
        pg8::gemm_phase<EpiStoreBf16, DenseSched, true, true>(lds3, S, E, c.tid); }
    else if constexpr (KIND == 3 + L_MIXA) ph_mixa(c, l);
    else if constexpr (KIND == 3 + L_GSCAN) ph_gscan(c);
    else if constexpr (KIND == 3 + L_GOUT) ph_gout(c, l);
    else if constexpr (KIND == 3 + L_GEMM2) { DenseSched S{(const char*)(P.ws + WS_MIX), (const char*)(P.ws + WS_WOUT) + (size_t)l * 1024 * 2048, T_ / 256, 4, c.nblk, c.bid};
        EpiResid E{l == 0 ? P.in[I_X] : (const float*)(P.ws + WS_X), (const float*)(P.ws + WS_MOD) + (size_t)l * 8 * 6144 + 2048, (float*)(P.ws + WS_Z)};
        pg8::gemm_phase<EpiResid, DenseSched, true, true>(lds3, S, E, c.tid); }
    else if constexpr (KIND == 3 + L_LN1) ph_ln1(c, l);
    else if constexpr (KIND == 3 + L_ROUTEA) ph_routea(c);
    else if constexpr (KIND == 3 + L_ROUTEB) ph_routeb(c);
    else if constexpr (KIND == 3 + L_GATHER) ph_gather(c);
    else if constexpr (KIND == 3 + L_UP) { MoeSched S{(const char*)(P.ws + WS_XBUF), (const char*)(P.ws + WS_WUP) + (size_t)l * 32 * 2048 * 2048, R + R_BLKE, R[R_NRB], 8, c.nblk, c.bid, (size_t)2048 * 2048};
        EpiSwiglu E{(bf16_t*)(P.ws + WS_ACT), P.in[I_BUP] + (size_t)l * 32 * 2048};
        pg8::gemm_phase<EpiSwiglu, MoeSched, true, true>(lds3, S, E, c.tid); }
    else if constexpr (KIND == 3 + L_DOWN) { MoeSched S{(const char*)(P.ws + WS_ACT), (const char*)(P.ws + WS_WDN) + (size_t)l * 32 * 1024 * 2048, R + R_BLKE, R[R_NRB], 4, c.nblk, c.bid, (size_t)1024 * 2048};
        EpiDown E{(bf16_t*)(P.ws + WS_Y4), P.in[I_BDN] + (size_t)l * 32 * 1024, R + R_ROWTOK};
        pg8::gemm_phase<EpiDown, MoeSched, true, true>(lds3, S, E, c.tid); }
    else if constexpr (KIND == 3 + L_COMBINE) ph_combine(c, l);
}

#define SEAM() xcd_barrier(bar)
#ifndef PROBE_KIND
#define PROBE_KIND -1
#endif
#define RK(K, L) do { run_kind<K>(c, L); if ((K) == PROBE_KIND && (L) == 0) { SEAM(); run_kind<K>(c, L); } } while (0)
template <int L> __device__ __forceinline__ void run_layer(const Ctx& c, const XcdBarrier& bar) {
    RK(3 + L_GEMM1, L); SEAM();
    RK(3 + L_MIXA, L); SEAM();
    RK(3 + L_GSCAN, L); SEAM();
    RK(3 + L_GOUT, L); SEAM();
    RK(3 + L_GEMM2, L); SEAM();
    RK(3 + L_LN1, L); SEAM();
    RK(3 + L_ROUTEA, L); SEAM();
    RK(3 + L_ROUTEB, L); SEAM();
    RK(3 + L_GATHER, L); SEAM();
    RK(3 + L_UP, L); SEAM();
    RK(3 + L_DOWN, L); SEAM();
    RK(3 + L_COMBINE, L);
}
__global__ void __launch_bounds__(NTHREADS, 2) mk_fwd(Params P) {
    extern __shared__ __attribute__((aligned(16))) unsigned char lds[];
    Ctx c; c.P = &P; c.lds = lds; c.tid = threadIdx.x; c.lane = c.tid & 63; c.wave = __builtin_amdgcn_readfirstlane(c.tid >> 6);
    c.bid = blockIdx.x; c.nblk = gridDim.x; c.gw = c.bid * NWAVES + c.wave; c.ngw = c.nblk * NWAVES;
    for (int u = c.tid; u < 64; u += NTHREADS) ((volatile LAS unsigned*)((LAS unsigned char*)lds + MISC_OFF))[u] = 0u;
    __syncthreads();
    const XcdBarrier bar = xcd_barrier_post((unsigned*)(P.ws + WS_CTL) + CW_BAR, (volatile LAS unsigned*)((LAS unsigned char*)lds + MISC_OFF) + 8);
    RK(0, 0); __syncthreads(); RK(1, 0); SEAM();
    RK(2, 0); SEAM();
    run_layer<0>(c, bar); SEAM();
    run_layer<1>(c, bar);
}

extern "C" void kernel_launch(void* const* d_in, const int* in_sizes, int n_in, void* d_out, int out_size, void* d_ws, size_t ws_size, hipStream_t stream) {
    static int grid = 0;
    if (grid == 0) {
        if (n_in != N_IN || out_size != T_ * D_ || ws_size < WS_END) { fprintf(stderr, "kernel_launch: unexpected shapes (n_in %d out %d ws %zu need %zu)\n", n_in, out_size, ws_size, (size_t)WS_END); grid = -1; return; }
        int dev = 0, cus = 0, per_cu = 0;
        (void)hipGetDevice(&dev); (void)hipDeviceGetAttribute(&cus, hipDeviceAttributeMultiprocessorCount, dev);
        (void)hipFuncSetAttribute((const void*)mk_fwd, hipFuncAttributeMaxDynamicSharedMemorySize, LDS_BYTES);
        if (hipOccupancyMaxActiveBlocksPerMultiprocessor(&per_cu, (const void*)mk_fwd, NTHREADS, LDS_BYTES) != hipSuccess || per_cu < 1) { fprintf(stderr, "kernel_launch: occupancy query says %d blocks/CU\n", per_cu); (void)hipGetLastError(); grid = -1; return; }
        grid = cus > 0 ? cus : 256;
    }
    if (grid < 0) return;
    (void)hipMemsetAsync((char*)d_ws + WS_CTL, 0, 1 * MiB, stream);
    Params p{};
    for (int i = 0; i < N_IN; ++i) p.in[i] = (const float*)d_in[i];
    p.out = (float*)d_out; p.ws = (unsigned char*)d_ws;
    void* args[] = {&p};
    hipError_t e = hipLaunchCooperativeKernel((const void*)mk_fwd, dim3(grid), dim3(NTHREADS), args, LDS_BYTES, stream);
    if (e != hipSuccess) fprintf(stderr, "cooperative launch failed: %s (grid %d)\n", hipGetErrorString(e), grid);
}
```

```cpp
#include <hip/hip_runtime.h>
#include <hip/hip_cooperative_groups.h>
#include <cstdio>
#include <cstdint>
namespace cg = cooperative_groups;

#define LAS __attribute__((address_space(3)))
typedef unsigned short bf16_t;
typedef short bf16x8 __attribute__((ext_vector_type(8)));
typedef float f32x4 __attribute__((ext_vector_type(4)));
typedef float f32x2 __attribute__((ext_vector_type(2)));
typedef unsigned u32x4 __attribute__((ext_vector_type(4)));
typedef unsigned u32x2 __attribute__((ext_vector_type(2)));

constexpr int T_ = 16384, D_ = 1024, NB_ = 8, SEQ_ = 2048, DEPTH_ = 2;
constexpr int IN_DIM = 2444, NPROJ = 2560;
constexpr int C_POOL = 0, C_AQ = 256, C_AK = 640, C_AV = 768, C_GQ = 896, C_GK = 1280, C_GV = 1664, C_GZ = 2048, C_GB = 2432, C_GA = 2438;
constexpr int NE_ = 32, TOPK_ = 4, NASSIGN = T_ * TOPK_, NRB_MAX = NASSIGN / 256 + NE_, PROWS = NRB_MAX * 256;
constexpr float ALPHA_ = 1.41421356237309515f;
constexpr float LN_EPS_ = 1e-5f, NORM_EPS_ = 1e-6f;
constexpr int NTHREADS = 512, NWAVES = 8;
constexpr int LDS_BYTES = 147456;

constexpr size_t MiB = 1u << 20;
constexpr size_t WS_CTL = 0;
constexpr size_t WS_MOD = 1 * MiB;
constexpr size_t WS_ROUTE = 2 * MiB;
constexpr size_t WS_WIN = 4 * MiB;
constexpr size_t WS_WOUT = 14 * MiB;
constexpr size_t WS_WUP = 18 * MiB;
constexpr size_t WS_WDN = WS_WUP + 256 * MiB;
constexpr size_t WS_H = WS_WDN + 128 * MiB;
constexpr size_t WS_H2 = WS_H + 32 * MiB;
constexpr size_t WS_PROJ = WS_H2 + 32 * MiB;
constexpr size_t WS_MIX = WS_PROJ + 80 * MiB;
constexpr size_t WS_Z = WS_MIX + 32 * MiB;
constexpr size_t WS_X = WS_Z + 64 * MiB;
constexpr size_t WS_QN = WS_X + 64 * MiB;
constexpr size_t WS_KN = WS_QN + 24 * MiB;
constexpr size_t WS_VV = WS_KN + 24 * MiB;
constexpr size_t WS_OR = WS_VV + 24 * MiB;
constexpr size_t WS_GB = WS_OR + 24 * MiB;
constexpr size_t WS_TOPI = WS_GB + 1 * MiB;
constexpr size_t WS_TOPG = WS_TOPI + 1 * MiB;
constexpr size_t WS_XBUF = WS_TOPG + 1 * MiB;
constexpr size_t WS_ACT = WS_XBUF + 144 * MiB;
constexpr size_t WS_Y4 = WS_ACT + 144 * MiB;
constexpr size_t WS_X1 = WS_Y4 + 128 * MiB;
constexpr size_t WS_END = WS_X1 + 64 * MiB;
constexpr int R_COUNTS = 0;
constexpr int R_BLKE = 8192;
constexpr int R_NRB = 8192 + 512;
constexpr int R_ROWTOK = 16384;

__device__ __forceinline__ unsigned f2bf(float f) { unsigned u = __builtin_bit_cast(unsigned, f); return (u + 0x7fffu + ((u >> 16) & 1u)) >> 16; }
__device__ __forceinline__ unsigned pk2(float lo, float hi) { return f2bf(lo) | (f2bf(hi) << 16); }
__device__ __forceinline__ float bf2f(unsigned short b) { return __builtin_bit_cast(float, (unsigned)b << 16); }
__device__ __forceinline__ float bflo(unsigned w) { return __builtin_bit_cast(float, w << 16); }
__device__ __forceinline__ float bfhi(unsigned w) { return __builtin_bit_cast(float, w & 0xffff0000u); }
__device__ __forceinline__ float wave_sum(float v) {
#pragma unroll
    for (int o = 1; o < 64; o <<= 1) v += __shfl_xor(v, o);
    return v;
}
__device__ __forceinline__ float wave_max(float v) {
#pragma unroll
    for (int o = 1; o < 64; o <<= 1) v = fmaxf(v, __shfl_xor(v, o));
    return v;
}
__device__ __forceinline__ float silu_f(float x) { return x / (1.f + __expf(-x)); }
__device__ __forceinline__ float sigmoid_f(float x) { return 1.f / (1.f + __expf(-x)); }

namespace pg8 {
constexpr int BM = 256, BK = 64, HALF = 128, HTB = HALF * BK * 2, STAGE_BYTES = 8 * HTB, NXCD = 8, WGM = 8, KD = 1024;
__host__ __device__ __forceinline__ int lds_byte(int r, int c) { const int st = (r >> 4) * 2 + (c >> 5), rr = r & 15, cc = c & 31, ob = rr * 64 + cc * 2; return st * 1024 + (ob ^ (((ob >> 9) & 1) << 5)); }
__host__ __device__ __forceinline__ void stage_rc(int b, int& R, int& C) { const int st = b / 1024, sb = b % 1024, swz = sb ^ (((sb >> 9) & 1) << 5); R = (st >> 1) * 16 + swz / 64; C = (st & 1) * 32 + (swz % 64) / 2; }
__host__ __device__ __forceinline__ int perm32(int rho) { const int n = rho >> 4, i = rho & 15; return 8 * (i >> 2) + 4 * n + (i & 3); }

struct Unit { int pm, pn, e; const char* a; const char* b; };

__device__ __forceinline__ void tile_of(int L, int nM, int nN, int& pm, int& pn) {
    const int nwg = nM * nN; int wgid = L;
    { const int q = nwg / NXCD, r = nwg % NXCD, xcd = wgid % NXCD, off = wgid / NXCD; wgid = (xcd < r ? xcd * (q + 1) : r * (q + 1) + (xcd - r) * q) + off; }
    const int nig = WGM * nN, gid = wgid / nig, fm = gid * WGM, gsz = (nM - fm) < WGM ? (nM - fm) : WGM;
    pm = fm + ((wgid % nig) % gsz); pn = (wgid % nig) / gsz;
}

__device__ __forceinline__ unsigned cvt_pk_bf16(float lo, float hi) { unsigned r; asm volatile("v_cvt_pk_bf16_f32 %0, %1, %2" : "=v"(r) : "v"(lo), "v"(hi)); return r; }

template <class Epi, class Sched, bool ALIGN_EPI, bool SP2>
__device__ __forceinline__ void gemm_phase(LAS unsigned char* lds, const Sched& S, const Epi& E, const int tid) {
    const int wid = __builtin_amdgcn_readfirstlane(tid >> 6), lane = tid & 63, wr = wid >> 2, wc = wid & 3, fr = lane & 15, fq = lane >> 4;
    constexpr int K = KD, nt = K / BK;
    unsigned voffA[2], voffB[2];
#pragma unroll
    for (int i = 0; i < 2; ++i) { int R, C; stage_rc(tid * 16 + i * 8192, R, C); const int Rb = Epi::PERM ? ((R & ~31) + perm32(R & 31)) : R;
        voffA[i] = (unsigned)(R * K + C) * 2u; voffB[i] = (unsigned)(Rb * K + C) * 2u; }
    const size_t kstep = (size_t)(BK * 2);
    const size_t hstep = (size_t)HALF * K * 2;
    const unsigned ldsw = (unsigned)wid * 1024u;
    const int aoff = lds_byte(wr * 64 + fr, fq * 8), boff = lds_byte(wc * 32 + fr, fq * 8);
#define PG8_SA(b, h) (((b) * 2 + (h)) * HTB)
#define PG8_SB(b, h) ((4 + (b) * 2 + (h)) * HTB)
#define PG8_STAGE(bufoff, gbase, voff) do { _Pragma("unroll") for (int _i = 0; _i < 2; ++_i) \
        __builtin_amdgcn_global_load_lds((const unsigned*)((const char*)(gbase) + (voff)[_i]), (LAS unsigned*)(lds + (bufoff) + ldsw + _i * 8192), 16, 0, 0); } while (0)
#define PG8_LDA(dst, b, h) do { _Pragma("unroll") for (int m = 0; m < 4; ++m) _Pragma("unroll") for (int k = 0; k < 2; ++k) dst[m][k] = *(const LAS bf16x8*)(lds + PG8_SA(b, h) + aoff + m * 2048 + k * 1024); } while (0)
#define PG8_LDB(dst, b, h) do { _Pragma("unroll") for (int n = 0; n < 2; ++n) _Pragma("unroll") for (int k = 0; k < 2; ++k) dst[n][k] = *(const LAS bf16x8*)(lds + PG8_SB(b, h) + boff + n * 2048 + k * 1024); } while (0)
#define PG8_MMA(ai, bj, At, Bt) do { __builtin_amdgcn_s_setprio(1); _Pragma("unroll") for (int m = 0; m < 4; ++m) _Pragma("unroll") for (int n = 0; n < 2; ++n) _Pragma("unroll") for (int k = 0; k < 2; ++k) \
        acc[ai][bj][m][n] = __builtin_amdgcn_mfma_f32_16x16x32_bf16(Bt[n][k], At[m][k], acc[ai][bj][m][n], 0, 0, 0); __builtin_amdgcn_s_setprio(0); } while (0)
#define PG8_WAIT_V(n) asm volatile("s_waitcnt vmcnt(" #n ")" ::: "memory")
#define PG8_WAIT_L(n) asm volatile("s_waitcnt lgkmcnt(" #n ")" ::: "memory")
#define PG8_BAR __builtin_amdgcn_s_barrier()
#define PG8_SCHED __builtin_amdgcn_sched_barrier(0)
    Unit cur, nxt; int ui = 0;
    if (!S.next(0, cur)) return;
    f32x4 acc[2][2][4][2];
#pragma unroll
    for (int a = 0; a < 2; ++a)
#pragma unroll
        for (int b = 0; b < 2; ++b)
#pragma unroll
            for (int m = 0; m < 4; ++m)
#pragma unroll
                for (int n = 0; n < 2; ++n) acc[a][b][m][n] = (f32x4){0.f, 0.f, 0.f, 0.f};
    bf16x8 At[4][2], B0[2][2], B1[2][2];
    const char* cA = cur.a; const char* cB = cur.b;
    if constexpr (SP2) {
        PG8_STAGE(PG8_SB(0, 0), cB, voffB); PG8_STAGE(PG8_SB(0, 1), cB + hstep, voffB); PG8_STAGE(PG8_SA(0, 0), cA, voffA); PG8_STAGE(PG8_SA(0, 1), cA + hstep, voffA);
        if (wr == 1) PG8_BAR;
        PG8_WAIT_V(2); PG8_BAR;
        PG8_STAGE(PG8_SB(1, 0), cB + kstep, voffB); PG8_STAGE(PG8_SA(1, 0), cA + kstep, voffA); PG8_STAGE(PG8_SB(1, 1), cB + hstep + kstep, voffB);
        PG8_WAIT_V(6); PG8_BAR;
    } else {
        PG8_STAGE(PG8_SB(0, 0), cB, voffB); PG8_STAGE(PG8_SA(0, 0), cA, voffA); PG8_STAGE(PG8_SB(0, 1), cB + hstep, voffB); PG8_STAGE(PG8_SA(0, 1), cA + hstep, voffA);
        if (wr == 1) PG8_BAR;
        PG8_WAIT_V(4); PG8_BAR;
        PG8_STAGE(PG8_SB(1, 0), cB + kstep, voffB); PG8_STAGE(PG8_SA(1, 0), cA + kstep, voffA); PG8_STAGE(PG8_SB(1, 1), cB + hstep + kstep, voffB);
        PG8_WAIT_V(6); PG8_BAR;
    }
    for (;;) {
        const bool has_next = S.next(ui + 1, nxt);
        const char* nA = has_next ? nxt.a : cA; const char* nB = has_next ? nxt.b : cB;
        for (int t = 0; t < nt; t += 2) {
            const bool last = (t == nt - 2);
            const char* a1 = cA + (size_t)(t + 1) * kstep;
            const char* a2 = last ? nA : cA + (size_t)(t + 2) * kstep; const char* b2 = last ? nB : cB + (size_t)(t + 2) * kstep;
            const char* a3 = a2 + kstep; const char* b3 = b2 + kstep;
            if constexpr (SP2) {
            PG8_LDB(B0, 0, 0); PG8_LDB(B1, 0, 1); PG8_SCHED; PG8_LDA(At, 0, 0); PG8_STAGE(PG8_SA(1, 1), a1 + hstep, voffA);
            PG8_WAIT_V(8); PG8_WAIT_L(0); PG8_BAR; PG8_MMA(0, 0, At, B0); PG8_MMA(0, 1, At, B1); PG8_BAR; PG8_SCHED;
            PG8_LDA(At, 0, 1); PG8_STAGE(PG8_SB(0, 0), b2, voffB); PG8_STAGE(PG8_SB(0, 1), b2 + hstep, voffB); PG8_STAGE(PG8_SA(0, 0), a2, voffA);
            PG8_WAIT_V(8); PG8_WAIT_L(0); PG8_BAR; PG8_MMA(1, 0, At, B0); PG8_MMA(1, 1, At, B1); PG8_BAR; PG8_SCHED;
            PG8_LDB(B0, 1, 0); PG8_LDB(B1, 1, 1); PG8_SCHED; PG8_LDA(At, 1, 0); PG8_STAGE(PG8_SA(0, 1), a2 + hstep, voffA);
            PG8_WAIT_V(8); PG8_WAIT_L(0); PG8_BAR; PG8_MMA(0, 0, At, B0); PG8_MMA(0, 1, At, B1); PG8_BAR; PG8_SCHED;
            PG8_LDA(At, 1, 1); PG8_STAGE(PG8_SB(1, 0), b3, voffB); PG8_STAGE(PG8_SB(1, 1), b3 + hstep, voffB); PG8_STAGE(PG8_SA(1, 0), a3, voffA);
            PG8_WAIT_V(8); PG8_WAIT_L(0); PG8_BAR; PG8_MMA(1, 0, At, B0); PG8_MMA(1, 1, At, B1); PG8_BAR; PG8_SCHED;
            } else {
            PG8_LDB(B0, 0, 0); PG8_SCHED; PG8_LDA(At, 0, 0); PG8_STAGE(PG8_SA(1, 1), a1 + hstep, voffA);
            PG8_WAIT_L(8); PG8_BAR; PG8_WAIT_L(0); PG8_MMA(0, 0, At, B0); PG8_BAR; PG8_SCHED;
            PG8_LDB(B1, 0, 1); PG8_STAGE(PG8_SB(0, 0), b2, voffB);
            PG8_BAR; PG8_WAIT_L(0); PG8_MMA(0, 1, At, B1); PG8_BAR;
            PG8_LDA(At, 0, 1); PG8_STAGE(PG8_SA(0, 0), a2, voffA);
            PG8_BAR; PG8_WAIT_L(0); PG8_MMA(1, 0, At, B0); PG8_BAR; PG8_SCHED;
            PG8_STAGE(PG8_SB(0, 1), b2 + hstep, voffB);
            PG8_WAIT_V(6); PG8_BAR; PG8_MMA(1, 1, At, B1); PG8_BAR;
            PG8_LDB(B0, 1, 0); PG8_SCHED; PG8_LDA(At, 1, 0); PG8_STAGE(PG8_SA(0, 1), a2 + hstep, voffA);
            PG8_WAIT_L(8); PG8_BAR; PG8_WAIT_L(0); PG8_MMA(0, 0, At, B0); PG8_BAR; PG8_SCHED;
            PG8_LDB(B1, 1, 1); PG8_STAGE(PG8_SB(1, 0), b3, voffB);
            PG8_BAR; PG8_WAIT_L(0); PG8_MMA(0, 1, At, B1); PG8_BAR;
            PG8_LDA(At, 1, 1); PG8_STAGE(PG8_SA(1, 0), a3, voffA);
            PG8_BAR; PG8_WAIT_L(0); PG8_MMA(1, 0, At, B0); PG8_BAR; PG8_SCHED;
            PG8_STAGE(PG8_SB(1, 1), b3 + hstep, voffB);
            PG8_WAIT_V(6); PG8_BAR; PG8_MMA(1, 1, At, B1); PG8_BAR;
            }
        }
        if constexpr (ALIGN_EPI) { if (wr == 0) PG8_BAR; }
        E(acc, cur, wr, wc, fr, fq);
        if (!has_next) break;
#pragma unroll
        for (int a = 0; a < 2; ++a)
#pragma unroll
            for (int b = 0; b < 2; ++b)
#pragma unroll
                for (int m = 0; m < 4; ++m)
#pragma unroll
                    for (int n = 0; n < 2; ++n) acc[a][b][m][n] = (f32x4){0.f, 0.f, 0.f, 0.f};
        cur = nxt; cA = nA; cB = nB; ++ui;
        if constexpr (ALIGN_EPI) { if (wr == 1) PG8_BAR; }
    }
    PG8_WAIT_V(0);
    if constexpr (!ALIGN_EPI) { if (wr == 0) PG8_BAR; }
    PG8_BAR;
#undef PG8_SA
#undef PG8_SB
#undef PG8_STAGE
#undef PG8_LDA
#undef PG8_LDB
#undef PG8_MMA
#undef PG8_WAIT_V
#undef PG8_WAIT_L
#undef PG8_BAR
#undef PG8_SCHED
}
}

enum { I_X = 0, I_C, I_RELB, I_WIN, I_WOUT, I_WADA, I_BADA, I_LN1G, I_LN1B, I_LN2G, I_LN2B, I_POOLW, I_POOLS, I_SINKS, I_CONVW, I_ALOG, I_DTB, I_NORMW,
       I_RW, I_RB, I_WUP, I_BUP, I_WDN, I_BDN, N_IN };
struct Params { const float* in[N_IN]; float* out; unsigned char* ws; };

struct Ctx {
    const Params* P; unsigned char* lds; int tid, lane, wave, gw, ngw, bid, nblk;
};

enum { PH_CONV = 0, PH_MOD, PH_PREP0, PH_L0 };
enum { L_GEMM1 = 0, L_MIXA, L_SWA, L_GPREP, L_GSCAN, L_GOUT, L_GEMM2, L_LN1, L_ROUTEA, L_ROUTEB, L_GATHER, L_UP, L_DOWN, L_COMBINE, L_NPH };
constexpr int N_PHASES = PH_L0 + DEPTH_ * L_NPH;

__device__ __forceinline__ void transpose_item(const float* W, int N, bf16_t* WT, int k0, int n0, int drow0, float* scr, int lane) {
    const int n = n0 + (lane & 31); const bool ok = n < N;
#pragma unroll 8
    for (int i = 0; i < 32; ++i) { const int kk = 2 * i + (lane >> 5); scr[kk * 33 + (lane & 31)] = ok ? W[(size_t)(k0 + kk) * N + n] : 0.f; }
    asm volatile("s_waitcnt lgkmcnt(0)" ::: "memory");
    const int c = lane & 7;
#pragma unroll
    for (int j = 0; j < 4; ++j) { const int nn = (lane >> 3) + 8 * j; const float* s = scr + (8 * c) * 33 + nn;
        u32x4 o; o.x = pk2(s[0 * 33], s[1 * 33]); o.y = pk2(s[2 * 33], s[3 * 33]); o.z = pk2(s[4 * 33], s[5 * 33]); o.w = pk2(s[6 * 33], s[7 * 33]);
        *(u32x4*)(WT + (size_t)(drow0 + nn) * 1024 + k0 + 8 * c) = o; }
    asm volatile("s_waitcnt lgkmcnt(0)" ::: "memory");
}
__device__ __forceinline__ void ph_conv(const Ctx& c) {
    const Params& P = *c.P;
    float* scr = (float*)(c.lds + c.wave * 16384);
    constexpr int I_IN = 16 * 80, I_OUT = 16 * 32, I_UP = 32 * 16 * 64, I_DN = 32 * 16 * 32, I_LAYER = I_IN + I_OUT + I_UP + I_DN;
    for (int it = c.gw; it < DEPTH_ * I_LAYER; it += c.ngw) {
        const int l = it / I_LAYER; int r = it % I_LAYER;
        if (r < I_IN) { const int kb = r / 80, nb = r % 80;
            transpose_item(P.in[I_WIN] + (size_t)l * 1024 * IN_DIM, IN_DIM, (bf16_t*)(P.ws + WS_WIN) + (size_t)l * NPROJ * 1024, 64 * kb, 32 * nb, 32 * nb, scr, c.lane); continue; }
        r -= I_IN;
        if (r < I_OUT) { const int kb = r / 32, nb = r % 32;
            transpose_item(P.in[I_WOUT] + (size_t)l * 1024 * 1024, 1024, (bf16_t*)(P.ws + WS_WOUT) + (size_t)l * 1024 * 1024, 64 * kb, 32 * nb, 32 * nb, scr, c.lane); continue; }
        r -= I_OUT;
        if (r < I_UP) { const int e = r / 1024, rr = r % 1024, kb = rr / 64, nb = rr % 64, n0 = 32 * nb, bj = n0 / 1024, rem = n0 % 1024, pn = rem / 128, c0 = rem % 128;
            transpose_item(P.in[I_WUP] + (size_t)(l * 32 + e) * 1024 * 2048, 2048, (bf16_t*)(P.ws + WS_WUP) + (size_t)(l * 32 + e) * 2048 * 1024, 64 * kb, n0, pn * 256 + bj * 128 + c0, scr, c.lane); continue; }
        r -= I_UP;
        { const int e = r / 512, rr = r % 512, kb = rr / 32, nb = rr % 32;
            transpose_item(P.in[I_WDN] + (size_t)(l * 32 + e) * 1024 * 1024, 1024, (bf16_t*)(P.ws + WS_WDN) + (size_t)(l * 32 + e) * 1024 * 1024, 64 * kb, 32 * nb, 32 * nb, scr, c.lane); }
    }
}

__device__ __forceinline__ void ph_mod(const Ctx& c) {
    const Params& P = *c.P;
    float* cs = (float*)c.lds;
    float* part = cs + 8192;
    for (int i = c.tid; i < 8192; i += NTHREADS) cs[i] = silu_f(P.in[I_C][i]);
    __syncthreads();
    float* mod = (float*)(P.ws + WS_MOD);
    for (int item = c.bid; item < DEPTH_ * 96; item += c.nblk) {
        const int l = item / 96, j = (item % 96) * 64 + c.lane;
        const float* w = P.in[I_WADA] + (size_t)l * 1024 * 6144 + j;
        float acc[8];
#pragma unroll
        for (int b = 0; b < 8; ++b) acc[b] = 0.f;
        const int k0 = c.wave * 128;
#pragma unroll 8
        for (int k = k0; k < k0 + 128; ++k) { const float wv = w[(size_t)k * 6144];
#pragma unroll
            for (int b = 0; b < 8; ++b) acc[b] += cs[b * 1024 + k] * wv; }
#pragma unroll
        for (int b = 0; b < 8; ++b) part[(c.wave * 8 + b) * 64 + c.lane] = acc[b];
        __syncthreads();
        { const int b = c.tid >> 6, col = c.tid & 63; float s = 0.f;
#pragma unroll
          for (int w8 = 0; w8 < 8; ++w8) s += part[(w8 * 8 + b) * 64 + col];
          const int jj = (item % 96) * 64 + col;
          mod[((size_t)l * 8 + b) * 6144 + jj] = s + P.in[I_BADA][l * 6144 + jj]; }
        __syncthreads();
    }
}

__device__ __forceinline__ void store_bf16_row(bf16_t* row, int lane, const f32x4 (&v)[4]) {
#pragma unroll
    for (int j = 0; j < 4; ++j) { u32x2 w; w.x = pk2(v[j][0], v[j][1]); w.y = pk2(v[j][2], v[j][3]); *(u32x2*)(row + 4 * lane + 256 * j) = w; }
}
__device__ __forceinline__ void modulate(f32x4 (&h)[4], const f32x4 (&x)[4], const float* sh, const float* sc, int lane) {
#pragma unroll
    for (int j = 0; j < 4; ++j) { const f32x4 a = *(const f32x4*)(sc + 4 * lane + 256 * j), b = *(const f32x4*)(sh + 4 * lane + 256 * j); h[j] = x[j] * (1.f + a) + b; }
}
__device__ __forceinline__ void ln_rows(f32x4 (&v)[4], const float* g, const float* b, int lane) {
    float s = 0.f;
#pragma unroll
    for (int j = 0; j < 4; ++j) s += (v[j][0] + v[j][1]) + (v[j][2] + v[j][3]);
    const float mean = wave_sum(s) * (1.f / 1024.f); float s2 = 0.f;
#pragma unroll
    for (int j = 0; j < 4; ++j) { v[j] = v[j] - mean; s2 += (v[j][0] * v[j][0] + v[j][1] * v[j][1]) + (v[j][2] * v[j][2] + v[j][3] * v[j][3]); }
    const float rstd = 1.f / sqrtf(wave_sum(s2) * (1.f / 1024.f) + LN_EPS_);
#pragma unroll
    for (int j = 0; j < 4; ++j) { const f32x4 gg = *(const f32x4*)(g + 4 * lane + 256 * j), bb = *(const f32x4*)(b + 4 * lane + 256 * j); v[j] = v[j] * rstd * gg + bb; }
}

__device__ __forceinline__ void ph_prep0(const Ctx& c) {
    const Params& P = *c.P; const float* mod = (const float*)(P.ws + WS_MOD);
    bf16_t* H = (bf16_t*)(P.ws + WS_H);
    for (int t = c.gw; t < T_; t += c.ngw) {
        const int b = t / SEQ_; const float* xr = P.in[I_X] + (size_t)t * 1024;
        f32x4 x[4], h[4];
#pragma unroll
        for (int j = 0; j < 4; ++j) x[j] = *(const f32x4*)(xr + 4 * c.lane + 256 * j);
        modulate(h, x, mod + (size_t)b * 6144, mod + (size_t)b * 6144 + 1024, c.lane);
        store_bf16_row(H + (size_t)t * 1024, c.lane, h);
    }
}

struct DenseSched {
    const char* A; const char* Bt; int nM, nN, G, c;
    __device__ __forceinline__ bool next(int i, pg8::Unit& u) const {
        const int L = i * G + c; if (L >= nM * nN) return false;
        pg8::tile_of(L, nM, nN, u.pm, u.pn); u.e = 0;
        u.a = A + (size_t)u.pm * 256 * 2048; u.b = Bt + (size_t)u.pn * 256 * 2048; return true; }
};
struct MoeSched {
    const char* A; const char* Bt; const int* blk_e; int nrb, nN, G, c; size_t estride;
    __device__ __forceinline__ bool next(int i, pg8::Unit& u) const {
        const int L = i * G + c; if (L >= nrb * nN) return false;
        pg8::tile_of(L, nrb, nN, u.pm, u.pn); u.e = blk_e[u.pm];
        u.a = A + (size_t)u.pm * 256 * 2048; u.b = Bt + (size_t)u.e * estride + (size_t)u.pn * 256 * 2048; return true; }
};
struct EpiStoreBf16 {
    static constexpr bool PERM = true;
    bf16_t* O; int ldc;
    __device__ __forceinline__ void operator()(const f32x4 (&acc)[2][2][4][2], const pg8::Unit& u, int wr, int wc, int fr, int fq) const {
        const int row0 = u.pm * 256 + wr * 64 + fr, col0 = u.pn * 256 + wc * 32 + 8 * fq;
#pragma unroll
        for (int ai = 0; ai < 2; ++ai)
#pragma unroll
            for (int m = 0; m < 4; ++m) { bf16_t* rowp = O + (size_t)(row0 + ai * 128 + m * 16) * ldc + col0;
#pragma unroll
                for (int bj = 0; bj < 2; ++bj) { const f32x4 v0 = acc[ai][bj][m][0], v1 = acc[ai][bj][m][1];
                    u32x4 w; w.x = pg8::cvt_pk_bf16(v0[0], v0[1]); w.y = pg8::cvt_pk_bf16(v0[2], v0[3]); w.z = pg8::cvt_pk_bf16(v1[0], v1[1]); w.w = pg8::cvt_pk_bf16(v1[2], v1[3]);
                    *(u32x4*)(rowp + bj * 128) = w; } }
    }
};
struct EpiResid {
    static constexpr bool PERM = false;
    const float* X; const float* gate; float* Z;
    __device__ __forceinline__ void operator()(const f32x4 (&acc)[2][2][4][2], const pg8::Unit& u, int wr, int wc, int fr, int fq) const {
        const int row0 = u.pm * 256 + wr * 64 + fr, col0 = u.pn * 256 + wc * 32 + 4 * fq;
        const float* gp = gate + (size_t)(u.pm >> 3) * 6144 + col0;
        f32x4 gv[2][2];
#pragma unroll
        for (int bj = 0; bj < 2; ++bj)
#pragma unroll
            for (int n = 0; n < 2; ++n) gv[bj][n] = *(const f32x4*)(gp + bj * 128 + n * 16);
#pragma unroll
        for (int ai = 0; ai < 2; ++ai)
#pragma unroll
            for (int m = 0; m < 4; ++m) { const size_t off = (size_t)(row0 + ai * 128 + m * 16) * 1024 + col0;
#pragma unroll
                for (int bj = 0; bj < 2; ++bj)
#pragma unroll
                    for (int n = 0; n < 2; ++n) { const f32x4 xv = *(const f32x4*)(X + off + bj * 128 + n * 16);
                        *(f32x4*)(Z + off + bj * 128 + n * 16) = xv * ALPHA_ + gv[bj][n] * acc[ai][bj][m][n]; } }
    }
};
struct EpiSwiglu {
    static constexpr bool PERM = true;
    bf16_t* ACT; const float* bup;
    __device__ __forceinline__ void operator()(const f32x4 (&acc)[2][2][4][2], const pg8::Unit& u, int wr, int wc, int fr, int fq) const {
        const int row0 = u.pm * 256 + wr * 64 + fr, j0 = u.pn * 128 + wc * 32 + 8 * fq;
        const float* bp = bup + (size_t)u.e * 2048 + j0;
        f32x4 bg[2], bl[2];
#pragma unroll
        for (int n = 0; n < 2; ++n) { bg[n] = *(const f32x4*)(bp + 4 * n); bl[n] = *(const f32x4*)(bp + 1024 + 4 * n); }
#pragma unroll
        for (int ai = 0; ai < 2; ++ai)
#pragma unroll
            for (int m = 0; m < 4; ++m) { float o[8];
#pragma unroll
                for (int n = 0; n < 2; ++n)
#pragma unroll
                    for (int q = 0; q < 4; ++q) { const float xg = fminf(acc[ai][0][m][n][q] + bg[n][q], 7.f); const float xl = fminf(fmaxf(acc[ai][1][m][n][q] + bl[n][q], -7.f), 7.f);
                        o[4 * n + q] = xg * sigmoid_f(1.702f * xg) * (xl + 1.f); }
                u32x4 w; w.x = pg8::cvt_pk_bf16(o[0], o[1]); w.y = pg8::cvt_pk_bf16(o[2], o[3]); w.z = pg8::cvt_pk_bf16(o[4], o[5]); w.w = pg8::cvt_pk_bf16(o[6], o[7]);
                *(u32x4*)(ACT + (size_t)(row0 + ai * 128 + m * 16) * 1024 + j0) = w; }
    }
};
struct EpiDown {
    static constexpr bool PERM = true;
    bf16_t* Y4; const float* bdn; const int* rowtok;
    __device__ __forceinline__ void operator()(const f32x4 (&acc)[2][2][4][2], const pg8::Unit& u, int wr, int wc, int fr, int fq) const {
        const int row0 = u.pm * 256 + wr * 64 + fr, col0 = u.pn * 256 + wc * 32 + 8 * fq;
        const float* bp = bdn + (size_t)u.e * 1024 + col0;
        f32x4 bv[2][2];
#pragma unroll
        for (int bj = 0; bj < 2; ++bj)
#pragma unroll
            for (int n = 0; n < 2; ++n) bv[bj][n] = *(const f32x4*)(bp + bj * 128 + 4 * n);
#pragma unroll
        for (int ai = 0; ai < 2; ++ai)
#pragma unroll
            for (int m = 0; m < 4; ++m) { const int a = rowtok[row0 + ai * 128 + m * 16];
                if (a >= 0) { bf16_t* rowp = Y4 + (size_t)a * 1024 + col0;
#pragma unroll
                    for (int bj = 0; bj < 2; ++bj) { const f32x4 v0 = acc[ai][bj][m][0] + bv[bj][0], v1 = acc[ai][bj][m][1] + bv[bj][1];
                        u32x4 w; w.x = pg8::cvt_pk_bf16(v0[0], v0[1]); w.y = pg8::cvt_pk_bf16(v0[2], v0[3]); w.z = pg8::cvt_pk_bf16(v1[0], v1[1]); w.w = pg8::cvt_pk_bf16(v1[2], v1[3]);
                        *(u32x4*)(rowp + bj * 128) = w; } } }
    }
};

__device__ __forceinline__ int t5_bucket(int n) { if (n < 16) return n; const int v = 16 + (int)(logf((float)n * (1.f / 16.f)) / logf(8.f) * 16.f); return v < 31 ? v : 31; }

__device__ __forceinline__ void pool_tile(const Ctx& c, int l, int tile) {
    const Params& P = *c.P; const bf16_t* proj = (const bf16_t*)(P.ws + WS_PROJ); bf16_t* mix = (bf16_t*)(P.ws + WS_MIX);
    float* us = (float*)c.lds;
    float* ps = us + 47 * 256;
    const int t0 = tile * 32, s0 = t0 % SEQ_;
    for (int i = c.tid; i < 47 * 256; i += NTHREADS) { const int r = i >> 8, ch = i & 255, s = s0 - 15 + r;
        us[i] = (s >= 0) ? bf2f(proj[(size_t)(t0 - 15 + r) * NPROJ + C_POOL + ch]) : 0.f; }
    __syncthreads();
    for (int i = c.tid; i < 32 * 256; i += NTHREADS) { const int r = i >> 8, ch = i & 255, gi = ch >> 6, w = 2 << gi, s = s0 + r;
        float sum = 0.f;
        for (int j = 0; j < w; ++j) sum += us[(15 + r - j) * 256 + ch];
        const float cnt = (float)((s + 1) < w ? (s + 1) : w);
        ps[i] = sum / cnt - us[(15 + r) * 256 + ch]; }
    __syncthreads();
    const float* pw = P.in[I_POOLW] + (size_t)l * 4 * 64 * 64; const float* psc = P.in[I_POOLS] + l * 256;
    for (int i = c.tid; i < 32 * 256; i += NTHREADS) { const int r = i >> 8, dd = i & 255, gi = dd >> 6, d = dd & 63;
        const float* pr = ps + r * 256 + gi * 64; const float* wp = pw + (size_t)gi * 4096 + d; float acc = 0.f;
#pragma unroll 8
        for (int k = 0; k < 64; ++k) acc += pr[k] * wp[k * 64];
        mix[(size_t)(t0 + r) * 1024 + dd] = (bf16_t)f2bf(acc * psc[dd]); }
    __syncthreads();
}
__device__ __forceinline__ void swa_item(const Ctx& c, int l, int item, float* wl) {
    const Params& P = *c.P; const bf16_t* proj = (const bf16_t*)(P.ws + WS_PROJ); bf16_t* mix = (bf16_t*)(P.ws + WS_MIX);
    float* qs = wl; float* pr = wl + 64;
    const int t = item / 6, hq = item % 6, kvh = hq / 3, s = t % SEQ_, lane = c.lane;
    qs[lane] = bf2f(proj[(size_t)t * NPROJ + C_AQ + hq * 64 + lane]);
    asm volatile("s_waitcnt lgkmcnt(0)" ::: "memory");
    const float sink = P.in[I_SINKS][l * 6 + hq];
    float sc[2];
#pragma unroll
    for (int h2 = 0; h2 < 2; ++h2) { const int kk = lane + 64 * h2, dist = 127 - kk, sk = s - dist;
        float dot = -1e30f;
        if (sk >= 0) { const bf16_t* kr = proj + (size_t)(t - dist) * NPROJ + C_AK + kvh * 64; float a = 0.f;
#pragma unroll
            for (int d8 = 0; d8 < 8; ++d8) { const u32x4 kv = *(const u32x4*)(kr + d8 * 8);
                a += qs[d8 * 8 + 0] * bflo(kv.x) + qs[d8 * 8 + 1] * bfhi(kv.x) + qs[d8 * 8 + 2] * bflo(kv.y) + qs[d8 * 8 + 3] * bfhi(kv.y)
                   + qs[d8 * 8 + 4] * bflo(kv.z) + qs[d8 * 8 + 5] * bfhi(kv.z) + qs[d8 * 8 + 6] * bflo(kv.w) + qs[d8 * 8 + 7] * bfhi(kv.w); }
            dot = a * 0.125f + P.in[I_RELB][t5_bucket(dist) * 6 + hq]; }
        sc[h2] = dot; }
    const float m = fmaxf(wave_max(fmaxf(sc[0], sc[1])), sink);
    const float p0 = (sc[0] > -1e29f) ? __expf(sc[0] - m) : 0.f, p1 = (sc[1] > -1e29f) ? __expf(sc[1] - m) : 0.f;
    const float den = wave_sum(p0 + p1) + __expf(sink - m);
    pr[lane] = p0; pr[lane + 64] = p1;
    asm volatile("s_waitcnt lgkmcnt(0)" ::: "memory");
    float o = 0.f;
    const int kk0 = (s >= 127) ? 0 : (127 - s);
    for (int kk = kk0; kk < 128; ++kk) o += pr[kk] * bf2f(proj[(size_t)(t - 127 + kk) * NPROJ + C_AV + kvh * 64 + lane]);
    mix[(size_t)t * 1024 + 256 + hq * 64 + lane] = (bf16_t)f2bf(o / den);
    asm volatile("s_waitcnt lgkmcnt(0)" ::: "memory");
}
constexpr int SW_KS = 0, SW_KROW = 144, SW_VT = 272 * 144, SW_VROW = 552, SW_BIAS = SW_VT + 64 * SW_VROW, SW_END = SW_BIAS + 3 * 128 * 4;
__device__ __forceinline__ void swa_mfma_item(const Ctx& c, int l, int item) {
    const Params& P = *c.P; const bf16_t* proj = (const bf16_t*)(P.ws + WS_PROJ); bf16_t* mix = (bf16_t*)(P.ws + WS_MIX);
    unsigned char* Ks = c.lds + SW_KS; unsigned char* Vt = c.lds + SW_VT; float* bias_s = (float*)(c.lds + SW_BIAS);
    const int b = item >> 5, n = (item >> 1) & 15, kvh = item & 1;
    const int tok0 = b * SEQ_ + n * 128;
    __syncthreads();
#pragma unroll
    for (int i = 0; i < 4; ++i) { const int idx = c.tid + i * NTHREADS, j = idx >> 3, ch = idx & 7; const bool ok = (n > 0) || (j >= 128);
        u32x4 kv = (u32x4){0u, 0u, 0u, 0u}, vv = kv;
        if (ok) { const bf16_t* rp = proj + (size_t)(tok0 - 128 + j) * NPROJ; kv = *(const u32x4*)(rp + C_AK + kvh * 64 + 8 * ch); vv = *(const u32x4*)(rp + C_AV + kvh * 64 + 8 * ch); }
        *(u32x4*)(Ks + j * SW_KROW + 16 * ch) = kv;
        unsigned short* vt = (unsigned short*)(Vt + (8 * ch) * SW_VROW + 2 * j);
        vt[0 * (SW_VROW / 2)] = (unsigned short)(vv.x & 0xffff); vt[1 * (SW_VROW / 2)] = (unsigned short)(vv.x >> 16);
        vt[2 * (SW_VROW / 2)] = (unsigned short)(vv.y & 0xffff); vt[3 * (SW_VROW / 2)] = (unsigned short)(vv.y >> 16);
        vt[4 * (SW_VROW / 2)] = (unsigned short)(vv.z & 0xffff); vt[5 * (SW_VROW / 2)] = (unsigned short)(vv.z >> 16);
        vt[6 * (SW_VROW / 2)] = (unsigned short)(vv.w & 0xffff); vt[7 * (SW_VROW / 2)] = (unsigned short)(vv.w >> 16); }
    if (c.tid < 144) *(u32x4*)(Ks + 256 * SW_KROW + 16 * c.tid) = (u32x4){0u, 0u, 0u, 0u};
    if (c.tid < 128) { const int d = c.tid >> 1, hf = c.tid & 1; *(u32x4*)(Vt + d * SW_VROW + 512 + 16 * hf) = (u32x4){0u, 0u, 0u, 0u}; }
    if (c.tid < 384) { const int g = c.tid >> 7, dist = c.tid & 127; bias_s[c.tid] = P.in[I_RELB][t5_bucket(dist) * 6 + kvh * 3 + g]; }
    __syncthreads();
    const int lane = c.lane, qc = lane & 15, q4 = lane >> 4, i0 = 16 * c.wave, jw = i0;
    const int iq0 = i0 + qc;
#pragma unroll 1
    for (int g = 0; g < 3; ++g) {
        asm volatile("" ::: "memory");
        int iq = iq0; asm volatile("" : "+v"(iq));
        const int hq = kvh * 3 + g; const float sink = P.in[I_SINKS][l * 6 + hq];
        const bf16_t* qp = proj + (size_t)(tok0 + iq) * NPROJ + C_AQ + hq * 64 + 8 * q4;
        const bf16x8 bq0 = *(const bf16x8*)(qp), bq1 = *(const bf16x8*)(qp + 32);
        f32x4 s[10];
#pragma unroll
        for (int kt = 0; kt < 10; ++kt) { const unsigned char* kp = Ks + (jw + 16 * kt + qc) * SW_KROW + 16 * q4;
            const bf16x8 a0 = *(const bf16x8*)(kp), a1 = *(const bf16x8*)(kp + 64);
            f32x4 acc = (f32x4){0.f, 0.f, 0.f, 0.f};
            acc = __builtin_amdgcn_mfma_f32_16x16x32_bf16(a0, bq0, acc, 0, 0, 0);
            acc = __builtin_amdgcn_mfma_f32_16x16x32_bf16(a1, bq1, acc, 0, 0, 0);
            s[kt] = acc; }
        float m = -1e30f;
        const int nz = (n == 0) ? -1 : 0;
#pragma unroll
        for (int kt = 0; kt < 10; ++kt)
#pragma unroll
            for (int r = 0; r < 4; ++r) { const int j = jw + 16 * kt + 4 * q4 + r, dist = iq + 128 - j;
                const unsigned mk = (unsigned)(~((dist | (127 - dist)) >> 31)) & ~((unsigned)((j - 128) >> 31) & (unsigned)nz);
                const float val = s[kt][r] * 0.125f + bias_s[g * 128 + (dist & 127)];
                const float v = __builtin_bit_cast(float, (__builtin_bit_cast(unsigned, val) & mk) | (0xf149f2cau & ~mk));
                s[kt][r] = v; m = fmaxf(m, v); }
        m = fmaxf(m, __shfl_xor(m, 16)); m = fmaxf(m, __shfl_xor(m, 32)); m = fmaxf(m, sink);
        float sum = 0.f;
#pragma unroll
        for (int kt = 0; kt < 10; ++kt)
#pragma unroll
            for (int r = 0; r < 4; ++r) { const float pv = __expf(s[kt][r] - m); s[kt][r] = pv; sum += pv; }
        sum += __shfl_xor(sum, 16); sum += __shfl_xor(sum, 32);
        const float rden = 1.f / (sum + __expf(sink - m));
        f32x4 o[4];
#pragma unroll
        for (int dt = 0; dt < 4; ++dt) o[dt] = (f32x4){0.f, 0.f, 0.f, 0.f};
#pragma unroll
        for (int k5 = 0; k5 < 5; ++k5) {
            u32x4 pw; pw.x = pk2(s[2 * k5][0], s[2 * k5][1]); pw.y = pk2(s[2 * k5][2], s[2 * k5][3]); pw.z = pk2(s[2 * k5 + 1][0], s[2 * k5 + 1][1]); pw.w = pk2(s[2 * k5 + 1][2], s[2 * k5 + 1][3]);
            const bf16x8 pb = __builtin_bit_cast(bf16x8, pw);
#pragma unroll
            for (int dt = 0; dt < 4; ++dt) { const unsigned char* vp = Vt + (16 * dt + qc) * SW_VROW + 2 * (jw + 32 * k5 + 4 * q4);
                const u32x2 lo = *(const u32x2*)(vp), hi = *(const u32x2*)(vp + 32);
                const bf16x8 av = __builtin_bit_cast(bf16x8, (u32x4){lo.x, lo.y, hi.x, hi.y});
                o[dt] = __builtin_amdgcn_mfma_f32_16x16x32_bf16(av, pb, o[dt], 0, 0, 0); } }
        bf16_t* op = mix + (size_t)(tok0 + iq) * 1024 + 256 + hq * 64 + 4 * q4;
#pragma unroll
        for (int dt = 0; dt < 4; ++dt) { u32x2 w; w.x = pk2(o[dt][0] * rden, o[dt][1] * rden); w.y = pk2(o[dt][2] * rden, o[dt][3] * rden); *(u32x2*)(op + 16 * dt) = w; }
    }
}
__device__ __forceinline__ void gdn_prep_tok(const Ctx& c, int l, int t) {
    const Params& P = *c.P; const bf16_t* proj = (const bf16_t*)(P.ws + WS_PROJ); const int lane = c.lane, s = t % SEQ_;
    float* QN = (float*)(P.ws + WS_QN); float* KN = (float*)(P.ws + WS_KN); float* VV = (float*)(P.ws + WS_VV); float* GB = (float*)(P.ws + WS_GB);
    const float* cw = P.in[I_CONVW] + (size_t)l * 4 * 1152;
#pragma unroll 1
    for (int grp = 0; grp < 18; ++grp) { const int ch = grp * 64 + lane; float a = 0.f;
#pragma unroll
        for (int j = 0; j < 4; ++j) { const int sj = s - 3 + j; if (sj >= 0) a += cw[j * 1152 + ch] * bf2f(proj[(size_t)(t - 3 + j) * NPROJ + C_GQ + ch]); }
        a = silu_f(a);
        if (grp < 12) { const float ss = wave_sum(a * a); a = a * (1.f / sqrtf(ss + NORM_EPS_)); }
        if (grp < 6) QN[(size_t)t * 384 + ch] = a * 0.125f;
        else if (grp < 12) KN[(size_t)t * 384 + (ch - 384)] = a;
        else VV[(size_t)t * 384 + (ch - 768)] = a; }
    if (lane < 6) { const float braw = bf2f(proj[(size_t)t * NPROJ + C_GB + lane]), araw = bf2f(proj[(size_t)t * NPROJ + C_GA + lane]);
        const float xx = araw + P.in[I_DTB][l * 6 + lane]; const float sp = xx > 20.f ? xx : log1pf(__expf(xx));
        GB[(size_t)t * 12 + lane] = -__expf(P.in[I_ALOG][l * 6 + lane]) * sp; GB[(size_t)t * 12 + 6 + lane] = sigmoid_f(braw); }
}
__device__ __forceinline__ void ph_gprep(const Ctx& c, int l);
__device__ __forceinline__ void ph_mixa(const Ctx& c, int l) {
    for (int tile = c.bid; tile < T_ / 32; tile += c.nblk) pool_tile(c, l, tile);
    for (int it = c.bid; it < NB_ * 16 * 2; it += c.nblk) swa_mfma_item(c, l, it);
    __syncthreads();
    ph_gprep(c, l);
}
__device__ __forceinline__ void ph_gscan(const Ctx& c) {
    const Params& P = *c.P;
    const float* QN = (const float*)(P.ws + WS_QN); const float* KN = (const float*)(P.ws + WS_KN); const float* VV = (const float*)(P.ws + WS_VV); const float* GB = (const float*)(P.ws + WS_GB);
    float* OR = (float*)(P.ws + WS_OR);
    float* ks = (float*)c.lds; float* qs = ks + 4096; float* vs = qs + 4096; float* gs = vs + 4096; float* bs = gs + 64;
    const int j = c.tid >> 3, p = c.tid & 7;
    for (int item = c.bid; item < NB_ * 6; item += c.nblk) {
        const int b = item / 6, h = item % 6;
        float S[8];
#pragma unroll
        for (int i = 0; i < 8; ++i) S[i] = 0.f;
        for (int ch = 0; ch < SEQ_ / 64; ++ch) {
            const int tb = b * SEQ_ + ch * 64;
            __syncthreads();
            for (int i = c.tid; i < 4096; i += NTHREADS) { const int r = i >> 6, d = i & 63; const size_t g = (size_t)(tb + r) * 384 + h * 64 + d; ks[i] = KN[g]; qs[i] = QN[g]; vs[i] = VV[g]; }
            if (c.tid < 64) { gs[c.tid] = __expf(GB[(size_t)(tb + c.tid) * 12 + h]); bs[c.tid] = GB[(size_t)(tb + c.tid) * 12 + 6 + h]; }
            __syncthreads();
            for (int r = 0; r < 64; ++r) {
                const float eg = gs[r], be = bs[r]; float kk[8], qq[8];
#pragma unroll
                for (int i = 0; i < 8; ++i) { kk[i] = ks[r * 64 + p * 8 + i]; qq[i] = qs[r * 64 + p * 8 + i]; }
                float kS = 0.f;
#pragma unroll
                for (int i = 0; i < 8; ++i) { S[i] *= eg; kS += kk[i] * S[i]; }
                kS += __shfl_xor(kS, 1); kS += __shfl_xor(kS, 2); kS += __shfl_xor(kS, 4);
                const float dl = be * (vs[r * 64 + j] - kS); float o = 0.f;
#pragma unroll
                for (int i = 0; i < 8; ++i) { S[i] += kk[i] * dl; o += qq[i] * S[i]; }
                o += __shfl_xor(o, 1); o += __shfl_xor(o, 2); o += __shfl_xor(o, 4);
                if (p == 0) OR[(size_t)(tb + r) * 384 + h * 64 + j] = o;
            }
        }
    }
}
constexpr size_t WS_GOP = WS_QN;
constexpr size_t WS_GCD = WS_QN + 64 * MiB;
constexpr int GOP_BYTES = 40960, GOP_W = 0, GOP_QD = 8192, GOP_AT = 16384, GOP_KT = 24576, GOP_U = 32768;
constexpr int GP_HALF = 55296, GP_RAW = 0, GP_LS = 0, GP_WT = 16384, GP_KB = 25728, GP_QB = 34944, GP_VB = 44160, GP_GT = 53376, GP_ROW = 144;

__device__ __forceinline__ void gdn_subst(float (&x)[64], const float* Ls, int lane) {
#pragma unroll
    for (int j = 0; j < 63; ++j) {
        const int col = __builtin_bit_cast(int, Ls[j * 64 + lane]);
        const float xj = x[j];
#pragma unroll
        for (int i = j + 1; i < 64; ++i) x[i] -= __builtin_bit_cast(float, __builtin_amdgcn_readlane(col, i)) * xj;
    }
}
__device__ __forceinline__ void gdn_prep_pair(const Ctx& c, int l, int item, bool active) {
    const Params& P = *c.P; const bf16_t* proj = (const bf16_t*)(P.ws + WS_PROJ);
    const int half = c.wave >> 2, hw = c.wave & 3, lane = c.lane, htid = c.tid & 255, qc = lane & 15, q4 = lane >> 4;
    unsigned char* L0 = c.lds + half * GP_HALF;
    bf16_t* raw = (bf16_t*)(L0 + GP_RAW); float* Ls = (float*)(L0 + GP_LS); unsigned char* WT = L0 + GP_WT;
    unsigned char* KB = L0 + GP_KB; unsigned char* QB = L0 + GP_QB; unsigned char* VB = L0 + GP_VB;
    float* gc = (float*)(L0 + GP_GT); float* eg = gc + 64; float* bt = gc + 128;
    const int h = item % 6, n = (item / 6) & 31, b = item / 192;
    const int tb = b * SEQ_ + n * 64;
    const int ci = (b * 6 + h) * 32 + n;
    unsigned char* gop = P.ws + WS_GOP + (size_t)ci * GOP_BYTES;
    __syncthreads();
    if (active) {
        for (int idx = htid; idx < 67 * 24; idx += 256) { const int r = idx / 24, ch = idx % 24, grp = ch >> 3, c8 = ch & 7;
            u32x4 v = (u32x4){0u, 0u, 0u, 0u};
            if (n * 64 + r - 3 >= 0) v = *(const u32x4*)(proj + (size_t)(tb + r - 3) * NPROJ + C_GQ + grp * 384 + h * 64 + 8 * c8);
            *(u32x4*)((unsigned char*)raw + r * 384 + ch * 16) = v; }
        if (hw == 0) { const float braw = bf2f(proj[(size_t)(tb + lane) * NPROJ + C_GB + h]), araw = bf2f(proj[(size_t)(tb + lane) * NPROJ + C_GA + h]);
            const float xx = araw + P.in[I_DTB][l * 6 + h]; const float sp = xx > 20.f ? xx : log1pf(__expf(xx));
            float g = -__expf(P.in[I_ALOG][l * 6 + h]) * sp;
#pragma unroll
            for (int o = 1; o < 64; o <<= 1) { const float t = __shfl_up(g, o); if (lane >= o) g += t; }
            gc[lane] = g; eg[lane] = __expf(g); bt[lane] = sigmoid_f(braw); }
    }
    __syncthreads();
    if (active) {
        const float* cw = P.in[I_CONVW] + (size_t)l * 4 * 1152 + h * 64 + lane;
        float wq[4], wk[4], wv[4];
#pragma unroll
        for (int j = 0; j < 4; ++j) { wq[j] = cw[j * 1152]; wk[j] = cw[j * 1152 + 384]; wv[j] = cw[j * 1152 + 768]; }
#pragma unroll 4
        for (int ii = 16 * hw; ii < 16 * hw + 16; ++ii) { float aq = 0.f, ak = 0.f, av = 0.f;
#pragma unroll
            for (int j = 0; j < 4; ++j) { const bf16_t* rr = raw + (ii + j) * 192 + lane; aq += wq[j] * bf2f(rr[0]); ak += wk[j] * bf2f(rr[64]); av += wv[j] * bf2f(rr[128]); }
            aq = silu_f(aq); ak = silu_f(ak); av = silu_f(av);
            const float sq = wave_sum(aq * aq), sk = wave_sum(ak * ak);
            aq *= 0.125f / sqrtf(sq + NORM_EPS_); ak *= 1.f / sqrtf(sk + NORM_EPS_);
            *(bf16_t*)(QB + ii * GP_ROW + 2 * lane) = (bf16_t)f2bf(aq); *(bf16_t*)(KB + ii * GP_ROW + 2 * lane) = (bf16_t)f2bf(ak); *(bf16_t*)(VB + ii * GP_ROW + 2 * lane) = (bf16_t)f2bf(av); }
    }
    __syncthreads();
    if (active) {
        bf16x8 ka[2], qa[2];
#pragma unroll
        for (int ks = 0; ks < 2; ++ks) { ka[ks] = *(const bf16x8*)(KB + (16 * hw + qc) * GP_ROW + 64 * ks + 16 * q4); qa[ks] = *(const bf16x8*)(QB + (16 * hw + qc) * GP_ROW + 64 * ks + 16 * q4); }
        f32x4 at[4];
#pragma unroll
        for (int t = 0; t < 4; ++t) at[t] = (f32x4){0.f, 0.f, 0.f, 0.f};
#pragma unroll
        for (int ct = 0; ct < 4; ++ct) if (ct <= hw) {
            bf16x8 kb2[2];
#pragma unroll
            for (int ks = 0; ks < 2; ++ks) kb2[ks] = *(const bf16x8*)(KB + (16 * ct + qc) * GP_ROW + 64 * ks + 16 * q4);
            f32x4 acc = (f32x4){0.f, 0.f, 0.f, 0.f};
            acc = __builtin_amdgcn_mfma_f32_16x16x32_bf16(ka[0], kb2[0], acc, 0, 0, 0); acc = __builtin_amdgcn_mfma_f32_16x16x32_bf16(ka[1], kb2[1], acc, 0, 0, 0);
            { const int j = 16 * ct + qc; const float gj = gc[j]; f32x4 lv;
#pragma unroll
              for (int r = 0; r < 4; ++r) { const int i = 16 * hw + 4 * q4 + r; lv[r] = (i > j) ? bt[i] * acc[r] * __expf(gc[i] - gj) : 0.f; }
              *(f32x4*)(Ls + j * 64 + 16 * hw + 4 * q4) = lv; }
            f32x4 a2 = (f32x4){0.f, 0.f, 0.f, 0.f};
            a2 = __builtin_amdgcn_mfma_f32_16x16x32_bf16(kb2[0], qa[0], a2, 0, 0, 0); a2 = __builtin_amdgcn_mfma_f32_16x16x32_bf16(kb2[1], qa[1], a2, 0, 0, 0);
            { const int i = 16 * hw + qc; const float gi = gc[i];
#pragma unroll
              for (int r = 0; r < 4; ++r) { const int j = 16 * ct + 4 * q4 + r; at[ct][r] = (i >= j) ? a2[r] * __expf(gi - gc[j]) : 0.f; } }
        }
#pragma unroll
        for (int ks = 0; ks < 2; ++ks) { u32x4 w; w.x = pk2(at[2 * ks][0], at[2 * ks][1]); w.y = pk2(at[2 * ks][2], at[2 * ks][3]); w.z = pk2(at[2 * ks + 1][0], at[2 * ks + 1][1]); w.w = pk2(at[2 * ks + 1][2], at[2 * ks + 1][3]);
            *(u32x4*)(gop + GOP_AT + (hw * 2 + ks) * 1024 + lane * 16) = w; }
    }
    __syncthreads();
    if (active) {
        if (hw == 0) { float x[64];
#pragma unroll
            for (int i = 0; i < 64; ++i) x[i] = bt[i] * bf2f(*(const bf16_t*)(VB + i * GP_ROW + 2 * lane));
            gdn_subst(x, Ls, lane);
            unsigned char* up = gop + GOP_U + (lane >> 4) * 2048 + (lane & 15) * 32;
#pragma unroll
            for (int rt = 0; rt < 4; ++rt)
#pragma unroll
                for (int qq = 0; qq < 4; ++qq) { u32x2 w; w.x = pk2(x[16 * rt + 4 * qq], x[16 * rt + 4 * qq + 1]); w.y = pk2(x[16 * rt + 4 * qq + 2], x[16 * rt + 4 * qq + 3]); *(u32x2*)(up + qq * 512 + rt * 8) = w; }
        } else if (hw == 1) { float x[64];
#pragma unroll
            for (int i = 0; i < 64; ++i) x[i] = bt[i] * eg[i] * bf2f(*(const bf16_t*)(KB + i * GP_ROW + 2 * lane));
            gdn_subst(x, Ls, lane);
#pragma unroll
            for (int i = 0; i < 64; ++i) *(bf16_t*)(WT + i * GP_ROW + 2 * lane) = (bf16_t)f2bf(x[i]);
            asm volatile("s_waitcnt lgkmcnt(0)" ::: "memory");
#pragma unroll
            for (int mt = 0; mt < 4; ++mt)
#pragma unroll
                for (int ks = 0; ks < 2; ++ks) { const unsigned char* wp = WT + (16 * mt + qc) * GP_ROW + 64 * ks + 8 * q4; const u32x2 lo = *(const u32x2*)(wp), hi = *(const u32x2*)(wp + 32);
                    *(u32x4*)(gop + GOP_W + (mt * 2 + ks) * 1024 + lane * 16) = (u32x4){lo.x, lo.y, hi.x, hi.y}; }
        } else if (hw == 2) {
#pragma unroll
            for (int mt = 0; mt < 4; ++mt) { const float e = eg[16 * mt + qc];
#pragma unroll
                for (int ks = 0; ks < 2; ++ks) { const unsigned char* qp = QB + (16 * mt + qc) * GP_ROW + 64 * ks + 8 * q4; const u32x2 lo = *(const u32x2*)(qp), hi = *(const u32x2*)(qp + 32);
                    u32x4 w; w.x = pk2(bflo(lo.x) * e, bfhi(lo.x) * e); w.y = pk2(bflo(lo.y) * e, bfhi(lo.y) * e); w.z = pk2(bflo(hi.x) * e, bfhi(hi.x) * e); w.w = pk2(bflo(hi.y) * e, bfhi(hi.y) * e);
                    *(u32x4*)(gop + GOP_QD + (mt * 2 + ks) * 1024 + lane * 16) = w; } }
        } else { const float gl = gc[63];
#pragma unroll
            for (int mt = 0; mt < 4; ++mt)
#pragma unroll
                for (int ks = 0; ks < 2; ++ks) { float v[8];
#pragma unroll
                    for (int e = 0; e < 8; ++e) { const int i = 32 * ks + 4 * q4 + (e < 4 ? e : 12 + e); v[e] = bf2f(*(const bf16_t*)(KB + i * GP_ROW + 2 * (16 * mt + qc))) * __expf(gl - gc[i]); }
                    u32x4 w; w.x = pk2(v[0], v[1]); w.y = pk2(v[2], v[3]); w.z = pk2(v[4], v[5]); w.w = pk2(v[6], v[7]);
                    *(u32x4*)(gop + GOP_KT + (mt * 2 + ks) * 1024 + lane * 16) = w; }
            if (lane == 0) ((float*)(P.ws + WS_GCD))[ci] = eg[63];
        }
    }
}
__device__ __forceinline__ void ph_gprep(const Ctx& c, int l) {
    const int half = c.wave >> 2, nit = NB_ * 32 * 6, npair = (nit + 1) / 2;
    for (int pr = c.bid; pr < npair; pr += c.nblk) { const int item = 2 * pr + half; gdn_prep_pair(c, l, item < nit ? item : nit - 1, item < nit); }
    __syncthreads();
}
__device__ __forceinline__ void ph_gscan2(const Ctx& c) {
    const Params& P = *c.P; float* OR = (float*)(P.ws + WS_OR); const float* CD = (const float*)(P.ws + WS_GCD);
    const int lane = c.lane, qc = lane & 15, q4 = lane >> 4;
    if (c.wave >= 4) return;
    for (int bh = c.bid; bh < NB_ * 6; bh += c.nblk) {
        const int b = bh / 6, h = bh % 6, s = c.wave;
        f32x4 S[4];
#pragma unroll
        for (int t = 0; t < 4; ++t) S[t] = (f32x4){0.f, 0.f, 0.f, 0.f};
#pragma unroll 1
        for (int n = 0; n < 32; ++n) {
            const int ci = bh * 32 + n; const unsigned char* gop = P.ws + WS_GOP + (size_t)ci * GOP_BYTES;
            const float cd = CD[ci];
            bf16x8 sb[2];
#pragma unroll
            for (int ks = 0; ks < 2; ++ks) { u32x4 w; w.x = pk2(S[2 * ks][0], S[2 * ks][1]); w.y = pk2(S[2 * ks][2], S[2 * ks][3]); w.z = pk2(S[2 * ks + 1][0], S[2 * ks + 1][1]); w.w = pk2(S[2 * ks + 1][2], S[2 * ks + 1][3]); sb[ks] = __builtin_bit_cast(bf16x8, w); }
            const u32x4 u0 = *(const u32x4*)(gop + GOP_U + s * 2048 + lane * 32), u1 = *(const u32x4*)(gop + GOP_U + s * 2048 + lane * 32 + 16);
            f32x4 vn[4], o[4];
#pragma unroll
            for (int mt = 0; mt < 4; ++mt) { f32x4 p1 = (f32x4){0.f, 0.f, 0.f, 0.f}, q1 = p1;
#pragma unroll
                for (int ks = 0; ks < 2; ++ks) { const bf16x8 wf = *(const bf16x8*)(gop + GOP_W + (mt * 2 + ks) * 1024 + lane * 16), qf = *(const bf16x8*)(gop + GOP_QD + (mt * 2 + ks) * 1024 + lane * 16);
                    p1 = __builtin_amdgcn_mfma_f32_16x16x32_bf16(wf, sb[ks], p1, 0, 0, 0); q1 = __builtin_amdgcn_mfma_f32_16x16x32_bf16(qf, sb[ks], q1, 0, 0, 0); }
                const unsigned ua = (mt == 0) ? u0.x : (mt == 1) ? u0.z : (mt == 2) ? u1.x : u1.z, ub = (mt == 0) ? u0.y : (mt == 1) ? u0.w : (mt == 2) ? u1.y : u1.w;
                vn[mt] = (f32x4){bflo(ua), bfhi(ua), bflo(ub), bfhi(ub)} - p1; o[mt] = q1; }
            bf16x8 vb[2];
#pragma unroll
            for (int ks = 0; ks < 2; ++ks) { u32x4 w; w.x = pk2(vn[2 * ks][0], vn[2 * ks][1]); w.y = pk2(vn[2 * ks][2], vn[2 * ks][3]); w.z = pk2(vn[2 * ks + 1][0], vn[2 * ks + 1][1]); w.w = pk2(vn[2 * ks + 1][2], vn[2 * ks + 1][3]); vb[ks] = __builtin_bit_cast(bf16x8, w); }
#pragma unroll
            for (int mt = 0; mt < 4; ++mt) { S[mt] = S[mt] * cd;
#pragma unroll
                for (int ks = 0; ks < 2; ++ks) { const bf16x8 af = *(const bf16x8*)(gop + GOP_AT + (mt * 2 + ks) * 1024 + lane * 16), kf = *(const bf16x8*)(gop + GOP_KT + (mt * 2 + ks) * 1024 + lane * 16);
                    o[mt] = __builtin_amdgcn_mfma_f32_16x16x32_bf16(af, vb[ks], o[mt], 0, 0, 0); S[mt] = __builtin_amdgcn_mfma_f32_16x16x32_bf16(kf, vb[ks], S[mt], 0, 0, 0); } }
            float* op = OR + (size_t)(b * SEQ_ + n * 64 + 4 * q4) * 384 + h * 64 + 16 * s + qc;
#pragma unroll
            for (int mt = 0; mt < 4; ++mt)
#pragma unroll
                for (int r = 0; r < 4; ++r) op[(size_t)(16 * mt + r) * 384] = o[mt][r];
        }
    }
}
__device__ __forceinline__ void ph_gout(const Ctx& c, int l) {
    const Params& P = *c.P; const bf16_t* proj = (const bf16_t*)(P.ws + WS_PROJ); bf16_t* mix = (bf16_t*)(P.ws + WS_MIX); const float* OR = (const float*)(P.ws + WS_OR);
    const float nw = P.in[I_NORMW][l * 64 + c.lane];
    for (int t = c.gw; t < T_; t += c.ngw) {
#pragma unroll
        for (int h = 0; h < 6; ++h) { const float o = OR[(size_t)t * 384 + h * 64 + c.lane]; const float ms = wave_sum(o * o) * (1.f / 64.f);
            const float z = bf2f(proj[(size_t)t * NPROJ + C_GZ + h * 64 + c.lane]);
            mix[(size_t)t * 1024 + 640 + h * 64 + c.lane] = (bf16_t)f2bf(o * (1.f / sqrtf(ms + NORM_EPS_)) * nw * silu_f(z)); }
    }
}

__device__ __forceinline__ void ph_ln1(const Ctx& c, int l) {
    const Params& P = *c.P; const float* mod = (const float*)(P.ws + WS_MOD) + (size_t)l * 8 * 6144;
    float* Z = (float*)(P.ws + WS_Z); bf16_t* H2 = (bf16_t*)(P.ws + WS_H2); int* TI = (int*)(P.ws + WS_TOPI); float* TG = (float*)(P.ws + WS_TOPG);
    float* wr = (float*)c.lds;
    const float* rw = P.in[I_RW] + (size_t)l * 1024 * 32;
    for (int i = c.tid; i < 32768; i += NTHREADS) { const int k = i >> 5, e = i & 31; wr[e * 1024 + k] = rw[i]; }
    __syncthreads();
    const float* g = P.in[I_LN1G] + l * 1024; const float* bb = P.in[I_LN1B] + l * 1024; const float* rb = P.in[I_RB] + l * 32;
    for (int t = c.gw; t < T_; t += c.ngw) {
        const int b = t / SEQ_; float* zr = Z + (size_t)t * 1024;
        f32x4 v[4], h[4];
#pragma unroll
        for (int j = 0; j < 4; ++j) v[j] = *(const f32x4*)(zr + 4 * c.lane + 256 * j);
        ln_rows(v, g, bb, c.lane);
        { float* xr = (float*)(P.ws + WS_X1) + (size_t)t * 1024;
#pragma unroll
        for (int j = 0; j < 4; ++j) *(f32x4*)(xr + 4 * c.lane + 256 * j) = v[j]; }
        modulate(h, v, mod + (size_t)b * 6144 + 3072, mod + (size_t)b * 6144 + 4096, c.lane);
        store_bf16_row(H2 + (size_t)t * 1024, c.lane, h);
        float mylg = -3.0e38f;
#pragma unroll 2
        for (int e = 0; e < 32; ++e) { float a = 0.f;
#pragma unroll
            for (int j = 0; j < 4; ++j) { const f32x4 w = *(const f32x4*)(wr + e * 1024 + 4 * c.lane + 256 * j); a += (h[j][0] * w[0] + h[j][1] * w[1]) + (h[j][2] * w[2] + h[j][3] * w[3]); }
            const float s = wave_sum(a) + rb[e]; if (c.lane == e) mylg = s; }
        int bi[4]; float bv[4];
#pragma unroll
        for (int k = 0; k < 4; ++k) { const float best = wave_max(mylg); const unsigned long long bal = __ballot(mylg == best); const int id = __ffsll((long long)bal) - 1;
            if (c.lane == id) mylg = -3.0e38f;
            bi[k] = id; bv[k] = best; }
        const float e1 = __expf(bv[1] - bv[0]), e2 = __expf(bv[2] - bv[0]), e3 = __expf(bv[3] - bv[0]), inv = 1.f / (1.f + e1 + e2 + e3);
        if (c.lane == 0) { *(int4*)(TI + (size_t)t * 4) = make_int4(bi[0], bi[1], bi[2], bi[3]); *(f32x4*)(TG + (size_t)t * 4) = (f32x4){inv, e1 * inv, e2 * inv, e3 * inv}; }
    }
    __syncthreads();
}

__device__ __forceinline__ void ph_routea(const Ctx& c) {
    const Params& P = *c.P; const int* TI = (const int*)(P.ws + WS_TOPI); int* R = (int*)(P.ws + WS_ROUTE);
    int* hist = (int*)c.lds;
    for (int seg = c.bid; seg < 256; seg += c.nblk) {
        if (c.tid < 32) hist[c.tid] = 0;
        __syncthreads();
        if (c.tid < 256) atomicAdd(&hist[TI[seg * 256 + c.tid]], 1);
        __syncthreads();
        if (c.tid < 32) R[R_COUNTS + seg * 32 + c.tid] = hist[c.tid];
        __syncthreads();
    }
}
__device__ __forceinline__ void ph_routeb(const Ctx& c) {
    const Params& P = *c.P; const int* TI = (const int*)(P.ws + WS_TOPI); int* R = (int*)(P.ws + WS_ROUTE);
    int* tot = (int*)c.lds; int* off = tot + 32; int* pst = off + 32; int* eid = pst + 64;
    for (int seg = c.bid; seg < 256; seg += c.nblk) {
        if (c.tid < 32) { int a = 0, o = 0; for (int s2 = 0; s2 < 256; ++s2) { const int v = R[R_COUNTS + s2 * 32 + c.tid]; a += v; if (s2 < seg) o += v; } tot[c.tid] = a; off[c.tid] = o; }
        if (c.tid < 256) eid[c.tid] = TI[seg * 256 + c.tid];
        __syncthreads();
        if (c.tid == 0) { int ps = 0; for (int e = 0; e < 32; ++e) { pst[e] = ps; ps += ((tot[e] + 255) >> 8) << 8; } pst[32] = ps; }
        __syncthreads();
        if (c.tid < 256) { const int e = eid[c.tid]; int rank = 0; for (int q = 0; q < c.tid; ++q) rank += (eid[q] == e) ? 1 : 0;
            R[R_ROWTOK + pst[e] + off[e] + rank] = seg * 256 + c.tid; }
        if (seg == 0) {
            for (int e = 0; e < 32; ++e) { const int lo = pst[e] + tot[e], hi = pst[e + 1]; for (int q = lo + c.tid; q < hi; q += NTHREADS) R[R_ROWTOK + q] = -1; }
            const int nrb = pst[32] >> 8;
            for (int rb = c.tid; rb < nrb; rb += NTHREADS) { int e = 0; for (int q = 1; q < 32; ++q) if ((rb << 8) >= pst[q]) e = q; R[R_BLKE + rb] = e; }
            if (c.tid == 0) R[R_NRB] = nrb;
        }
        __syncthreads();
    }
}
__device__ __forceinline__ void ph_gather(const Ctx& c) {
    const Params& P = *c.P; const int* R = (const int*)(P.ws + WS_ROUTE); const bf16_t* H2 = (const bf16_t*)(P.ws + WS_H2); bf16_t* XB = (bf16_t*)(P.ws + WS_XBUF);
    const int nrows = R[R_NRB] * 256;
    for (int r = c.gw; r < nrows; r += c.ngw) { const int a = R[R_ROWTOK + r];
        u32x4 v0 = (u32x4){0u, 0u, 0u, 0u}, v1 = v0;
        if (a >= 0) { const bf16_t* src = H2 + (size_t)(a >> 2) * 1024; v0 = *(const u32x4*)(src + 8 * c.lane); v1 = *(const u32x4*)(src + 512 + 8 * c.lane); }
        *(u32x4*)(XB + (size_t)r * 1024 + 8 * c.lane) = v0; *(u32x4*)(XB + (size_t)r * 1024 + 512 + 8 * c.lane) = v1; }
}

__device__ __forceinline__ void ph_combine(const Ctx& c, int l) {
    const Params& P = *c.P; const float* mod = (const float*)(P.ws + WS_MOD) + (size_t)l * 8 * 6144;
    const float* X1 = (const float*)(P.ws + WS_X1); const bf16_t* Y4 = (const bf16_t*)(P.ws + WS_Y4); const float* TG = (const float*)(P.ws + WS_TOPG);
    float* XO = (l == DEPTH_ - 1) ? P.out : (float*)(P.ws + WS_X); bf16_t* H = (bf16_t*)(P.ws + WS_H);
    const float* g = P.in[I_LN2G] + l * 1024; const float* bb = P.in[I_LN2B] + l * 1024;
    for (int t = c.gw; t < T_; t += c.ngw) {
        const int b = t / SEQ_; const f32x4 gt = *(const f32x4*)(TG + (size_t)t * 4);
        f32x4 v[4];
#pragma unroll
        for (int j = 0; j < 4; ++j) { const int col = 4 * c.lane + 256 * j; f32x4 y = (f32x4){0.f, 0.f, 0.f, 0.f};
#pragma unroll
            for (int k = 0; k < 4; ++k) { const u32x2 w = *(const u32x2*)(Y4 + (size_t)(t * 4 + k) * 1024 + col); y += gt[k] * (f32x4){bflo(w.x), bfhi(w.x), bflo(w.y), bfhi(w.y)}; }
            const f32x4 x1 = *(const f32x4*)(X1 + (size_t)t * 1024 + col), g2 = *(const f32x4*)(mod + (size_t)b * 6144 + 5120 + col);
            v[j] = x1 * ALPHA_ + g2 * y; }
        ln_rows(v, g, bb, c.lane);
#pragma unroll
        for (int j = 0; j < 4; ++j) *(f32x4*)(XO + (size_t)t * 1024 + 4 * c.lane + 256 * j) = v[j];
        if (l + 1 < DEPTH_) { const float* m2 = (const float*)(P.ws + WS_MOD) + (size_t)(l + 1) * 8 * 6144 + (size_t)b * 6144; f32x4 h[4];
            modulate(h, v, m2, m2 + 1024, c.lane); store_bf16_row(H + (size_t)t * 1024, c.lane, h); }
    }
}

#define XB_TMO      128
#define XB_XCNT(j)  (256  + 64 * (j))
#define XB_XSUB(j)  (1280 + 64 * (j))
#define XB_XGEN(j)  (2304 + 64 * (j))
#define XB_TOP      3328
#define XB_TOPGEN   3392
#define XCD_BAR_WORDS 3456
#define XB_SPIN_CAP (1u << 18)
constexpr int CW_BAR = 4096;
constexpr int MISC_OFF = LDS_BYTES - 256;
__device__ __forceinline__ unsigned xb_ld(unsigned* p)              { return __hip_atomic_load(p, __ATOMIC_RELAXED, __HIP_MEMORY_SCOPE_AGENT); }
__device__ __forceinline__ unsigned xb_add(unsigned* p, unsigned v) { return __hip_atomic_fetch_add(p, v, __ATOMIC_RELAXED, __HIP_MEMORY_SCOPE_AGENT); }
__device__ __forceinline__ unsigned xb_xcc_id() { return (unsigned)__builtin_amdgcn_s_getreg((3 << 11) | 20) & 0xFu; }
#define XB_SPIN(cond, bar) do { unsigned _sp = 0; while (cond) { __builtin_amdgcn_s_sleep(1); \
    if ((++_sp & 255u) == 0u) { if (xb_ld(&(bar)[XB_TMO])) break; if (_sp > XB_SPIN_CAP) { atomicAdd(&(bar)[XB_TMO], 1u); break; } } } } while (0)
struct XcdBarrier { unsigned* bar; unsigned x; volatile LAS unsigned* st; };
__device__ __forceinline__ XcdBarrier xcd_barrier_post(unsigned* bar, volatile LAS unsigned* st) {
    XcdBarrier b; b.bar = bar; b.x = xb_xcc_id(); b.st = st;
    if (threadIdx.x == 0) (void)xb_add(&bar[XB_XCNT(b.x)], 1u);
    return b;
}
__device__ __forceinline__ void xcd_barrier_complete(unsigned* bar, unsigned x, unsigned& nloc, unsigned& nx) {
    const unsigned G = gridDim.x * gridDim.y * gridDim.z;
    unsigned sum, cnt, mine, sp = 0u;
    for (;;) {
        sum = 0u; cnt = 0u; mine = 0u;
#pragma unroll
        for (unsigned j = 0; j < 16; ++j) { const unsigned c = xb_ld(&bar[XB_XCNT(j)]); sum += c; cnt += (c > 0u) ? 1u : 0u; mine = (j == x) ? c : mine; }
        if (sum == G) break;
        __builtin_amdgcn_s_sleep(1);
        if ((++sp & 255u) == 0u) { if (xb_ld(&bar[XB_TMO])) break; if (sp > XB_SPIN_CAP) { atomicAdd(&bar[XB_TMO], 1u); break; } }
    }
    nloc = mine > 0u ? mine : 1u; nx = cnt > 0u ? cnt : 1u;
}
__device__ __forceinline__ void xcd_barrier(const XcdBarrier& b) {
    asm volatile("s_waitcnt vmcnt(0)" ::: "memory");
    __syncthreads();
    if (threadIdx.x == 0) {
        unsigned* bar = b.bar;
        __builtin_amdgcn_s_waitcnt(0);
        unsigned nloc = b.st[0], nx = b.st[1];
        if (nloc == 0u) { xcd_barrier_complete(bar, b.x, nloc, nx); b.st[0] = nloc; b.st[1] = nx; }
        const unsigned old = xb_add(&bar[XB_XSUB(b.x)], 1u);
        const unsigned gen = old / nloc;
        if (old + 1u == (gen + 1u) * nloc) {
            __builtin_amdgcn_fence(__ATOMIC_RELEASE, "agent");
            asm volatile("s_waitcnt vmcnt(0)" ::: "memory");
            const unsigned og = xb_add(&bar[XB_TOP], 1u);
            const unsigned tg = og / nx;
            if (og + 1u == (tg + 1u) * nx) xb_add(&bar[XB_TOPGEN], 1u);
            else XB_SPIN(xb_ld(&bar[XB_TOPGEN]) == tg, bar);
            __builtin_amdgcn_fence(__ATOMIC_ACQUIRE, "agent");
            xb_add(&bar[XB_XGEN(b.x)], 1u);
            asm volatile("s_waitcnt vmcnt(0)" ::: "memory");
        } else {
            XB_SPIN(xb_ld(&bar[XB_XGEN(b.x)]) == gen, bar);
            __builtin_amdgcn_fence(__ATOMIC_ACQUIRE, "agent");
            asm volatile("s_waitcnt vmcnt(0)" ::: "memory");
        }
    }
    __syncthreads();
}

template <int KIND>
__device__ __forceinline__ void run_kind(const Ctx& c0, int l) {
    Ctx c = c0;
    { int t = c0.tid; asm volatile("" : "+v"(t)); c.tid = t; c.lane = t & 63; c.wave = __builtin_amdgcn_readfirstlane(t >> 6); }
    { int b = c0.bid, n = c0.nblk; asm volatile("" : "+s"(b), "+s"(n)); c.bid = b; c.nblk = n; c.gw = b * NWAVES + c.wave; c.ngw = n * NWAVES; }
    { long z = 0; asm volatile("" : "+s"(z)); c.P = (const Params*)((const char*)c0.P + z); }
    const Params& P = *c.P; LAS unsigned char* lds3 = (LAS unsigned char*)c.lds;
    const int* R = (const int*)(P.ws + WS_ROUTE);
    if constexpr (KIND == 0) ph_conv(c);
    else if constexpr (KIND == 1) ph_mod(c);
    else if constexpr (KIND == 2) ph_prep0(c);
    else if constexpr (KIND == 3 + L_GEMM1) { DenseSched S{(const char*)(P.ws + WS_H), (const char*)(P.ws + WS_WIN) + (size_t)l * NPROJ * 2048, T_ / 256, NPROJ / 256, c.nblk, c.bid};
        EpiStoreBf16 E{(bf16_t*)(P.ws + WS_PROJ), NPROJ};
        pg8::gemm_phase<EpiStoreBf16, DenseSched, true, true>(lds3, S, E, c.tid); }
    else if constexpr (KIND == 3 + L_MIXA) { for (int tile = c.bid; tile < T_ / 32; tile += c.nblk) pool_tile(c, l, tile); }
    else if constexpr (KIND == 3 + L_SWA) { for (int it = c.bid; it < NB_ * 16 * 2; it += c.nblk) swa_mfma_item(c, l, it); __syncthreads(); }
    else if constexpr (KIND == 3 + L_GPREP) ph_gprep(c, l);
    else if constexpr (KIND == 3 + L_GSCAN) ph_gscan2(c);
    else if constexpr (KIND == 3 + L_GOUT) ph_gout(c, l);
    else if constexpr (KIND == 3 + L_GEMM2) { DenseSched S{(const char*)(P.ws + WS_MIX), (const char*)(P.ws + WS_WOUT) + (size_t)l * 1024 * 2048, T_ / 256, 4, c.nblk, c.bid};
        EpiResid E{l == 0 ? P.in[I_X] : (const float*)(P.ws + WS_X), (const float*)(P.ws + WS_MOD) + (size_t)l * 8 * 6144 + 2048, (float*)(P.ws + WS_Z)};
        pg8::gemm_phase<EpiResid, DenseSched, true, true>(lds3, S, E, c.tid); }
    else if constexpr (KIND == 3 + L_LN1) ph_ln1(c, l);
    else if constexpr (KIND == 3 + L_ROUTEA) ph_routea(c);
    else if constexpr (KIND == 3 + L_ROUTEB) ph_routeb(c);
    else if constexpr (KIND == 3 + L_GATHER) ph_gather(c);
    else if constexpr (KIND == 3 + L_UP) { MoeSched S{(const char*)(P.ws + WS_XBUF), (const char*)(P.ws + WS_WUP) + (size_t)l * 32 * 2048 * 2048, R + R_BLKE, R[R_NRB], 8, c.nblk, c.bid, (size_t)2048 * 2048};
        EpiSwiglu E{(bf16_t*)(P.ws + WS_ACT), P.in[I_BUP] + (size_t)l * 32 * 2048};
        pg8::gemm_phase<EpiSwiglu, MoeSched, true, true>(lds3, S, E, c.tid); }
    else if constexpr (KIND == 3 + L_DOWN) { MoeSched S{(const char*)(P.ws + WS_ACT), (const char*)(P.ws + WS_WDN) + (size_t)l * 32 * 1024 * 2048, R + R_BLKE, R[R_NRB], 4, c.nblk, c.bid, (size_t)1024 * 2048};
        EpiDown E{(bf16_t*)(P.ws + WS_Y4), P.in[I_BDN] + (size_t)l * 32 * 1024, R + R_ROWTOK};
        pg8::gemm_phase<EpiDown, MoeSched, true, true>(lds3, S, E, c.tid); }
    else if constexpr (KIND == 3 + L_COMBINE) ph_combine(c, l);
}

#define SEAM() xcd_barrier(bar)
#ifndef PROBE_KIND
#define PROBE_KIND -1
#endif
#define RK(K, L) do { run_kind<K>(c, L); if ((K) == PROBE_KIND && (L) == 0) { SEAM(); run_kind<K>(c, L); } } while (0)
template <int L> __device__ __forceinline__ void run_layer(const Ctx& c, const XcdBarrier& bar) {
    RK(3 + L_GEMM1, L); SEAM();
    RK(3 + L_MIXA, L); RK(3 + L_SWA, L); RK(3 + L_GPREP, L); SEAM();
    RK(3 + L_GSCAN, L); SEAM();
    RK(3 + L_GOUT, L); SEAM();
    RK(3 + L_GEMM2, L); SEAM();
    RK(3 + L_LN1, L); SEAM();
    RK(3 + L_ROUTEA, L); SEAM();
    RK(3 + L_ROUTEB, L); SEAM();
    RK(3 + L_GATHER, L); SEAM();
    RK(3 + L_UP, L); SEAM();
    RK(3 + L_DOWN, L); SEAM();
    RK(3 + L_COMBINE, L);
}
__global__ void __launch_bounds__(NTHREADS, 2) mk_fwd(Params P) {
    extern __shared__ __attribute__((aligned(16))) unsigned char lds[];
    Ctx c; c.P = &P; c.lds = lds; c.tid = threadIdx.x; c.lane = c.tid & 63; c.wave = __builtin_amdgcn_readfirstlane(c.tid >> 6);
    c.bid = blockIdx.x; c.nblk = gridDim.x; c.gw = c.bid * NWAVES + c.wave; c.ngw = c.nblk * NWAVES;
    for (int u = c.tid; u < 64; u += NTHREADS) ((volatile LAS unsigned*)((LAS unsigned char*)lds + MISC_OFF))[u] = 0u;
    __syncthreads();
    const XcdBarrier bar = xcd_barrier_post((unsigned*)(P.ws + WS_CTL) + CW_BAR, (volatile LAS unsigned*)((LAS unsigned char*)lds + MISC_OFF) + 8);
    RK(0, 0); __syncthreads(); RK(1, 0); SEAM();
    RK(2, 0); SEAM();
    run_layer<0>(c, bar); SEAM();
    run_layer<1>(c, bar);
}

extern "C" void kernel_launch(void* const* d_in, const int* in_sizes, int n_in, void* d_out, int out_size, void* d_ws, size_t ws_size, hipStream_t stream) {
    static int grid = 0;
    if (grid == 0) {
        if (n_in != N_IN || out_size != T_ * D_ || ws_size < WS_END) { fprintf(stderr, "kernel_launch: unexpected shapes (n_in %d out %d ws %zu need %zu)\n", n_in, out_size, ws_size, (size_t)WS_END); grid = -1; return; }
        int dev = 0, cus = 0, per_cu = 0;
        (void)hipGetDevice(&dev); (void)hipDeviceGetAttribute(&cus, hipDeviceAttributeMultiprocessorCount, dev);
        (void)hipFuncSetAttribute((const void*)mk_fwd, hipFuncAttributeMaxDynamicSharedMemorySize, LDS_BYTES);
        if (hipOccupancyMaxActiveBlocksPerMultiprocessor(&per_cu, (const void*)mk_fwd, NTHREADS, LDS_BYTES) != hipSuccess || per_cu < 1) { fprintf(stderr, "kernel_launch: occupancy query says %d blocks/CU\n", per_cu); (void)hipGetLastError(); grid = -1; return; }
        grid = cus > 0 ? cus : 256;
    }
    if (grid < 0) return;
    (void)hipMemsetAsync((char*)d_ws + WS_CTL, 0, 1 * MiB, stream);
    Params p{};
    for (int i = 0; i < N_IN; ++i) p.in[i] = (const float*)d_in[i];
    p.out = (float*)d_out; p.ws = (unsigned char*)d_ws;
    void* args[] = {&p};
    hipError_t e = hipLaunchCooperativeKernel((const void*)mk_fwd, dim3(grid), dim3(NTHREADS), args, LDS_BYTES, stream);
    if (e != hipSuccess) fprintf(stderr, "cooperative launch failed: %s (grid %d)\n", hipGetErrorString(e), grid);
}
```

```cpp
#include <hip/hip_runtime.h>
#include <hip/hip_cooperative_groups.h>
#include <cstdio>
#include <cstdint>
namespace cg = cooperative_groups;

#define LAS __attribute__((address_space(3)))
typedef unsigned short bf16_t;
typedef short bf16x8 __attribute__((ext_vector_type(8)));
typedef float f32x4 __attribute__((ext_vector_type(4)));
typedef float f32x2 __attribute__((ext_vector_type(2)));
typedef unsigned u32x4 __attribute__((ext_vector_type(4)));
typedef unsigned u32x2 __attribute__((ext_vector_type(2)));

constexpr int T_ = 16384, D_ = 1024, NB_ = 8, SEQ_ = 2048, DEPTH_ = 2;
constexpr int IN_DIM = 2444, NPROJ = 2560;
constexpr int C_POOL = 0, C_AQ = 256, C_AK = 640, C_AV = 768, C_GQ = 896, C_GK = 1280, C_GV = 1664, C_GZ = 2048, C_GB = 2432, C_GA = 2438;
constexpr int NE_ = 32, TOPK_ = 4, NASSIGN = T_ * TOPK_, NRB_MAX = NASSIGN / 256 + NE_, PROWS = NRB_MAX * 256;
constexpr float ALPHA_ = 1.41421356237309515f;
constexpr float LN_EPS_ = 1e-5f, NORM_EPS_ = 1e-6f;
constexpr int NTHREADS = 512, NWAVES = 8;
constexpr int LDS_BYTES = 147456;

constexpr size_t MiB = 1u << 20;
constexpr size_t WS_CTL = 0;
constexpr size_t WS_MOD = 1 * MiB;
constexpr size_t WS_ROUTE = 2 * MiB;
constexpr size_t WS_WIN = 4 * MiB;
constexpr size_t WS_WOUT = 14 * MiB;
constexpr size_t WS_WUP = 18 * MiB;
constexpr size_t WS_WDN = WS_WUP + 256 * MiB;
constexpr size_t WS_H = WS_WDN + 128 * MiB;
constexpr size_t WS_H2 = WS_H + 32 * MiB;
constexpr size_t WS_PROJ = WS_H2 + 32 * MiB;
constexpr size_t WS_MIX = WS_PROJ + 80 * MiB;
constexpr size_t WS_Z = WS_MIX + 32 * MiB;
constexpr size_t WS_X = WS_Z + 64 * MiB;
constexpr size_t WS_QN = WS_X + 64 * MiB;
constexpr size_t WS_KN = WS_QN + 24 * MiB;
constexpr size_t WS_VV = WS_KN + 24 * MiB;
constexpr size_t WS_OR = WS_VV + 24 * MiB;
constexpr size_t WS_GB = WS_OR + 24 * MiB;
constexpr size_t WS_TOPI = WS_GB + 1 * MiB;
constexpr size_t WS_TOPG = WS_TOPI + 1 * MiB;
constexpr size_t WS_XBUF = WS_TOPG + 1 * MiB;
constexpr size_t WS_ACT = WS_XBUF + 144 * MiB;
constexpr size_t WS_Y4 = WS_ACT + 144 * MiB;
constexpr size_t WS_X1 = WS_Y4 + 128 * MiB;
constexpr size_t WS_END = WS_X1 + 64 * MiB;
constexpr int R_COUNTS = 0;
constexpr int R_BLKE = 8192;
constexpr int R_NRB = 8192 + 512;
constexpr int R_ROWTOK = 16384;

__device__ __forceinline__ unsigned f2bf(float f) { unsigned u = __builtin_bit_cast(unsigned, f); return (u + 0x7fffu + ((u >> 16) & 1u)) >> 16; }
__device__ __forceinline__ unsigned pk2(float lo, float hi) { return f2bf(lo) | (f2bf(hi) << 16); }
__device__ __forceinline__ float bf2f(unsigned short b) { return __builtin_bit_cast(float, (unsigned)b << 16); }
__device__ __forceinline__ float bflo(unsigned w) { return __builtin_bit_cast(float, w << 16); }
__device__ __forceinline__ float bfhi(unsigned w) { return __builtin_bit_cast(float, w & 0xffff0000u); }
__device__ __forceinline__ float wave_sum(float v) {
#pragma unroll
    for (int o = 1; o < 64; o <<= 1) v += __shfl_xor(v, o);
    return v;
}
__device__ __forceinline__ float wave_max(float v) {
#pragma unroll
    for (int o = 1; o < 64; o <<= 1) v = fmaxf(v, __shfl_xor(v, o));
    return v;
}
__device__ __forceinline__ float silu_f(float x) { return x / (1.f + __expf(-x)); }
__device__ __forceinline__ float sigmoid_f(float x) { return 1.f / (1.f + __expf(-x)); }

namespace pg8 {
constexpr int BM = 256, BK = 64, HALF = 128, HTB = HALF * BK * 2, STAGE_BYTES = 8 * HTB, NXCD = 8, WGM = 8, KD = 1024;
__host__ __device__ __forceinline__ int lds_byte(int r, int c) { const int st = (r >> 4) * 2 + (c >> 5), rr = r & 15, cc = c & 31, ob = rr * 64 + cc * 2; return st * 1024 + (ob ^ (((ob >> 9) & 1) << 5)); }
__host__ __device__ __forceinline__ void stage_rc(int b, int& R, int& C) { const int st = b / 1024, sb = b % 1024, swz = sb ^ (((sb >> 9) & 1) << 5); R = (st >> 1) * 16 + swz / 64; C = (st & 1) * 32 + (swz % 64) / 2; }
__host__ __device__ __forceinline__ int perm32(int rho) { const int n = rho >> 4, i = rho & 15; return 8 * (i >> 2) + 4 * n + (i & 3); }

struct Unit { int pm, pn, e; const char* a; const char* b; const int* ridx; };

__device__ __forceinline__ void tile_of(int L, int nM, int nN, int& pm, int& pn) {
    const int nwg = nM * nN; int wgid = L;
    { const int q = nwg / NXCD, r = nwg % NXCD, xcd = wgid % NXCD, off = wgid / NXCD; wgid = (xcd < r ? xcd * (q + 1) : r * (q + 1) + (xcd - r) * q) + off; }
    const int nig = WGM * nN, gid = wgid / nig, fm = gid * WGM, gsz = (nM - fm) < WGM ? (nM - fm) : WGM;
    pm = fm + ((wgid % nig) % gsz); pn = (wgid % nig) / gsz;
}

__device__ __forceinline__ unsigned cvt_pk_bf16(float lo, float hi) { unsigned r; asm volatile("v_cvt_pk_bf16_f32 %0, %1, %2" : "=v"(r) : "v"(lo), "v"(hi)); return r; }

template <class Epi, class Sched, bool ALIGN_EPI, bool SP2, bool GATHER = false>
__device__ __forceinline__ void gemm_phase(LAS unsigned char* lds, const Sched& S, const Epi& E, const int tid) {
    const int wid = __builtin_amdgcn_readfirstlane(tid >> 6), lane = tid & 63, wr = wid >> 2, wc = wid & 3, fr = lane & 15, fq = lane >> 4;
    constexpr int K = KD, nt = K / BK;
    unsigned voffA[2], voffB[2];
#pragma unroll
    for (int i = 0; i < 2; ++i) { int R, C; stage_rc(tid * 16 + i * 8192, R, C); const int Rb = Epi::PERM ? ((R & ~31) + perm32(R & 31)) : R;
        voffA[i] = (unsigned)(R * K + C) * 2u; voffB[i] = (unsigned)(Rb * K + C) * 2u; }
    const size_t kstep = (size_t)(BK * 2);
    const size_t hstep = (size_t)HALF * K * 2;
    const size_t hsA = GATHER ? 0 : hstep;
    int gR[2], gC[2];
#pragma unroll
    for (int i = 0; i < 2; ++i) stage_rc(tid * 16 + i * 8192, gR[i], gC[i]);
    unsigned vgC0[2], vgC1[2], vgN0[2], vgN1[2];
#define PG8_GLOAD(dst0, dst1, u) do { _Pragma("unroll") for (int _i = 0; _i < 2; ++_i) { const int _r0 = (u).ridx[gR[_i]], _r1 = (u).ridx[HALF + gR[_i]]; \
        dst0[_i] = (unsigned)((_r0 < 0 ? 0 : _r0 >> 2) * (K * 2) + gC[_i] * 2); dst1[_i] = (unsigned)((_r1 < 0 ? 0 : _r1 >> 2) * (K * 2) + gC[_i] * 2); } } while (0)
    const unsigned ldsw = (unsigned)wid * 1024u;
    const int aoff = lds_byte(wr * 64 + fr, fq * 8), boff = lds_byte(wc * 32 + fr, fq * 8);
#define PG8_SA(b, h) (((b) * 2 + (h)) * HTB)
#define PG8_SB(b, h) ((4 + (b) * 2 + (h)) * HTB)
#define PG8_STAGE(bufoff, gbase, voff) do { _Pragma("unroll") for (int _i = 0; _i < 2; ++_i) \
        __builtin_amdgcn_global_load_lds((const unsigned*)((const char*)(gbase) + (voff)[_i]), (LAS unsigned*)(lds + (bufoff) + ldsw + _i * 8192), 16, 0, 0); } while (0)
#define PG8_LDA(dst, b, h) do { _Pragma("unroll") for (int m = 0; m < 4; ++m) _Pragma("unroll") for (int k = 0; k < 2; ++k) dst[m][k] = *(const LAS bf16x8*)(lds + PG8_SA(b, h) + aoff + m * 2048 + k * 1024); } while (0)
#define PG8_LDB(dst, b, h) do { _Pragma("unroll") for (int n = 0; n < 2; ++n) _Pragma("unroll") for (int k = 0; k < 2; ++k) dst[n][k] = *(const LAS bf16x8*)(lds + PG8_SB(b, h) + boff + n * 2048 + k * 1024); } while (0)
#define PG8_MMA(ai, bj, At, Bt) do { __builtin_amdgcn_s_setprio(1); _Pragma("unroll") for (int m = 0; m < 4; ++m) _Pragma("unroll") for (int n = 0; n < 2; ++n) _Pragma("unroll") for (int k = 0; k < 2; ++k) \
        acc[ai][bj][m][n] = __builtin_amdgcn_mfma_f32_16x16x32_bf16(Bt[n][k], At[m][k], acc[ai][bj][m][n], 0, 0, 0); __builtin_amdgcn_s_setprio(0); } while (0)
#define PG8_WAIT_V(n) asm volatile("s_waitcnt vmcnt(" #n ")" ::: "memory")
#define PG8_WAIT_L(n) asm volatile("s_waitcnt lgkmcnt(" #n ")" ::: "memory")
#define PG8_BAR __builtin_amdgcn_s_barrier()
#define PG8_SCHED __builtin_amdgcn_sched_barrier(0)
    Unit cur, nxt; int ui = 0;
    if (!S.next(0, cur)) return;
    f32x4 acc[2][2][4][2];
#pragma unroll
    for (int a = 0; a < 2; ++a)
#pragma unroll
        for (int b = 0; b < 2; ++b)
#pragma unroll
            for (int m = 0; m < 4; ++m)
#pragma unroll
                for (int n = 0; n < 2; ++n) acc[a][b][m][n] = (f32x4){0.f, 0.f, 0.f, 0.f};
    bf16x8 At[4][2], B0[2][2], B1[2][2];
    const char* cA = cur.a; const char* cB = cur.b;
    if constexpr (GATHER) { PG8_GLOAD(vgC0, vgC1, cur); _Pragma("unroll") for (int i = 0; i < 2; ++i) { vgN0[i] = vgC0[i]; vgN1[i] = vgC1[i]; } }
    if constexpr (SP2) {
        PG8_STAGE(PG8_SB(0, 0), cB, voffB); PG8_STAGE(PG8_SB(0, 1), cB + hstep, voffB); PG8_STAGE(PG8_SA(0, 0), cA, (GATHER ? vgC0 : voffA)); PG8_STAGE(PG8_SA(0, 1), cA + hsA, (GATHER ? vgC1 : voffA));
        if (wr == 1) PG8_BAR;
        PG8_WAIT_V(2); PG8_BAR;
        PG8_STAGE(PG8_SB(1, 0), cB + kstep, voffB); PG8_STAGE(PG8_SA(1, 0), cA + kstep, (GATHER ? vgC0 : voffA)); PG8_STAGE(PG8_SB(1, 1), cB + hstep + kstep, voffB);
        PG8_WAIT_V(6); PG8_BAR;
    } else {
        PG8_STAGE(PG8_SB(0, 0), cB, voffB); PG8_STAGE(PG8_SA(0, 0), cA, voffA); PG8_STAGE(PG8_SB(0, 1), cB + hstep, voffB); PG8_STAGE(PG8_SA(0, 1), cA + hstep, voffA);
        if (wr == 1) PG8_BAR;
        PG8_WAIT_V(4); PG8_BAR;
        PG8_STAGE(PG8_SB(1, 0), cB + kstep, voffB); PG8_STAGE(PG8_SA(1, 0), cA + kstep, voffA); PG8_STAGE(PG8_SB(1, 1), cB + hstep + kstep, voffB);
        PG8_WAIT_V(6); PG8_BAR;
    }
    for (;;) {
        const bool has_next = S.next(ui + 1, nxt);
        const char* nA = has_next ? nxt.a : cA; const char* nB = has_next ? nxt.b : cB;
        if constexpr (GATHER) { if (has_next) PG8_GLOAD(vgN0, vgN1, nxt); }
        for (int t = 0; t < nt; t += 2) {
            const bool last = (t == nt - 2);
            unsigned vA0[2], vA1[2];
            if constexpr (GATHER) { if (last) { vA0[0] = vgN0[0]; vA0[1] = vgN0[1]; vA1[0] = vgN1[0]; vA1[1] = vgN1[1]; } else { vA0[0] = vgC0[0]; vA0[1] = vgC0[1]; vA1[0] = vgC1[0]; vA1[1] = vgC1[1]; } }
            const char* a1 = cA + (size_t)(t + 1) * kstep;
            const char* a2 = last ? nA : cA + (size_t)(t + 2) * kstep; const char* b2 = last ? nB : cB + (size_t)(t + 2) * kstep;
            const char* a3 = a2 + kstep; const char* b3 = b2 + kstep;
            if constexpr (SP2) {
            PG8_LDB(B0, 0, 0); PG8_LDB(B1, 0, 1); PG8_SCHED; PG8_LDA(At, 0, 0); PG8_STAGE(PG8_SA(1, 1), a1 + hsA, (GATHER ? vgC1 : voffA));
            PG8_WAIT_V(8); PG8_WAIT_L(0); PG8_BAR; PG8_MMA(0, 0, At, B0); PG8_MMA(0, 1, At, B1); PG8_BAR; PG8_SCHED;
            PG8_LDA(At, 0, 1); PG8_STAGE(PG8_SB(0, 0), b2, voffB); PG8_STAGE(PG8_SB(0, 1), b2 + hstep, voffB); PG8_STAGE(PG8_SA(0, 0), a2, (GATHER ? vA0 : voffA));
            PG8_WAIT_V(8); PG8_WAIT_L(0); PG8_BAR; PG8_MMA(1, 0, At, B0); PG8_MMA(1, 1, At, B1); PG8_BAR; PG8_SCHED;
            PG8_LDB(B0, 1, 0); PG8_LDB(B1, 1, 1); PG8_SCHED; PG8_LDA(At, 1, 0); PG8_STAGE(PG8_SA(0, 1), a2 + hsA, (GATHER ? vA1 : voffA));
            PG8_WAIT_V(8); PG8_WAIT_L(0); PG8_BAR; PG8_MMA(0, 0, At, B0); PG8_MMA(0, 1, At, B1); PG8_BAR; PG8_SCHED;
            PG8_LDA(At, 1, 1); PG8_STAGE(PG8_SB(1, 0), b3, voffB); PG8_STAGE(PG8_SB(1, 1), b3 + hstep, voffB); PG8_STAGE(PG8_SA(1, 0), a3, (GATHER ? vA0 : voffA));
            PG8_WAIT_V(8); PG8_WAIT_L(0); PG8_BAR; PG8_MMA(1, 0, At, B0); PG8_MMA(1, 1, At, B1); PG8_BAR; PG8_SCHED;
            } else {
            PG8_LDB(B0, 0, 0); PG8_SCHED; PG8_LDA(At, 0, 0); PG8_STAGE(PG8_SA(1, 1), a1 + hstep, voffA);
            PG8_WAIT_L(8); PG8_BAR; PG8_WAIT_L(0); PG8_MMA(0, 0, At, B0); PG8_BAR; PG8_SCHED;
            PG8_LDB(B1, 0, 1); PG8_STAGE(PG8_SB(0, 0), b2, voffB);
            PG8_BAR; PG8_WAIT_L(0); PG8_MMA(0, 1, At, B1); PG8_BAR;
            PG8_LDA(At, 0, 1); PG8_STAGE(PG8_SA(0, 0), a2, voffA);
            PG8_BAR; PG8_WAIT_L(0); PG8_MMA(1, 0, At, B0); PG8_BAR; PG8_SCHED;
            PG8_STAGE(PG8_SB(0, 1), b2 + hstep, voffB);
            PG8_WAIT_V(6); PG8_BAR; PG8_MMA(1, 1, At, B1); PG8_BAR;
            PG8_LDB(B0, 1, 0); PG8_SCHED; PG8_LDA(At, 1, 0); PG8_STAGE(PG8_SA(0, 1), a2 + hstep, voffA);
            PG8_WAIT_L(8); PG8_BAR; PG8_WAIT_L(0); PG8_MMA(0, 0, At, B0); PG8_BAR; PG8_SCHED;
            PG8_LDB(B1, 1, 1); PG8_STAGE(PG8_SB(1, 0), b3, voffB);
            PG8_BAR; PG8_WAIT_L(0); PG8_MMA(0, 1, At, B1); PG8_BAR;
            PG8_LDA(At, 1, 1); PG8_STAGE(PG8_SA(1, 0), a3, voffA);
            PG8_BAR; PG8_WAIT_L(0); PG8_MMA(1, 0, At, B0); PG8_BAR; PG8_SCHED;
            PG8_STAGE(PG8_SB(1, 1), b3 + hstep, voffB);
            PG8_WAIT_V(6); PG8_BAR; PG8_MMA(1, 1, At, B1); PG8_BAR;
            }
        }
        if constexpr (ALIGN_EPI) { if (wr == 0) PG8_BAR; }
        E(acc, cur, wr, wc, fr, fq);
        if (!has_next) break;
#pragma unroll
        for (int a = 0; a < 2; ++a)
#pragma unroll
            for (int b = 0; b < 2; ++b)
#pragma unroll
                for (int m = 0; m < 4; ++m)
#pragma unroll
                    for (int n = 0; n < 2; ++n) acc[a][b][m][n] = (f32x4){0.f, 0.f, 0.f, 0.f};
        cur = nxt; cA = nA; cB = nB; ++ui;
        if constexpr (GATHER) { _Pragma("unroll") for (int i = 0; i < 2; ++i) { vgC0[i] = vgN0[i]; vgC1[i] = vgN1[i]; } }
        if constexpr (ALIGN_EPI) { if (wr == 1) PG8_BAR; }
    }
    PG8_WAIT_V(0);
    if constexpr (!ALIGN_EPI) { if (wr == 0) PG8_BAR; }
    PG8_BAR;
#undef PG8_GLOAD
#undef PG8_SA
#undef PG8_SB
#undef PG8_STAGE
#undef PG8_LDA
#undef PG8_LDB
#undef PG8_MMA
#undef PG8_WAIT_V
#undef PG8_WAIT_L
#undef PG8_BAR
#undef PG8_SCHED
}
}

enum { I_X = 0, I_C, I_RELB, I_WIN, I_WOUT, I_WADA, I_BADA, I_LN1G, I_LN1B, I_LN2G, I_LN2B, I_POOLW, I_POOLS, I_SINKS, I_CONVW, I_ALOG, I_DTB, I_NORMW,
       I_RW, I_RB, I_WUP, I_BUP, I_WDN, I_BDN, N_IN };
struct Params { const float* in[N_IN]; float* out; unsigned char* ws; };

struct Ctx {
    const Params* P; unsigned char* lds; int tid, lane, wave, gw, ngw, bid, nblk;
};

enum { PH_CONV = 0, PH_MOD, PH_PREP0, PH_L0 };
enum { L_GEMM1 = 0, L_MIXA, L_SWA, L_GPREP, L_GSCAN, L_GOUT, L_GEMM2, L_LN1, L_ROUTEA, L_ROUTEB, L_GATHER, L_UP, L_DOWN, L_COMBINE, L_NPH };
constexpr int N_PHASES = PH_L0 + DEPTH_ * L_NPH;

__device__ __forceinline__ void transpose_item(const float* W, int N, bf16_t* WT, int k0, int n0, int drow0, float* scr, int lane) {
    const int n = n0 + (lane & 31); const bool ok = n < N;
#pragma unroll 8
    for (int i = 0; i < 32; ++i) { const int kk = 2 * i + (lane >> 5); scr[kk * 33 + (lane & 31)] = ok ? W[(size_t)(k0 + kk) * N + n] : 0.f; }
    asm volatile("s_waitcnt lgkmcnt(0)" ::: "memory");
    const int c = lane & 7;
#pragma unroll
    for (int j = 0; j < 4; ++j) { const int nn = (lane >> 3) + 8 * j; const float* s = scr + (8 * c) * 33 + nn;
        u32x4 o; o.x = pk2(s[0 * 33], s[1 * 33]); o.y = pk2(s[2 * 33], s[3 * 33]); o.z = pk2(s[4 * 33], s[5 * 33]); o.w = pk2(s[6 * 33], s[7 * 33]);
        *(u32x4*)(WT + (size_t)(drow0 + nn) * 1024 + k0 + 8 * c) = o; }
    asm volatile("s_waitcnt lgkmcnt(0)" ::: "memory");
}
__device__ __forceinline__ void ph_conv(const Ctx& c) {
    const Params& P = *c.P;
    float* scr = (float*)(c.lds + c.wave * 16384);
    constexpr int I_IN = 16 * 80, I_OUT = 16 * 32, I_UP = 32 * 16 * 64, I_DN = 32 * 16 * 32, I_LAYER = I_IN + I_OUT + I_UP + I_DN;
    for (int it = c.gw; it < DEPTH_ * I_LAYER; it += c.ngw) {
        const int l = it / I_LAYER; int r = it % I_LAYER;
        if (r < I_IN) { const int kb = r / 80, nb = r % 80;
            transpose_item(P.in[I_WIN] + (size_t)l * 1024 * IN_DIM, IN_DIM, (bf16_t*)(P.ws + WS_WIN) + (size_t)l * NPROJ * 1024, 64 * kb, 32 * nb, 32 * nb, scr, c.lane); continue; }
        r -= I_IN;
        if (r < I_OUT) { const int kb = r / 32, nb = r % 32;
            transpose_item(P.in[I_WOUT] + (size_t)l * 1024 * 1024, 1024, (bf16_t*)(P.ws + WS_WOUT) + (size_t)l * 1024 * 1024, 64 * kb, 32 * nb, 32 * nb, scr, c.lane); continue; }
        r -= I_OUT;
        if (r < I_UP) { const int e = r / 1024, rr = r % 1024, kb = rr / 64, nb = rr % 64, n0 = 32 * nb, bj = n0 / 1024, rem = n0 % 1024, pn = rem / 128, c0 = rem % 128;
            transpose_item(P.in[I_WUP] + (size_t)(l * 32 + e) * 1024 * 2048, 2048, (bf16_t*)(P.ws + WS_WUP) + (size_t)(l * 32 + e) * 2048 * 1024, 64 * kb, n0, pn * 256 + bj * 128 + c0, scr, c.lane); continue; }
        r -= I_UP;
        { const int e = r / 512, rr = r % 512, kb = rr / 32, nb = rr % 32;
            transpose_item(P.in[I_WDN] + (size_t)(l * 32 + e) * 1024 * 1024, 1024, (bf16_t*)(P.ws + WS_WDN) + (size_t)(l * 32 + e) * 1024 * 1024, 64 * kb, 32 * nb, 32 * nb, scr, c.lane); }
    }
}

__device__ __forceinline__ void ph_mod(const Ctx& c) {
    const Params& P = *c.P;
    float* cs = (float*)c.lds;
    float* part = cs + 8192;
    for (int i = c.tid; i < 8192; i += NTHREADS) cs[i] = silu_f(P.in[I_C][i]);
    __syncthreads();
    float* mod = (float*)(P.ws + WS_MOD);
    for (int item = c.bid; item < DEPTH_ * 96; item += c.nblk) {
        const int l = item / 96, j = (item % 96) * 64 + c.lane;
        const float* w = P.in[I_WADA] + (size_t)l * 1024 * 6144 + j;
        float acc[8];
#pragma unroll
        for (int b = 0; b < 8; ++b) acc[b] = 0.f;
        const int k0 = c.wave * 128;
#pragma unroll 8
        for (int k = k0; k < k0 + 128; ++k) { const float wv = w[(size_t)k * 6144];
#pragma unroll
            for (int b = 0; b < 8; ++b) acc[b] += cs[b * 1024 + k] * wv; }
#pragma unroll
        for (int b = 0; b < 8; ++b) part[(c.wave * 8 + b) * 64 + c.lane] = acc[b];
        __syncthreads();
        { const int b = c.tid >> 6, col = c.tid & 63; float s = 0.f;
#pragma unroll
          for (int w8 = 0; w8 < 8; ++w8) s += part[(w8 * 8 + b) * 64 + col];
          const int jj = (item % 96) * 64 + col;
          mod[((size_t)l * 8 + b) * 6144 + jj] = s + P.in[I_BADA][l * 6144 + jj]; }
        __syncthreads();
    }
}

__device__ __forceinline__ void store_bf16_row(bf16_t* row, int lane, const f32x4 (&v)[4]) {
#pragma unroll
    for (int j = 0; j < 4; ++j) { u32x2 w; w.x = pk2(v[j][0], v[j][1]); w.y = pk2(v[j][2], v[j][3]); *(u32x2*)(row + 4 * lane + 256 * j) = w; }
}
__device__ __forceinline__ void modulate(f32x4 (&h)[4], const f32x4 (&x)[4], const float* sh, const float* sc, int lane) {
#pragma unroll
    for (int j = 0; j < 4; ++j) { const f32x4 a = *(const f32x4*)(sc + 4 * lane + 256 * j), b = *(const f32x4*)(sh + 4 * lane + 256 * j); h[j] = x[j] * (1.f + a) + b; }
}
__device__ __forceinline__ void ln_rows(f32x4 (&v)[4], const float* g, const float* b, int lane) {
    float s = 0.f;
#pragma unroll
    for (int j = 0; j < 4; ++j) s += (v[j][0] + v[j][1]) + (v[j][2] + v[j][3]);
    const float mean = wave_sum(s) * (1.f / 1024.f); float s2 = 0.f;
#pragma unroll
    for (int j = 0; j < 4; ++j) { v[j] = v[j] - mean; s2 += (v[j][0] * v[j][0] + v[j][1] * v[j][1]) + (v[j][2] * v[j][2] + v[j][3] * v[j][3]); }
    const float rstd = 1.f / sqrtf(wave_sum(s2) * (1.f / 1024.f) + LN_EPS_);
#pragma unroll
    for (int j = 0; j < 4; ++j) { const f32x4 gg = *(const f32x4*)(g + 4 * lane + 256 * j), bb = *(const f32x4*)(b + 4 * lane + 256 * j); v[j] = v[j] * rstd * gg + bb; }
}

__device__ __forceinline__ void ph_prep0(const Ctx& c) {
    const Params& P = *c.P; const float* mod = (const float*)(P.ws + WS_MOD);
    bf16_t* H = (bf16_t*)(P.ws + WS_H);
    for (int t = c.gw; t < T_; t += c.ngw) {
        const int b = t / SEQ_; const float* xr = P.in[I_X] + (size_t)t * 1024;
        f32x4 x[4], h[4];
#pragma unroll
        for (int j = 0; j < 4; ++j) x[j] = *(const f32x4*)(xr + 4 * c.lane + 256 * j);
        modulate(h, x, mod + (size_t)b * 6144, mod + (size_t)b * 6144 + 1024, c.lane);
        store_bf16_row(H + (size_t)t * 1024, c.lane, h);
    }
}

struct DenseSched {
    const char* A; const char* Bt; int nM, nN, G, c;
    __device__ __forceinline__ bool next(int i, pg8::Unit& u) const {
        const int L = i * G + c; if (L >= nM * nN) return false;
        pg8::tile_of(L, nM, nN, u.pm, u.pn); u.e = 0; u.ridx = nullptr;
        u.a = A + (size_t)u.pm * 256 * 2048; u.b = Bt + (size_t)u.pn * 256 * 2048; return true; }
};
struct MoeSched {
    const char* A; const char* Bt; const int* blk_e; int nrb, nN, G, c; size_t estride; const int* rowtok; int gather;
    __device__ __forceinline__ bool next(int i, pg8::Unit& u) const {
        const int L = i * G + c; if (L >= nrb * nN) return false;
        pg8::tile_of(L, nrb, nN, u.pm, u.pn); u.e = blk_e[u.pm]; u.ridx = rowtok + u.pm * 256;
        u.a = gather ? A : A + (size_t)u.pm * 256 * 2048; u.b = Bt + (size_t)u.e * estride + (size_t)u.pn * 256 * 2048; return true; }
};
struct EpiStoreBf16 {
    static constexpr bool PERM = true;
    bf16_t* O; int ldc;
    __device__ __forceinline__ void operator()(const f32x4 (&acc)[2][2][4][2], const pg8::Unit& u, int wr, int wc, int fr, int fq) const {
        const int row0 = u.pm * 256 + wr * 64 + fr, col0 = u.pn * 256 + wc * 32 + 8 * fq;
#pragma unroll
        for (int ai = 0; ai < 2; ++ai)
#pragma unroll
            for (int m = 0; m < 4; ++m) { bf16_t* rowp = O + (size_t)(row0 + ai * 128 + m * 16) * ldc + col0;
#pragma unroll
                for (int bj = 0; bj < 2; ++bj) { const f32x4 v0 = acc[ai][bj][m][0], v1 = acc[ai][bj][m][1];
                    u32x4 w; w.x = pg8::cvt_pk_bf16(v0[0], v0[1]); w.y = pg8::cvt_pk_bf16(v0[2], v0[3]); w.z = pg8::cvt_pk_bf16(v1[0], v1[1]); w.w = pg8::cvt_pk_bf16(v1[2], v1[3]);
                    *(u32x4*)(rowp + bj * 128) = w; } }
    }
};
struct EpiResid {
    static constexpr bool PERM = false;
    const float* X; const float* gate; float* Z;
    __device__ __forceinline__ void operator()(const f32x4 (&acc)[2][2][4][2], const pg8::Unit& u, int wr, int wc, int fr, int fq) const {
        const int row0 = u.pm * 256 + wr * 64 + fr, col0 = u.pn * 256 + wc * 32 + 4 * fq;
        const float* gp = gate + (size_t)(u.pm >> 3) * 6144 + col0;
        f32x4 gv[2][2];
#pragma unroll
        for (int bj = 0; bj < 2; ++bj)
#pragma unroll
            for (int n = 0; n < 2; ++n) gv[bj][n] = *(const f32x4*)(gp + bj * 128 + n * 16);
#pragma unroll
        for (int ai = 0; ai < 2; ++ai)
#pragma unroll
            for (int m = 0; m < 4; ++m) { const size_t off = (size_t)(row0 + ai * 128 + m * 16) * 1024 + col0;
#pragma unroll
                for (int bj = 0; bj < 2; ++bj)
#pragma unroll
                    for (int n = 0; n < 2; ++n) { const f32x4 xv = *(const f32x4*)(X + off + bj * 128 + n * 16);
                        *(f32x4*)(Z + off + bj * 128 + n * 16) = xv * ALPHA_ + gv[bj][n] * acc[ai][bj][m][n]; } }
    }
};
struct EpiSwiglu {
    static constexpr bool PERM = true;
    bf16_t* ACT; const float* bup;
    __device__ __forceinline__ void operator()(const f32x4 (&acc)[2][2][4][2], const pg8::Unit& u, int wr, int wc, int fr, int fq) const {
        const int row0 = u.pm * 256 + wr * 64 + fr, j0 = u.pn * 128 + wc * 32 + 8 * fq;
        const float* bp = bup + (size_t)u.e * 2048 + j0;
        f32x4 bg[2], bl[2];
#pragma unroll
        for (int n = 0; n < 2; ++n) { bg[n] = *(const f32x4*)(bp + 4 * n); bl[n] = *(const f32x4*)(bp + 1024 + 4 * n); }
#pragma unroll
        for (int ai = 0; ai < 2; ++ai)
#pragma unroll
            for (int m = 0; m < 4; ++m) { float o[8];
#pragma unroll
                for (int n = 0; n < 2; ++n)
#pragma unroll
                    for (int q = 0; q < 4; ++q) { const float xg = fminf(acc[ai][0][m][n][q] + bg[n][q], 7.f); const float xl = fminf(fmaxf(acc[ai][1][m][n][q] + bl[n][q], -7.f), 7.f);
                        o[4 * n + q] = xg * sigmoid_f(1.702f * xg) * (xl + 1.f); }
                u32x4 w; w.x = pg8::cvt_pk_bf16(o[0], o[1]); w.y = pg8::cvt_pk_bf16(o[2], o[3]); w.z = pg8::cvt_pk_bf16(o[4], o[5]); w.w = pg8::cvt_pk_bf16(o[6], o[7]);
                *(u32x4*)(ACT + (size_t)(row0 + ai * 128 + m * 16) * 1024 + j0) = w; }
    }
};
struct EpiDown {
    static constexpr bool PERM = true;
    bf16_t* Y4; const float* bdn; const int* rowtok;
    __device__ __forceinline__ void operator()(const f32x4 (&acc)[2][2][4][2], const pg8::Unit& u, int wr, int wc, int fr, int fq) const {
        const int row0 = u.pm * 256 + wr * 64 + fr, col0 = u.pn * 256 + wc * 32 + 8 * fq;
        const float* bp = bdn + (size_t)u.e * 1024 + col0;
        f32x4 bv[2][2];
#pragma unroll
        for (int bj = 0; bj < 2; ++bj)
#pragma unroll
            for (int n = 0; n < 2; ++n) bv[bj][n] = *(const f32x4*)(bp + bj * 128 + 4 * n);
#pragma unroll
        for (int ai = 0; ai < 2; ++ai)
#pragma unroll
            for (int m = 0; m < 4; ++m) { const int a = rowtok[row0 + ai * 128 + m * 16];
                if (a >= 0) { bf16_t* rowp = Y4 + (size_t)a * 1024 + col0;
#pragma unroll
                    for (int bj = 0; bj < 2; ++bj) { const f32x4 v0 = acc[ai][bj][m][0] + bv[bj][0], v1 = acc[ai][bj][m][1] + bv[bj][1];
                        u32x4 w; w.x = pg8::cvt_pk_bf16(v0[0], v0[1]); w.y = pg8::cvt_pk_bf16(v0[2], v0[3]); w.z = pg8::cvt_pk_bf16(v1[0], v1[1]); w.w = pg8::cvt_pk_bf16(v1[2], v1[3]);
                        *(u32x4*)(rowp + bj * 128) = w; } } }
    }
};

__device__ __forceinline__ int t5_bucket(int n) { if (n < 16) return n; const int v = 16 + (int)(logf((float)n * (1.f / 16.f)) / logf(8.f) * 16.f); return v < 31 ? v : 31; }

constexpr int PL_W = 0, PL_U = 65536, PL_P = PL_U + 47 * 512, PL_END = PL_P + 256 * 32 * 4;
__device__ __forceinline__ void ph_pool(const Ctx& c, int l) {
    const Params& P = *c.P; const bf16_t* proj = (const bf16_t*)(P.ws + WS_PROJ); bf16_t* mix = (bf16_t*)(P.ws + WS_MIX);
    float* Wl = (float*)(c.lds + PL_W); bf16_t* us = (bf16_t*)(c.lds + PL_U); float* pt = (float*)(c.lds + PL_P);
    if (c.bid >= T_ / 32) return;
    { const f32x4* pw = (const f32x4*)(P.in[I_POOLW] + (size_t)l * 16384);
      for (int i = c.tid; i < 4096; i += NTHREADS) ((f32x4*)Wl)[i] = pw[i]; }
    const int ch = c.tid & 255, th = c.tid >> 8, gi = ch >> 6, w = 2 << gi;
    const float psc = P.in[I_POOLS][l * 256 + ch];
    for (int tile = c.bid; tile < T_ / 32; tile += c.nblk) {
        const int t0 = tile * 32, s0 = t0 % SEQ_;
        __syncthreads();
        for (int i = c.tid; i < 47 * 32; i += NTHREADS) { const int r = i >> 5, c8 = i & 31; u32x4 v = (u32x4){0u, 0u, 0u, 0u};
            if (s0 - 15 + r >= 0) v = *(const u32x4*)(proj + (size_t)(t0 - 15 + r) * NPROJ + C_POOL + 8 * c8);
            *(u32x4*)(us + r * 256 + 8 * c8) = v; }
        __syncthreads();
        {
            const int i0 = th * 16; float sum = 0.f;
            for (int j = 1; j < w; ++j) sum += bf2f(us[(15 + i0 - j) * 256 + ch]);
#pragma unroll 4
            for (int i = i0; i < i0 + 16; ++i) { const float ui = bf2f(us[(15 + i) * 256 + ch]); sum += ui;
                const int s = s0 + i; const float cnt = (float)((s + 1) < w ? (s + 1) : w);
                pt[ch * 32 + i] = sum / cnt - ui;
                sum -= bf2f(us[(15 + i - (w - 1)) * 256 + ch]); } }
        __syncthreads();
        {
            const int d = ch & 63; float acc[16];
#pragma unroll
            for (int i = 0; i < 16; ++i) acc[i] = 0.f;
            const float* wp = Wl + gi * 4096 + d; const float* pp = pt + (gi * 64) * 32 + th * 16;
#pragma unroll 4
            for (int k = 0; k < 64; ++k) { const float wv = wp[k * 64]; const f32x4 a = *(const f32x4*)(pp + k * 32), b = *(const f32x4*)(pp + k * 32 + 4), cc = *(const f32x4*)(pp + k * 32 + 8), dd = *(const f32x4*)(pp + k * 32 + 12);
#pragma unroll
                for (int q = 0; q < 4; ++q) { acc[q] += a[q] * wv; acc[4 + q] += b[q] * wv; acc[8 + q] += cc[q] * wv; acc[12 + q] += dd[q] * wv; } }
#pragma unroll
            for (int i = 0; i < 16; ++i) mix[(size_t)(t0 + th * 16 + i) * 1024 + ch] = (bf16_t)f2bf(acc[i] * psc); }
    }
    __syncthreads();
}
__device__ __forceinline__ void swa_item(const Ctx& c, int l, int item, float* wl) {
    const Params& P = *c.P; const bf16_t* proj = (const bf16_t*)(P.ws + WS_PROJ); bf16_t* mix = (bf16_t*)(P.ws + WS_MIX);
    float* qs = wl; float* pr = wl + 64;
    const int t = item / 6, hq = item % 6, kvh = hq / 3, s = t % SEQ_, lane = c.lane;
    qs[lane] = bf2f(proj[(size_t)t * NPROJ + C_AQ + hq * 64 + lane]);
    asm volatile("s_waitcnt lgkmcnt(0)" ::: "memory");
    const float sink = P.in[I_SINKS][l * 6 + hq];
    float sc[2];
#pragma unroll
    for (int h2 = 0; h2 < 2; ++h2) { const int kk = lane + 64 * h2, dist = 127 - kk, sk = s - dist;
        float dot = -1e30f;
        if (sk >= 0) { const bf16_t* kr = proj + (size_t)(t - dist) * NPROJ + C_AK + kvh * 64; float a = 0.f;
#pragma unroll
            for (int d8 = 0; d8 < 8; ++d8) { const u32x4 kv = *(const u32x4*)(kr + d8 * 8);
                a += qs[d8 * 8 + 0] * bflo(kv.x) + qs[d8 * 8 + 1] * bfhi(kv.x) + qs[d8 * 8 + 2] * bflo(kv.y) + qs[d8 * 8 + 3] * bfhi(kv.y)
                   + qs[d8 * 8 + 4] * bflo(kv.z) + qs[d8 * 8 + 5] * bfhi(kv.z) + qs[d8 * 8 + 6] * bflo(kv.w) + qs[d8 * 8 + 7] * bfhi(kv.w); }
            dot = a * 0.125f + P.in[I_RELB][t5_bucket(dist) * 6 + hq]; }
        sc[h2] = dot; }
    const float m = fmaxf(wave_max(fmaxf(sc[0], sc[1])), sink);
    const float p0 = (sc[0] > -1e29f) ? __expf(sc[0] - m) : 0.f, p1 = (sc[1] > -1e29f) ? __expf(sc[1] - m) : 0.f;
    const float den = wave_sum(p0 + p1) + __expf(sink - m);
    pr[lane] = p0; pr[lane + 64] = p1;
    asm volatile("s_waitcnt lgkmcnt(0)" ::: "memory");
    float o = 0.f;
    const int kk0 = (s >= 127) ? 0 : (127 - s);
    for (int kk = kk0; kk < 128; ++kk) o += pr[kk] * bf2f(proj[(size_t)(t - 127 + kk) * NPROJ + C_AV + kvh * 64 + lane]);
    mix[(size_t)t * 1024 + 256 + hq * 64 + lane] = (bf16_t)f2bf(o / den);
    asm volatile("s_waitcnt lgkmcnt(0)" ::: "memory");
}
constexpr int SW_KS = 0, SW_KROW = 144, SW_VT = 272 * 144, SW_VROW = 552, SW_BIAS = SW_VT + 64 * SW_VROW, SW_END = SW_BIAS + 3 * 128 * 4;
__device__ __forceinline__ void swa_mfma_item(const Ctx& c, int l, int item) {
    const Params& P = *c.P; const bf16_t* proj = (const bf16_t*)(P.ws + WS_PROJ); bf16_t* mix = (bf16_t*)(P.ws + WS_MIX);
    unsigned char* Ks = c.lds + SW_KS; unsigned char* Vt = c.lds + SW_VT; float* bias_s = (float*)(c.lds + SW_BIAS);
    const int b = item >> 5, n = (item >> 1) & 15, kvh = item & 1;
    const int tok0 = b * SEQ_ + n * 128;
    __syncthreads();
#pragma unroll
    for (int i = 0; i < 4; ++i) { const int idx = c.tid + i * NTHREADS, j = idx >> 3, ch = idx & 7; const bool ok = (n > 0) || (j >= 128);
        u32x4 kv = (u32x4){0u, 0u, 0u, 0u}, vv = kv;
        if (ok) { const bf16_t* rp = proj + (size_t)(tok0 - 128 + j) * NPROJ; kv = *(const u32x4*)(rp + C_AK + kvh * 64 + 8 * ch); vv = *(const u32x4*)(rp + C_AV + kvh * 64 + 8 * ch); }
        *(u32x4*)(Ks + j * SW_KROW + 16 * ch) = kv;
        unsigned short* vt = (unsigned short*)(Vt + (8 * ch) * SW_VROW + 2 * j);
        vt[0 * (SW_VROW / 2)] = (unsigned short)(vv.x & 0xffff); vt[1 * (SW_VROW / 2)] = (unsigned short)(vv.x >> 16);
        vt[2 * (SW_VROW / 2)] = (unsigned short)(vv.y & 0xffff); vt[3 * (SW_VROW / 2)] = (unsigned short)(vv.y >> 16);
        vt[4 * (SW_VROW / 2)] = (unsigned short)(vv.z & 0xffff); vt[5 * (SW_VROW / 2)] = (unsigned short)(vv.z >> 16);
        vt[6 * (SW_VROW / 2)] = (unsigned short)(vv.w & 0xffff); vt[7 * (SW_VROW / 2)] = (unsigned short)(vv.w >> 16); }
    if (c.tid < 144) *(u32x4*)(Ks + 256 * SW_KROW + 16 * c.tid) = (u32x4){0u, 0u, 0u, 0u};
    if (c.tid < 128) { const int d = c.tid >> 1, hf = c.tid & 1; *(u32x4*)(Vt + d * SW_VROW + 512 + 16 * hf) = (u32x4){0u, 0u, 0u, 0u}; }
    if (c.tid < 384) { const int g = c.tid >> 7, dist = c.tid & 127; bias_s[c.tid] = P.in[I_RELB][t5_bucket(dist) * 6 + kvh * 3 + g]; }
    __syncthreads();
    const int lane = c.lane, qc = lane & 15, q4 = lane >> 4, i0 = 16 * c.wave, jw = i0;
    const int iq0 = i0 + qc;
#pragma unroll 1
    for (int g = 0; g < 3; ++g) {
        asm volatile("" ::: "memory");
        int iq = iq0; asm volatile("" : "+v"(iq));
        const int hq = kvh * 3 + g; const float sink = P.in[I_SINKS][l * 6 + hq];
        const bf16_t* qp = proj + (size_t)(tok0 + iq) * NPROJ + C_AQ + hq * 64 + 8 * q4;
        const bf16x8 bq0 = *(const bf16x8*)(qp), bq1 = *(const bf16x8*)(qp + 32);
        f32x4 s[10];
#pragma unroll
        for (int kt = 0; kt < 10; ++kt) { const unsigned char* kp = Ks + (jw + 16 * kt + qc) * SW_KROW + 16 * q4;
            const bf16x8 a0 = *(const bf16x8*)(kp), a1 = *(const bf16x8*)(kp + 64);
            f32x4 acc = (f32x4){0.f, 0.f, 0.f, 0.f};
            acc = __builtin_amdgcn_mfma_f32_16x16x32_bf16(a0, bq0, acc, 0, 0, 0);
            acc = __builtin_amdgcn_mfma_f32_16x16x32_bf16(a1, bq1, acc, 0, 0, 0);
            s[kt] = acc; }
        float m = -1e30f;
        const int nz = (n == 0) ? -1 : 0;
#pragma unroll
        for (int kt = 0; kt < 10; ++kt)
#pragma unroll
            for (int r = 0; r < 4; ++r) { const int j = jw + 16 * kt + 4 * q4 + r, dist = iq + 128 - j;
                const unsigned mk = (unsigned)(~((dist | (127 - dist)) >> 31)) & ~((unsigned)((j - 128) >> 31) & (unsigned)nz);
                const float val = s[kt][r] * 0.125f + bias_s[g * 128 + (dist & 127)];
                const float v = __builtin_bit_cast(float, (__builtin_bit_cast(unsigned, val) & mk) | (0xf149f2cau & ~mk));
                s[kt][r] = v; m = fmaxf(m, v); }
        m = fmaxf(m, __shfl_xor(m, 16)); m = fmaxf(m, __shfl_xor(m, 32)); m = fmaxf(m, sink);
        float sum = 0.f;
#pragma unroll
        for (int kt = 0; kt < 10; ++kt)
#pragma unroll
            for (int r = 0; r < 4; ++r) { const float pv = __expf(s[kt][r] - m); s[kt][r] = pv; sum += pv; }
        sum += __shfl_xor(sum, 16); sum += __shfl_xor(sum, 32);
        const float rden = 1.f / (sum + __expf(sink - m));
        f32x4 o[4];
#pragma unroll
        for (int dt = 0; dt < 4; ++dt) o[dt] = (f32x4){0.f, 0.f, 0.f, 0.f};
#pragma unroll
        for (int k5 = 0; k5 < 5; ++k5) {
            u32x4 pw; pw.x = pk2(s[2 * k5][0], s[2 * k5][1]); pw.y = pk2(s[2 * k5][2], s[2 * k5][3]); pw.z = pk2(s[2 * k5 + 1][0], s[2 * k5 + 1][1]); pw.w = pk2(s[2 * k5 + 1][2], s[2 * k5 + 1][3]);
            const bf16x8 pb = __builtin_bit_cast(bf16x8, pw);
#pragma unroll
            for (int dt = 0; dt < 4; ++dt) { const unsigned char* vp = Vt + (16 * dt + qc) * SW_VROW + 2 * (jw + 32 * k5 + 4 * q4);
                const u32x2 lo = *(const u32x2*)(vp), hi = *(const u32x2*)(vp + 32);
                const bf16x8 av = __builtin_bit_cast(bf16x8, (u32x4){lo.x, lo.y, hi.x, hi.y});
                o[dt] = __builtin_amdgcn_mfma_f32_16x16x32_bf16(av, pb, o[dt], 0, 0, 0); } }
        bf16_t* op = mix + (size_t)(tok0 + iq) * 1024 + 256 + hq * 64 + 4 * q4;
#pragma unroll
        for (int dt = 0; dt < 4; ++dt) { u32x2 w; w.x = pk2(o[dt][0] * rden, o[dt][1] * rden); w.y = pk2(o[dt][2] * rden, o[dt][3] * rden); *(u32x2*)(op + 16 * dt) = w; }
    }
}
__device__ __forceinline__ void gdn_prep_tok(const Ctx& c, int l, int t) {
    const Params& P = *c.P; const bf16_t* proj = (const bf16_t*)(P.ws + WS_PROJ); const int lane = c.lane, s = t % SEQ_;
    float* QN = (float*)(P.ws + WS_QN); float* KN = (float*)(P.ws + WS_KN); float* VV = (float*)(P.ws + WS_VV); float* GB = (float*)(P.ws + WS_GB);
    const float* cw = P.in[I_CONVW] + (size_t)l * 4 * 1152;
#pragma unroll 1
    for (int grp = 0; grp < 18; ++grp) { const int ch = grp * 64 + lane; float a = 0.f;
#pragma unroll
        for (int j = 0; j < 4; ++j) { const int sj = s - 3 + j; if (sj >= 0) a += cw[j * 1152 + ch] * bf2f(proj[(size_t)(t - 3 + j) * NPROJ + C_GQ + ch]); }
        a = silu_f(a);
        if (grp < 12) { const float ss = wave_sum(a * a); a = a * (1.f / sqrtf(ss + NORM_EPS_)); }
        if (grp < 6) QN[(size_t)t * 384 + ch] = a * 0.125f;
        else if (grp < 12) KN[(size_t)t * 384 + (ch - 384)] = a;
        else VV[(size_t)t * 384 + (ch - 768)] = a; }
    if (lane < 6) { const float braw = bf2f(proj[(size_t)t * NPROJ + C_GB + lane]), araw = bf2f(proj[(size_t)t * NPROJ + C_GA + lane]);
        const float xx = araw + P.in[I_DTB][l * 6 + lane]; const float sp = xx > 20.f ? xx : log1pf(__expf(xx));
        GB[(size_t)t * 12 + lane] = -__expf(P.in[I_ALOG][l * 6 + lane]) * sp; GB[(size_t)t * 12 + 6 + lane] = sigmoid_f(braw); }
}
__device__ __forceinline__ void ph_gprep(const Ctx& c, int l);
__device__ __forceinline__ void ph_gscan(const Ctx& c) {
    const Params& P = *c.P;
    const float* QN = (const float*)(P.ws + WS_QN); const float* KN = (const float*)(P.ws + WS_KN); const float* VV = (const float*)(P.ws + WS_VV); const float* GB = (const float*)(P.ws + WS_GB);
    float* OR = (float*)(P.ws + WS_OR);
    float* ks = (float*)c.lds; float* qs = ks + 4096; float* vs = qs + 4096; float* gs = vs + 4096; float* bs = gs + 64;
    const int j = c.tid >> 3, p = c.tid & 7;
    for (int item = c.bid; item < NB_ * 6; item += c.nblk) {
        const int b = item / 6, h = item % 6;
        float S[8];
#pragma unroll
        for (int i = 0; i < 8; ++i) S[i] = 0.f;
        for (int ch = 0; ch < SEQ_ / 64; ++ch) {
            const int tb = b * SEQ_ + ch * 64;
            __syncthreads();
            for (int i = c.tid; i < 4096; i += NTHREADS) { const int r = i >> 6, d = i & 63; const size_t g = (size_t)(tb + r) * 384 + h * 64 + d; ks[i] = KN[g]; qs[i] = QN[g]; vs[i] = VV[g]; }
            if (c.tid < 64) { gs[c.tid] = __expf(GB[(size_t)(tb + c.tid) * 12 + h]); bs[c.tid] = GB[(size_t)(tb + c.tid) * 12 + 6 + h]; }
            __syncthreads();
            for (int r = 0; r < 64; ++r) {
                const float eg = gs[r], be = bs[r]; float kk[8], qq[8];
#pragma unroll
                for (int i = 0; i < 8; ++i) { kk[i] = ks[r * 64 + p * 8 + i]; qq[i] = qs[r * 64 + p * 8 + i]; }
                float kS = 0.f;
#pragma unroll
                for (int i = 0; i < 8; ++i) { S[i] *= eg; kS += kk[i] * S[i]; }
                kS += __shfl_xor(kS, 1); kS += __shfl_xor(kS, 2); kS += __shfl_xor(kS, 4);
                const float dl = be * (vs[r * 64 + j] - kS); float o = 0.f;
#pragma unroll
                for (int i = 0; i < 8; ++i) { S[i] += kk[i] * dl; o += qq[i] * S[i]; }
                o += __shfl_xor(o, 1); o += __shfl_xor(o, 2); o += __shfl_xor(o, 4);
                if (p == 0) OR[(size_t)(tb + r) * 384 + h * 64 + j] = o;
            }
        }
    }
}
constexpr size_t WS_GOP = WS_QN;
constexpr size_t WS_GCD = WS_QN + 64 * MiB;
constexpr int GOP_BYTES = 40960, GOP_W = 0, GOP_QD = 8192, GOP_AT = 16384, GOP_KT = 24576, GOP_U = 32768;
constexpr int GP_HALF = 55296, GP_RAW = 0, GP_LS = 0, GP_WT = 16384, GP_KB = 25728, GP_QB = 34944, GP_VB = 44160, GP_GT = 53376, GP_ROW = 144;

__device__ __forceinline__ void gdn_subst(float (&x)[64], const float* Ls, int lane) {
#pragma unroll
    for (int j = 0; j < 63; ++j) {
        const int col = __builtin_bit_cast(int, Ls[j * 64 + lane]);
        const float xj = x[j];
#pragma unroll
        for (int i = j + 1; i < 64; ++i) x[i] -= __builtin_bit_cast(float, __builtin_amdgcn_readlane(col, i)) * xj;
    }
}
__device__ __forceinline__ void gdn_prep_pair(const Ctx& c, int l, int item, bool active) {
    const Params& P = *c.P; const bf16_t* proj = (const bf16_t*)(P.ws + WS_PROJ);
    const int half = c.wave >> 2, hw = c.wave & 3, lane = c.lane, htid = c.tid & 255, qc = lane & 15, q4 = lane >> 4;
    unsigned char* L0 = c.lds + half * GP_HALF;
    bf16_t* raw = (bf16_t*)(L0 + GP_RAW); float* Ls = (float*)(L0 + GP_LS); unsigned char* WT = L0 + GP_WT;
    unsigned char* KB = L0 + GP_KB; unsigned char* QB = L0 + GP_QB; unsigned char* VB = L0 + GP_VB;
    float* gc = (float*)(L0 + GP_GT); float* eg = gc + 64; float* bt = gc + 128;
    const int h = item % 6, n = (item / 6) & 31, b = item / 192;
    const int tb = b * SEQ_ + n * 64;
    const int ci = (b * 6 + h) * 32 + n;
    unsigned char* gop = P.ws + WS_GOP + (size_t)ci * GOP_BYTES;
    __syncthreads();
    if (active) {
        for (int idx = htid; idx < 67 * 24; idx += 256) { const int r = idx / 24, ch = idx % 24, grp = ch >> 3, c8 = ch & 7;
            u32x4 v = (u32x4){0u, 0u, 0u, 0u};
            if (n * 64 + r - 3 >= 0) v = *(const u32x4*)(proj + (size_t)(tb + r - 3) * NPROJ + C_GQ + grp * 384 + h * 64 + 8 * c8);
            *(u32x4*)((unsigned char*)raw + r * 384 + ch * 16) = v; }
        if (hw == 0) { const float braw = bf2f(proj[(size_t)(tb + lane) * NPROJ + C_GB + h]), araw = bf2f(proj[(size_t)(tb + lane) * NPROJ + C_GA + h]);
            const float xx = araw + P.in[I_DTB][l * 6 + h]; const float sp = xx > 20.f ? xx : log1pf(__expf(xx));
            float g = -__expf(P.in[I_ALOG][l * 6 + h]) * sp;
#pragma unroll
            for (int o = 1; o < 64; o <<= 1) { const float t = __shfl_up(g, o); if (lane >= o) g += t; }
            gc[lane] = g; eg[lane] = __expf(g); bt[lane] = sigmoid_f(braw); }
    }
    __syncthreads();
    if (active) {
        const float* cw = P.in[I_CONVW] + (size_t)l * 4 * 1152 + h * 64 + lane;
        float wq[4], wk[4], wv[4];
#pragma unroll
        for (int j = 0; j < 4; ++j) { wq[j] = cw[j * 1152]; wk[j] = cw[j * 1152 + 384]; wv[j] = cw[j * 1152 + 768]; }
#pragma unroll 4
        for (int ii = 16 * hw; ii < 16 * hw + 16; ++ii) { float aq = 0.f, ak = 0.f, av = 0.f;
#pragma unroll
            for (int j = 0; j < 4; ++j) { const bf16_t* rr = raw + (ii + j) * 192 + lane; aq += wq[j] * bf2f(rr[0]); ak += wk[j] * bf2f(rr[64]); av += wv[j] * bf2f(rr[128]); }
            aq = silu_f(aq); ak = silu_f(ak); av = silu_f(av);
            const float sq = wave_sum(aq * aq), sk = wave_sum(ak * ak);
            aq *= 0.125f / sqrtf(sq + NORM_EPS_); ak *= 1.f / sqrtf(sk + NORM_EPS_);
            *(bf16_t*)(QB + ii * GP_ROW + 2 * lane) = (bf16_t)f2bf(aq); *(bf16_t*)(KB + ii * GP_ROW + 2 * lane) = (bf16_t)f2bf(ak); *(bf16_t*)(VB + ii * GP_ROW + 2 * lane) = (bf16_t)f2bf(av); }
    }
    __syncthreads();
    if (active) {
        bf16x8 ka[2], qa[2];
#pragma unroll
        for (int ks = 0; ks < 2; ++ks) { ka[ks] = *(const bf16x8*)(KB + (16 * hw + qc) * GP_ROW + 64 * ks + 16 * q4); qa[ks] = *(const bf16x8*)(QB + (16 * hw + qc) * GP_ROW + 64 * ks + 16 * q4); }
        f32x4 at[4];
#pragma unroll
        for (int t = 0; t < 4; ++t) at[t] = (f32x4){0.f, 0.f, 0.f, 0.f};
#pragma unroll
        for (int ct = 0; ct < 4; ++ct) if (ct <= hw) {
            bf16x8 kb2[2];
#pragma unroll
            for (int ks = 0; ks < 2; ++ks) kb2[ks] = *(const bf16x8*)(KB + (16 * ct + qc) * GP_ROW + 64 * ks + 16 * q4);
            f32x4 acc = (f32x4){0.f, 0.f, 0.f, 0.f};
            acc = __builtin_amdgcn_mfma_f32_16x16x32_bf16(ka[0], kb2[0], acc, 0, 0, 0); acc = __builtin_amdgcn_mfma_f32_16x16x32_bf16(ka[1], kb2[1], acc, 0, 0, 0);
            { const int j = 16 * ct + qc; const float gj = gc[j]; f32x4 lv;
#pragma unroll
              for (int r = 0; r < 4; ++r) { const int i = 16 * hw + 4 * q4 + r; lv[r] = (i > j) ? bt[i] * acc[r] * __expf(gc[i] - gj) : 0.f; }
              *(f32x4*)(Ls + j * 64 + 16 * hw + 4 * q4) = lv; }
            f32x4 a2 = (f32x4){0.f, 0.f, 0.f, 0.f};
            a2 = __builtin_amdgcn_mfma_f32_16x16x32_bf16(kb2[0], qa[0], a2, 0, 0, 0); a2 = __builtin_amdgcn_mfma_f32_16x16x32_bf16(kb2[1], qa[1], a2, 0, 0, 0);
            { const int i = 16 * hw + qc; const float gi = gc[i];
#pragma unroll
              for (int r = 0; r < 4; ++r) { const int j = 16 * ct + 4 * q4 + r; at[ct][r] = (i >= j) ? a2[r] * __expf(gi - gc[j]) : 0.f; } }
        }
#pragma unroll
        for (int ks = 0; ks < 2; ++ks) { u32x4 w; w.x = pk2(at[2 * ks][0], at[2 * ks][1]); w.y = pk2(at[2 * ks][2], at[2 * ks][3]); w.z = pk2(at[2 * ks + 1][0], at[2 * ks + 1][1]); w.w = pk2(at[2 * ks + 1][2], at[2 * ks + 1][3]);
            *(u32x4*)(gop + GOP_AT + (hw * 2 + ks) * 1024 + lane * 16) = w; }
    }
    __syncthreads();
    if (active) {
        if (hw == 0) { float x[64];
#pragma unroll
            for (int i = 0; i < 64; ++i) x[i] = bt[i] * bf2f(*(const bf16_t*)(VB + i * GP_ROW + 2 * lane));
            gdn_subst(x, Ls, lane);
            unsigned char* up = gop + GOP_U + (lane >> 4) * 2048 + (lane & 15) * 32;
#pragma unroll
            for (int rt = 0; rt < 4; ++rt)
#pragma unroll
                for (int qq = 0; qq < 4; ++qq) { u32x2 w; w.x = pk2(x[16 * rt + 4 * qq], x[16 * rt + 4 * qq + 1]); w.y = pk2(x[16 * rt + 4 * qq + 2], x[16 * rt + 4 * qq + 3]); *(u32x2*)(up + qq * 512 + rt * 8) = w; }
        } else if (hw == 1) { float x[64];
#pragma unroll
            for (int i = 0; i < 64; ++i) x[i] = bt[i] * eg[i] * bf2f(*(const bf16_t*)(KB + i * GP_ROW + 2 * lane));
            gdn_subst(x, Ls, lane);
#pragma unroll
            for (int i = 0; i < 64; ++i) *(bf16_t*)(WT + i * GP_ROW + 2 * lane) = (bf16_t)f2bf(x[i]);
            asm volatile("s_waitcnt lgkmcnt(0)" ::: "memory");
#pragma unroll
            for (int mt = 0; mt < 4; ++mt)
#pragma unroll
                for (int ks = 0; ks < 2; ++ks) { const unsigned char* wp = WT + (16 * mt + qc) * GP_ROW + 64 * ks + 8 * q4; const u32x2 lo = *(const u32x2*)(wp), hi = *(const u32x2*)(wp + 32);
                    *(u32x4*)(gop + GOP_W + (mt * 2 + ks) * 1024 + lane * 16) = (u32x4){lo.x, lo.y, hi.x, hi.y}; }
        } else if (hw == 2) {
#pragma unroll
            for (int mt = 0; mt < 4; ++mt) { const float e = eg[16 * mt + qc];
#pragma unroll
                for (int ks = 0; ks < 2; ++ks) { const unsigned char* qp = QB + (16 * mt + qc) * GP_ROW + 64 * ks + 8 * q4; const u32x2 lo = *(const u32x2*)(qp), hi = *(const u32x2*)(qp + 32);
                    u32x4 w; w.x = pk2(bflo(lo.x) * e, bfhi(lo.x) * e); w.y = pk2(bflo(lo.y) * e, bfhi(lo.y) * e); w.z = pk2(bflo(hi.x) * e, bfhi(hi.x) * e); w.w = pk2(bflo(hi.y) * e, bfhi(hi.y) * e);
                    *(u32x4*)(gop + GOP_QD + (mt * 2 + ks) * 1024 + lane * 16) = w; } }
        } else { const float gl = gc[63];
#pragma unroll
            for (int mt = 0; mt < 4; ++mt)
#pragma unroll
                for (int ks = 0; ks < 2; ++ks) { float v[8];
#pragma unroll
                    for (int e = 0; e < 8; ++e) { const int i = 32 * ks + 4 * q4 + (e < 4 ? e : 12 + e); v[e] = bf2f(*(const bf16_t*)(KB + i * GP_ROW + 2 * (16 * mt + qc))) * __expf(gl - gc[i]); }
                    u32x4 w; w.x = pk2(v[0], v[1]); w.y = pk2(v[2], v[3]); w.z = pk2(v[4], v[5]); w.w = pk2(v[6], v[7]);
                    *(u32x4*)(gop + GOP_KT + (mt * 2 + ks) * 1024 + lane * 16) = w; }
            if (lane == 0) ((float*)(P.ws + WS_GCD))[ci] = eg[63];
        }
    }
}
__device__ __forceinline__ void ph_gprep(const Ctx& c, int l) {
    const int half = c.wave >> 2, nit = NB_ * 32 * 6, npair = (nit + 1) / 2;
    for (int pr = c.bid; pr < npair; pr += c.nblk) { const int item = 2 * pr + half; gdn_prep_pair(c, l, item < nit ? item : nit - 1, item < nit); }
    __syncthreads();
}
__device__ __forceinline__ void ph_gscan2(const Ctx& c) {
    const Params& P = *c.P; float* OR = (float*)(P.ws + WS_OR); const float* CD = (const float*)(P.ws + WS_GCD);
    const int lane = c.lane, qc = lane & 15, q4 = lane >> 4;
    if (c.wave >= 4) return;
    for (int bh = c.bid; bh < NB_ * 6; bh += c.nblk) {
        const int b = bh / 6, h = bh % 6, s = c.wave;
        f32x4 S[4];
#pragma unroll
        for (int t = 0; t < 4; ++t) S[t] = (f32x4){0.f, 0.f, 0.f, 0.f};
#pragma unroll 1
        for (int n = 0; n < 32; ++n) {
            const int ci = bh * 32 + n; const unsigned char* gop = P.ws + WS_GOP + (size_t)ci * GOP_BYTES;
            const float cd = CD[ci];
            bf16x8 sb[2];
#pragma unroll
            for (int ks = 0; ks < 2; ++ks) { u32x4 w; w.x = pk2(S[2 * ks][0], S[2 * ks][1]); w.y = pk2(S[2 * ks][2], S[2 * ks][3]); w.z = pk2(S[2 * ks + 1][0], S[2 * ks + 1][1]); w.w = pk2(S[2 * ks + 1][2], S[2 * ks + 1][3]); sb[ks] = __builtin_bit_cast(bf16x8, w); }
            const u32x4 u0 = *(const u32x4*)(gop + GOP_U + s * 2048 + lane * 32), u1 = *(const u32x4*)(gop + GOP_U + s * 2048 + lane * 32 + 16);
            f32x4 vn[4], o[4];
#pragma unroll
            for (int mt = 0; mt < 4; ++mt) { f32x4 p1 = (f32x4){0.f, 0.f, 0.f, 0.f}, q1 = p1;
#pragma unroll
                for (int ks = 0; ks < 2; ++ks) { const bf16x8 wf = *(const bf16x8*)(gop + GOP_W + (mt * 2 + ks) * 1024 + lane * 16), qf = *(const bf16x8*)(gop + GOP_QD + (mt * 2 + ks) * 1024 + lane * 16);
                    p1 = __builtin_amdgcn_mfma_f32_16x16x32_bf16(wf, sb[ks], p1, 0, 0, 0); q1 = __builtin_amdgcn_mfma_f32_16x16x32_bf16(qf, sb[ks], q1, 0, 0, 0); }
                const unsigned ua = (mt == 0) ? u0.x : (mt == 1) ? u0.z : (mt == 2) ? u1.x : u1.z, ub = (mt == 0) ? u0.y : (mt == 1) ? u0.w : (mt == 2) ? u1.y : u1.w;
                vn[mt] = (f32x4){bflo(ua), bfhi(ua), bflo(ub), bfhi(ub)} - p1; o[mt] = q1; }
            bf16x8 vb[2];
#pragma unroll
            for (int ks = 0; ks < 2; ++ks) { u32x4 w; w.x = pk2(vn[2 * ks][0], vn[2 * ks][1]); w.y = pk2(vn[2 * ks][2], vn[2 * ks][3]); w.z = pk2(vn[2 * ks + 1][0], vn[2 * ks + 1][1]); w.w = pk2(vn[2 * ks + 1][2], vn[2 * ks + 1][3]); vb[ks] = __builtin_bit_cast(bf16x8, w); }
#pragma unroll
            for (int mt = 0; mt < 4; ++mt) { S[mt] = S[mt] * cd;
#pragma unroll
                for (int ks = 0; ks < 2; ++ks) { const bf16x8 af = *(const bf16x8*)(gop + GOP_AT + (mt * 2 + ks) * 1024 + lane * 16), kf = *(const bf16x8*)(gop + GOP_KT + (mt * 2 + ks) * 1024 + lane * 16);
                    o[mt] = __builtin_amdgcn_mfma_f32_16x16x32_bf16(af, vb[ks], o[mt], 0, 0, 0); S[mt] = __builtin_amdgcn_mfma_f32_16x16x32_bf16(kf, vb[ks], S[mt], 0, 0, 0); } }
            float* op = OR + (size_t)(b * SEQ_ + n * 64 + 4 * q4) * 384 + h * 64 + 16 * s + qc;
#pragma unroll
            for (int mt = 0; mt < 4; ++mt)
#pragma unroll
                for (int r = 0; r < 4; ++r) op[(size_t)(16 * mt + r) * 384] = o[mt][r];
        }
    }
}
__device__ __forceinline__ void ph_gout(const Ctx& c, int l) {
    const Params& P = *c.P; const bf16_t* proj = (const bf16_t*)(P.ws + WS_PROJ); bf16_t* mix = (bf16_t*)(P.ws + WS_MIX); const float* OR = (const float*)(P.ws + WS_OR);
    const float nw = P.in[I_NORMW][l * 64 + c.lane];
    for (int t = c.gw; t < T_; t += c.ngw) {
#pragma unroll
        for (int h = 0; h < 6; ++h) { const float o = OR[(size_t)t * 384 + h * 64 + c.lane]; const float ms = wave_sum(o * o) * (1.f / 64.f);
            const float z = bf2f(proj[(size_t)t * NPROJ + C_GZ + h * 64 + c.lane]);
            mix[(size_t)t * 1024 + 640 + h * 64 + c.lane] = (bf16_t)f2bf(o * (1.f / sqrtf(ms + NORM_EPS_)) * nw * silu_f(z)); }
    }
}

template <int N, int B> __device__ __forceinline__ void xred_step(const float (&p)[N], float (&q)[N / 2], int lane) {
    const bool up = (lane & B) != 0;
#pragma unroll
    for (int i = 0; i < N / 2; ++i) { const float keep = up ? p[i + N / 2] : p[i], send = up ? p[i] : p[i + N / 2]; q[i] = keep + __shfl_xor(send, B); }
}
__device__ __forceinline__ float xred32(const float (&p)[32], int lane) {
    float a[16], b[8], c4[4], d[2], e[1];
    xred_step<32, 32>(p, a, lane); xred_step<16, 16>(a, b, lane); xred_step<8, 8>(b, c4, lane); xred_step<4, 4>(c4, d, lane); xred_step<2, 2>(d, e, lane);
    return e[0] + __shfl_xor(e[0], 1);
}
__device__ __forceinline__ void top4_store(float mylg, int lane, int* ti, float* tg) {
    int bi[4]; float bv[4];
#pragma unroll
    for (int k = 0; k < 4; ++k) { const float best = wave_max(mylg); const unsigned long long bal = __ballot(mylg == best); const int id = (__ffsll((long long)bal) - 1) >> 1;
        if ((lane >> 1) == id) mylg = -3.0e38f;
        bi[k] = id; bv[k] = best; }
    const float e1 = __expf(bv[1] - bv[0]), e2 = __expf(bv[2] - bv[0]), e3 = __expf(bv[3] - bv[0]), inv = 1.f / (1.f + e1 + e2 + e3);
    if (lane == 0) { *(int4*)ti = make_int4(bi[0], bi[1], bi[2], bi[3]); *(f32x4*)tg = (f32x4){inv, e1 * inv, e2 * inv, e3 * inv}; }
}
__device__ __forceinline__ void ph_ln1(const Ctx& c, int l) {
    const Params& P = *c.P; const float* mod = (const float*)(P.ws + WS_MOD) + (size_t)l * 8 * 6144;
    const float* Z = (const float*)(P.ws + WS_Z); float* X1 = (float*)(P.ws + WS_X1); bf16_t* H2 = (bf16_t*)(P.ws + WS_H2); int* TI = (int*)(P.ws + WS_TOPI); float* TG = (float*)(P.ws + WS_TOPG);
    float* wr = (float*)c.lds;
    const float* rw = P.in[I_RW] + (size_t)l * 1024 * 32;
    for (int i = c.tid; i < 32768; i += NTHREADS) { const int k = i >> 5, e = i & 31; wr[e * 1024 + k] = rw[i]; }
    __syncthreads();
    const float* g = P.in[I_LN1G] + l * 1024; const float* bb = P.in[I_LN1B] + l * 1024; const float rbias = P.in[I_RB][l * 32 + (c.lane >> 1)];
    for (int tp = c.gw; tp < T_ / 2; tp += c.ngw) {
        const int t0 = 2 * tp, b = t0 / SEQ_;
        f32x4 v0[4], v1[4], h0[4], h1[4];
#pragma unroll
        for (int j = 0; j < 4; ++j) { v0[j] = *(const f32x4*)(Z + (size_t)t0 * 1024 + 4 * c.lane + 256 * j); v1[j] = *(const f32x4*)(Z + (size_t)(t0 + 1) * 1024 + 4 * c.lane + 256 * j); }
        ln_rows(v0, g, bb, c.lane); ln_rows(v1, g, bb, c.lane);
#pragma unroll
        for (int j = 0; j < 4; ++j) { *(f32x4*)(X1 + (size_t)t0 * 1024 + 4 * c.lane + 256 * j) = v0[j]; *(f32x4*)(X1 + (size_t)(t0 + 1) * 1024 + 4 * c.lane + 256 * j) = v1[j]; }
        modulate(h0, v0, mod + (size_t)b * 6144 + 3072, mod + (size_t)b * 6144 + 4096, c.lane);
        modulate(h1, v1, mod + (size_t)b * 6144 + 3072, mod + (size_t)b * 6144 + 4096, c.lane);
        store_bf16_row(H2 + (size_t)t0 * 1024, c.lane, h0); store_bf16_row(H2 + (size_t)(t0 + 1) * 1024, c.lane, h1);
        float p0[32], p1[32];
#pragma unroll
        for (int e = 0; e < 32; ++e) { float a0 = 0.f, a1 = 0.f;
            const float* wp = wr + e * 1024 + 4 * c.lane;
            if (e >= 2) asm volatile("" : "+v"(wp) : "v"(p0[e - 2]));
#pragma unroll
            for (int j = 0; j < 4; ++j) { const f32x4 w = *(const f32x4*)(wp + 256 * j);
                a0 += (h0[j][0] * w[0] + h0[j][1] * w[1]) + (h0[j][2] * w[2] + h0[j][3] * w[3]); a1 += (h1[j][0] * w[0] + h1[j][1] * w[1]) + (h1[j][2] * w[2] + h1[j][3] * w[3]); }
            p0[e] = a0; p1[e] = a1; }
        const float lg0 = xred32(p0, c.lane) + rbias, lg1 = xred32(p1, c.lane) + rbias;
        top4_store(lg0, c.lane, TI + (size_t)t0 * 4, TG + (size_t)t0 * 4);
        top4_store(lg1, c.lane, TI + (size_t)(t0 + 1) * 4, TG + (size_t)(t0 + 1) * 4);
    }
    __syncthreads();
}

__device__ __forceinline__ void ph_routea(const Ctx& c) {
    const Params& P = *c.P; const int* TI = (const int*)(P.ws + WS_TOPI); int* R = (int*)(P.ws + WS_ROUTE);
    int* hist = (int*)c.lds;
    for (int seg = c.bid; seg < 256; seg += c.nblk) {
        if (c.tid < 32) hist[c.tid] = 0;
        __syncthreads();
        if (c.tid < 256) atomicAdd(&hist[TI[seg * 256 + c.tid]], 1);
        __syncthreads();
        if (c.tid < 32) R[R_COUNTS + seg * 32 + c.tid] = hist[c.tid];
        __syncthreads();
    }
}
__device__ __forceinline__ void ph_routeb(const Ctx& c) {
    const Params& P = *c.P; const int* TI = (const int*)(P.ws + WS_TOPI); int* R = (int*)(P.ws + WS_ROUTE);
    int* tot = (int*)c.lds; int* off = tot + 32; int* pst = off + 32; int* eid = pst + 64;
    for (int seg = c.bid; seg < 256; seg += c.nblk) {
        if (c.tid < 32) { int a = 0, o = 0; for (int s2 = 0; s2 < 256; ++s2) { const int v = R[R_COUNTS + s2 * 32 + c.tid]; a += v; if (s2 < seg) o += v; } tot[c.tid] = a; off[c.tid] = o; }
        if (c.tid < 256) eid[c.tid] = TI[seg * 256 + c.tid];
        __syncthreads();
        if (c.tid == 0) { int ps = 0; for (int e = 0; e < 32; ++e) { pst[e] = ps; ps += ((tot[e] + 255) >> 8) << 8; } pst[32] = ps; }
        __syncthreads();
        if (c.tid < 256) { const int e = eid[c.tid]; int rank = 0; for (int q = 0; q < c.tid; ++q) rank += (eid[q] == e) ? 1 : 0;
            R[R_ROWTOK + pst[e] + off[e] + rank] = seg * 256 + c.tid; }
        if (seg == 0) {
            for (int e = 0; e < 32; ++e) { const int lo = pst[e] + tot[e], hi = pst[e + 1]; for (int q = lo + c.tid; q < hi; q += NTHREADS) R[R_ROWTOK + q] = -1; }
            const int nrb = pst[32] >> 8;
            for (int rb = c.tid; rb < nrb; rb += NTHREADS) { int e = 0; for (int q = 1; q < 32; ++q) if ((rb << 8) >= pst[q]) e = q; R[R_BLKE + rb] = e; }
            if (c.tid == 0) R[R_NRB] = nrb;
        }
        __syncthreads();
    }
}
__device__ __forceinline__ void ph_gather(const Ctx& c) {
    const Params& P = *c.P; const int* R = (const int*)(P.ws + WS_ROUTE); const bf16_t* H2 = (const bf16_t*)(P.ws + WS_H2); bf16_t* XB = (bf16_t*)(P.ws + WS_XBUF);
    const int nrows = R[R_NRB] * 256;
    for (int r = c.gw; r < nrows; r += c.ngw) { const int a = R[R_ROWTOK + r];
        u32x4 v0 = (u32x4){0u, 0u, 0u, 0u}, v1 = v0;
        if (a >= 0) { const bf16_t* src = H2 + (size_t)(a >> 2) * 1024; v0 = *(const u32x4*)(src + 8 * c.lane); v1 = *(const u32x4*)(src + 512 + 8 * c.lane); }
        *(u32x4*)(XB + (size_t)r * 1024 + 8 * c.lane) = v0; *(u32x4*)(XB + (size_t)r * 1024 + 512 + 8 * c.lane) = v1; }
}

__device__ __forceinline__ void ph_combine(const Ctx& c, int l) {
    const Params& P = *c.P; const float* mod = (const float*)(P.ws + WS_MOD) + (size_t)l * 8 * 6144;
    const float* X1 = (const float*)(P.ws + WS_X1); const bf16_t* Y4 = (const bf16_t*)(P.ws + WS_Y4); const float* TG = (const float*)(P.ws + WS_TOPG);
    float* XO = (l == DEPTH_ - 1) ? P.out : (float*)(P.ws + WS_X); bf16_t* H = (bf16_t*)(P.ws + WS_H);
    const float* g = P.in[I_LN2G] + l * 1024; const float* bb = P.in[I_LN2B] + l * 1024;
    for (int t = c.gw; t < T_; t += c.ngw) {
        const int b = t / SEQ_; const f32x4 gt = *(const f32x4*)(TG + (size_t)t * 4);
        f32x4 v[4];
#pragma unroll
        for (int j = 0; j < 4; ++j) { const int col = 4 * c.lane + 256 * j; f32x4 y = (f32x4){0.f, 0.f, 0.f, 0.f};
#pragma unroll
            for (int k = 0; k < 4; ++k) { const u32x2 w = *(const u32x2*)(Y4 + (size_t)(t * 4 + k) * 1024 + col); y += gt[k] * (f32x4){bflo(w.x), bfhi(w.x), bflo(w.y), bfhi(w.y)}; }
            const f32x4 x1 = *(const f32x4*)(X1 + (size_t)t * 1024 + col), g2 = *(const f32x4*)(mod + (size_t)b * 6144 + 5120 + col);
            v[j] = x1 * ALPHA_ + g2 * y; }
        ln_rows(v, g, bb, c.lane);
#pragma unroll
        for (int j = 0; j < 4; ++j) *(f32x4*)(XO + (size_t)t * 1024 + 4 * c.lane + 256 * j) = v[j];
        if (l + 1 < DEPTH_) { const float* m2 = (const float*)(P.ws + WS_MOD) + (size_t)(l + 1) * 8 * 6144 + (size_t)b * 6144; f32x4 h[4];
            modulate(h, v, m2, m2 + 1024, c.lane); store_bf16_row(H + (size_t)t * 1024, c.lane, h); }
    }
}

#define XB_TMO      128
#define XB_XCNT(j)  (256  + 64 * (j))
#define XB_XSUB(j)  (1280 + 64 * (j))
#define XB_XGEN(j)  (2304 + 64 * (j))
#define XB_TOP      3328
#define XB_TOPGEN   3392
#define XCD_BAR_WORDS 3456
#define XB_SPIN_CAP (1u << 18)
constexpr int CW_BAR = 4096;
constexpr int MISC_OFF = LDS_BYTES - 256;
__device__ __forceinline__ unsigned xb_ld(unsigned* p)              { return __hip_atomic_load(p, __ATOMIC_RELAXED, __HIP_MEMORY_SCOPE_AGENT); }
__device__ __forceinline__ unsigned xb_add(unsigned* p, unsigned v) { return __hip_atomic_fetch_add(p, v, __ATOMIC_RELAXED, __HIP_MEMORY_SCOPE_AGENT); }
__device__ __forceinline__ unsigned xb_xcc_id() { return (unsigned)__builtin_amdgcn_s_getreg((3 << 11) | 20) & 0xFu; }
#define XB_SPIN(cond, bar) do { unsigned _sp = 0; while (cond) { __builtin_amdgcn_s_sleep(1); \
    if ((++_sp & 255u) == 0u) { if (xb_ld(&(bar)[XB_TMO])) break; if (_sp > XB_SPIN_CAP) { atomicAdd(&(bar)[XB_TMO], 1u); break; } } } } while (0)
struct XcdBarrier { unsigned* bar; unsigned x; volatile LAS unsigned* st; };
__device__ __forceinline__ XcdBarrier xcd_barrier_post(unsigned* bar, volatile LAS unsigned* st) {
    XcdBarrier b; b.bar = bar; b.x = xb_xcc_id(); b.st = st;
    if (threadIdx.x == 0) (void)xb_add(&bar[XB_XCNT(b.x)], 1u);
    return b;
}
__device__ __forceinline__ void xcd_barrier_complete(unsigned* bar, unsigned x, unsigned& nloc, unsigned& nx) {
    const unsigned G = gridDim.x * gridDim.y * gridDim.z;
    unsigned sum, cnt, mine, sp = 0u;
    for (;;) {
        sum = 0u; cnt = 0u; mine = 0u;
#pragma unroll
        for (unsigned j = 0; j < 16; ++j) { const unsigned c = xb_ld(&bar[XB_XCNT(j)]); sum += c; cnt += (c > 0u) ? 1u : 0u; mine = (j == x) ? c : mine; }
        if (sum == G) break;
        __builtin_amdgcn_s_sleep(1);
        if ((++sp & 255u) == 0u) { if (xb_ld(&bar[XB_TMO])) break; if (sp > XB_SPIN_CAP) { atomicAdd(&bar[XB_TMO], 1u); break; } }
    }
    nloc = mine > 0u ? mine : 1u; nx = cnt > 0u ? cnt : 1u;
}
__device__ __forceinline__ void xcd_barrier(const XcdBarrier& b) {
    asm volatile("s_waitcnt vmcnt(0)" ::: "memory");
    __syncthreads();
    if (threadIdx.x == 0) {
        unsigned* bar = b.bar;
        __builtin_amdgcn_s_waitcnt(0);
        unsigned nloc = b.st[0], nx = b.st[1];
        if (nloc == 0u) { xcd_barrier_complete(bar, b.x, nloc, nx); b.st[0] = nloc; b.st[1] = nx; }
        const unsigned old = xb_add(&bar[XB_XSUB(b.x)], 1u);
        const unsigned gen = old / nloc;
        if (old + 1u == (gen + 1u) * nloc) {
            __builtin_amdgcn_fence(__ATOMIC_RELEASE, "agent");
            asm volatile("s_waitcnt vmcnt(0)" ::: "memory");
            const unsigned og = xb_add(&bar[XB_TOP], 1u);
            const unsigned tg = og / nx;
            if (og + 1u == (tg + 1u) * nx) xb_add(&bar[XB_TOPGEN], 1u);
            else XB_SPIN(xb_ld(&bar[XB_TOPGEN]) == tg, bar);
            __builtin_amdgcn_fence(__ATOMIC_ACQUIRE, "agent");
            xb_add(&bar[XB_XGEN(b.x)], 1u);
            asm volatile("s_waitcnt vmcnt(0)" ::: "memory");
        } else {
            XB_SPIN(xb_ld(&bar[XB_XGEN(b.x)]) == gen, bar);
            __builtin_amdgcn_fence(__ATOMIC_ACQUIRE, "agent");
            asm volatile("s_waitcnt vmcnt(0)" ::: "memory");
        }
    }
    __syncthreads();
}

template <int KIND>
__device__ __forceinline__ void run_kind(const Ctx& c0, int l) {
    Ctx c = c0;
    { int t = c0.tid; asm volatile("" : "+v"(t)); c.tid = t; c.lane = t & 63; c.wave = __builtin_amdgcn_readfirstlane(t >> 6); }
    { int b = c0.bid, n = c0.nblk; asm volatile("" : "+s"(b), "+s"(n)); c.bid = b; c.nblk = n; c.gw = b * NWAVES + c.wave; c.ngw = n * NWAVES; }
    { long z = 0; asm volatile("" : "+s"(z)); c.P = (const Params*)((const char*)c0.P + z); }
    const Params& P = *c.P; LAS unsigned char* lds3 = (LAS unsigned char*)c.lds;
    const int* R = (const int*)(P.ws + WS_ROUTE);
    if constexpr (KIND == 0) ph_conv(c);
    else if constexpr (KIND == 1) ph_mod(c);
    else if constexpr (KIND == 2) ph_prep0(c);
    else if constexpr (KIND == 3 + L_GEMM1) { DenseSched S{(const char*)(P.ws + WS_H), (const char*)(P.ws + WS_WIN) + (size_t)l * NPROJ * 2048, T_ / 256, NPROJ / 256, c.nblk, c.bid};
        EpiStoreBf16 E{(bf16_t*)(P.ws + WS_PROJ), NPROJ};
        pg8::gemm_phase<EpiStoreBf16, DenseSched, true, true>(lds3, S, E, c.tid); }
    else if constexpr (KIND == 3 + L_MIXA) ph_pool(c, l);
    else if constexpr (KIND == 3 + L_SWA) { for (int it = c.bid; it < NB_ * 16 * 2; it += c.nblk) swa_mfma_item(c, l, it); __syncthreads(); }
    else if constexpr (KIND == 3 + L_GPREP) ph_gprep(c, l);
    else if constexpr (KIND == 3 + L_GSCAN) ph_gscan2(c);
    else if constexpr (KIND == 3 + L_GOUT) ph_gout(c, l);
    else if constexpr (KIND == 3 + L_GEMM2) { DenseSched S{(const char*)(P.ws + WS_MIX), (const char*)(P.ws + WS_WOUT) + (size_t)l * 1024 * 2048, T_ / 256, 4, c.nblk, c.bid};
        EpiResid E{l == 0 ? P.in[I_X] : (const float*)(P.ws + WS_X), (const float*)(P.ws + WS_MOD) + (size_t)l * 8 * 6144 + 2048, (float*)(P.ws + WS_Z)};
        pg8::gemm_phase<EpiResid, DenseSched, true, true>(lds3, S, E, c.tid); }
    else if constexpr (KIND == 3 + L_LN1) ph_ln1(c, l);
    else if constexpr (KIND == 3 + L_ROUTEA) ph_routea(c);
    else if constexpr (KIND == 3 + L_ROUTEB) ph_routeb(c);
    else if constexpr (KIND == 3 + L_GATHER) ph_gather(c);
    else if constexpr (KIND == 3 + L_UP) { MoeSched S{(const char*)(P.ws + WS_H2), (const char*)(P.ws + WS_WUP) + (size_t)l * 32 * 2048 * 2048, R + R_BLKE, R[R_NRB], 8, c.nblk, c.bid, (size_t)2048 * 2048, R + R_ROWTOK, 1};
        EpiSwiglu E{(bf16_t*)(P.ws + WS_ACT), P.in[I_BUP] + (size_t)l * 32 * 2048};
        pg8::gemm_phase<EpiSwiglu, MoeSched, true, true, true>(lds3, S, E, c.tid); }
    else if constexpr (KIND == 3 + L_DOWN) { MoeSched S{(const char*)(P.ws + WS_ACT), (const char*)(P.ws + WS_WDN) + (size_t)l * 32 * 1024 * 2048, R + R_BLKE, R[R_NRB], 4, c.nblk, c.bid, (size_t)1024 * 2048, R + R_ROWTOK, 0};
        EpiDown E{(bf16_t*)(P.ws + WS_Y4), P.in[I_BDN] + (size_t)l * 32 * 1024, R + R_ROWTOK};
        pg8::gemm_phase<EpiDown, MoeSched, true, true>(lds3, S, E, c.tid); }
    else if constexpr (KIND == 3 + L_COMBINE) ph_combine(c, l);
}

#define SEAM() xcd_barrier(bar)
#ifndef PROBE_KIND
#define PROBE_KIND -1
#endif
#define RK(K, L) do { run_kind<K>(c, L); if ((K) == PROBE_KIND && (L) == 0) { SEAM(); run_kind<K>(c, L); } } while (0)
template <int L> __device__ __forceinline__ void run_layer(const Ctx& c, const XcdBarrier& bar) {
    RK(3 + L_GEMM1, L); SEAM();
    RK(3 + L_MIXA, L); RK(3 + L_SWA, L); RK(3 + L_GPREP, L); SEAM();
    RK(3 + L_GSCAN, L); SEAM();
    RK(3 + L_GOUT, L); SEAM();
    RK(3 + L_GEMM2, L); SEAM();
    RK(3 + L_LN1, L); SEAM();
    RK(3 + L_ROUTEA, L); SEAM();
    RK(3 + L_ROUTEB, L); SEAM();
    RK(3 + L_UP, L); SEAM();
    RK(3 + L_DOWN, L); SEAM();
    RK(3 + L_COMBINE, L);
}
__global__ void __launch_bounds__(NTHREADS, 2) mk_fwd(Params P) {
    extern __shared__ __attribute__((aligned(16))) unsigned char lds[];
    Ctx c; c.P = &P; c.lds = lds; c.tid = threadIdx.x; c.lane = c.tid & 63; c.wave = __builtin_amdgcn_readfirstlane(c.tid >> 6);
    c.bid = blockIdx.x; c.nblk = gridDim.x; c.gw = c.bid * NWAVES + c.wave; c.ngw = c.nblk * NWAVES;
    for (int u = c.tid; u < 64; u += NTHREADS) ((volatile LAS unsigned*)((LAS unsigned char*)lds + MISC_OFF))[u] = 0u;
    __syncthreads();
    const XcdBarrier bar = xcd_barrier_post((unsigned*)(P.ws + WS_CTL) + CW_BAR, (volatile LAS unsigned*)((LAS unsigned char*)lds + MISC_OFF) + 8);
    RK(0, 0); __syncthreads(); RK(1, 0); SEAM();
    RK(2, 0); SEAM();
    run_layer<0>(c, bar); SEAM();
    run_layer<1>(c, bar);
}

extern "C" void kernel_launch(void* const* d_in, const int* in_sizes, int n_in, void* d_out, int out_size, void* d_ws, size_t ws_size, hipStream_t stream) {
    static int grid = 0;
    if (grid == 0) {
        if (n_in != N_IN || out_size != T_ * D_ || ws_size < WS_END) { fprintf(stderr, "kernel_launch: unexpected shapes (n_in %d out %d ws %zu need %zu)\n", n_in, out_size, ws_size, (size_t)WS_END); grid = -1; return; }
        int dev = 0, cus = 0, per_cu = 0;
        (void)hipGetDevice(&dev); (void)hipDeviceGetAttribute(&cus, hipDeviceAttributeMultiprocessorCount, dev);
        (void)hipFuncSetAttribute((const void*)mk_fwd, hipFuncAttributeMaxDynamicSharedMemorySize, LDS_BYTES);
        if (hipOccupancyMaxActiveBlocksPerMultiprocessor(&per_cu, (const void*)mk_fwd, NTHREADS, LDS_BYTES) != hipSuccess || per_cu < 1) { fprintf(stderr, "kernel_launch: occupancy query says %d blocks/CU\n", per_cu); (void)hipGetLastError(); grid = -1; return; }
        grid = cus > 0 ? cus : 256;
    }
    if (grid < 0) return;
    (void)hipMemsetAsync((char*)d_ws + WS_CTL, 0, 1 * MiB, stream);
    Params p{};
    for (int i = 0; i < N_IN; ++i) p.in[i] = (const float*)d_in[i];
    p.out = (float*)d_out; p.ws = (unsigned char*)d_ws;
    void* args[] = {&p};
    hipError_t e = hipLaunchCooperativeKernel((const void*)mk_fwd, dim3(grid), dim3(NTHREADS), args, LDS_BYTES, stream);
    if (e != hipSuccess) fprintf(stderr, "cooperative launch failed: %s (grid %d)\n", hipGetErrorString(e), grid);
}
```

```cpp
#include <hip/hip_runtime.h>
#include <hip/hip_cooperative_groups.h>
#include <cstdio>
#include <cstdint>
namespace cg = cooperative_groups;

#define LAS __attribute__((address_space(3)))
typedef unsigned short bf16_t;
typedef short bf16x8 __attribute__((ext_vector_type(8)));
typedef short bf16x16 __attribute__((ext_vector_type(16)));
typedef int v8i32 __attribute__((ext_vector_type(8)));
typedef int v4i32 __attribute__((ext_vector_type(4)));
typedef float f32x4 __attribute__((ext_vector_type(4)));
typedef float f32x2 __attribute__((ext_vector_type(2)));
typedef unsigned u32x4 __attribute__((ext_vector_type(4)));
typedef unsigned u32x2 __attribute__((ext_vector_type(2)));

constexpr int T_ = 16384, D_ = 1024, NB_ = 8, SEQ_ = 2048, DEPTH_ = 2;
constexpr int IN_DIM = 2444, NPROJ = 2560;
constexpr int C_POOL = 0, C_AQ = 256, C_AK = 640, C_AV = 768, C_GQ = 896, C_GK = 1280, C_GV = 1664, C_GZ = 2048, C_GB = 2432, C_GA = 2438;
constexpr int NE_ = 32, TOPK_ = 4, NASSIGN = T_ * TOPK_, NRB_MAX = NASSIGN / 256 + NE_, PROWS = NRB_MAX * 256;
constexpr float ALPHA_ = 1.41421356237309515f;
constexpr float LN_EPS_ = 1e-5f, NORM_EPS_ = 1e-6f;
constexpr int NTHREADS = 512, NWAVES = 8;
constexpr int LDS_BYTES = 147456;

constexpr size_t MiB = 1u << 20;
constexpr size_t WS_CTL = 0;
constexpr size_t WS_MOD = 1 * MiB;
constexpr size_t WS_ROUTE = 2 * MiB;
constexpr size_t WS_WIN = 4 * MiB;
constexpr size_t WS_WOUT = 14 * MiB;
constexpr size_t WS_WUP = 18 * MiB;
constexpr size_t WS_WDN = WS_WUP + 256 * MiB;
constexpr size_t WS_H = WS_WDN + 128 * MiB;
constexpr size_t WS_H2 = WS_H + 32 * MiB;
constexpr size_t WS_PROJ = WS_H2 + 32 * MiB;
constexpr size_t WS_MIX = WS_PROJ + 80 * MiB;
constexpr size_t WS_Z = WS_MIX + 32 * MiB;
constexpr size_t WS_X = WS_Z + 64 * MiB;
constexpr size_t WS_QN = WS_X + 64 * MiB;
constexpr size_t WS_KN = WS_QN + 24 * MiB;
constexpr size_t WS_VV = WS_KN + 24 * MiB;
constexpr size_t WS_OR = WS_VV + 24 * MiB;
constexpr size_t WS_GB = WS_OR + 24 * MiB;
constexpr size_t WS_TOPI = WS_GB + 1 * MiB;
constexpr size_t WS_TOPG = WS_TOPI + 1 * MiB;
constexpr size_t WS_XBUF = WS_TOPG + 1 * MiB;
constexpr size_t WS_ACT = WS_XBUF + 144 * MiB;
constexpr size_t WS_Y4 = WS_ACT + 144 * MiB;
constexpr size_t WS_X1 = WS_Y4 + 128 * MiB;
constexpr size_t WS_END = WS_X1 + 64 * MiB;
constexpr int R_COUNTS = 0;
constexpr int R_BLKE = 8192;
constexpr int R_NRB = 8192 + 512;
constexpr int R_ROWTOK = 16384;

__device__ __forceinline__ unsigned f2bf(float f) { unsigned u = __builtin_bit_cast(unsigned, f); return (u + 0x7fffu + ((u >> 16) & 1u)) >> 16; }
__device__ __forceinline__ unsigned pk2(float lo, float hi) { return f2bf(lo) | (f2bf(hi) << 16); }
__device__ __forceinline__ float bf2f(unsigned short b) { return __builtin_bit_cast(float, (unsigned)b << 16); }
__device__ __forceinline__ float bflo(unsigned w) { return __builtin_bit_cast(float, w << 16); }
__device__ __forceinline__ float bfhi(unsigned w) { return __builtin_bit_cast(float, w & 0xffff0000u); }
__device__ __forceinline__ unsigned pk4_fp8(float a, float b, float c, float d) { int w = __builtin_amdgcn_cvt_pk_fp8_f32(a, b, 0, false); w = __builtin_amdgcn_cvt_pk_fp8_f32(c, d, w, true); return (unsigned)w; }
__device__ __forceinline__ float wave_sum(float v) {
#pragma unroll
    for (int o = 1; o < 64; o <<= 1) v += __shfl_xor(v, o);
    return v;
}
__device__ __forceinline__ float wave_max(float v) {
#pragma unroll
    for (int o = 1; o < 64; o <<= 1) v = fmaxf(v, __shfl_xor(v, o));
    return v;
}
__device__ __forceinline__ float silu_f(float x) { return x / (1.f + __expf(-x)); }
__device__ __forceinline__ float sigmoid_f(float x) { return 1.f / (1.f + __expf(-x)); }

namespace pg8 {
constexpr int BM = 256, BK = 64, HALF = 128, HTB = HALF * BK * 2, STAGE_BYTES = 8 * HTB, NXCD = 8, WGM = 8, KD = 1024;
__host__ __device__ __forceinline__ int lds_byte(int r, int c) { const int st = (r >> 4) * 2 + (c >> 5), rr = r & 15, cc = c & 31, ob = rr * 64 + cc * 2; return st * 1024 + (ob ^ (((ob >> 9) & 1) << 5)); }
__host__ __device__ __forceinline__ void stage_rc(int b, int& R, int& C) { const int st = b / 1024, sb = b % 1024, swz = sb ^ (((sb >> 9) & 1) << 5); R = (st >> 1) * 16 + swz / 64; C = (st & 1) * 32 + (swz % 64) / 2; }
__host__ __device__ __forceinline__ int perm32(int rho) { const int n = rho >> 4, i = rho & 15; return 8 * (i >> 2) + 4 * n + (i & 3); }

struct Unit { int pm, pn, e; const char* a; const char* b; const int* ridx; };

__device__ __forceinline__ void tile_of(int L, int nM, int nN, int& pm, int& pn) {
    const int nwg = nM * nN; int wgid = L;
    { const int q = nwg / NXCD, r = nwg % NXCD, xcd = wgid % NXCD, off = wgid / NXCD; wgid = (xcd < r ? xcd * (q + 1) : r * (q + 1) + (xcd - r) * q) + off; }
    const int nig = WGM * nN, gid = wgid / nig, fm = gid * WGM, gsz = (nM - fm) < WGM ? (nM - fm) : WGM;
    pm = fm + ((wgid % nig) % gsz); pn = (wgid % nig) / gsz;
}

__device__ __forceinline__ unsigned cvt_pk_bf16(float lo, float hi) { unsigned r; asm volatile("v_cvt_pk_bf16_f32 %0, %1, %2" : "=v"(r) : "v"(lo), "v"(hi)); return r; }

template <class Epi, class Sched, bool ALIGN_EPI, bool SP2, bool GATHER = false, int EB = 2, int WSC = 127>
__device__ __forceinline__ void gemm_phase(LAS unsigned char* lds, const Sched& S, const Epi& E, const int tid) {
    const int wid = __builtin_amdgcn_readfirstlane(tid >> 6), lane = tid & 63, wr = wid >> 2, wc = wid & 3, fr = lane & 15, fq = lane >> 4;
    constexpr int K = KD, RB = K * EB  , nt = RB / (BK * 2);
    unsigned voffA[2], voffB[2];
#pragma unroll
    for (int i = 0; i < 2; ++i) { int R, C; stage_rc(tid * 16 + i * 8192, R, C); const int Rb = Epi::PERM ? ((R & ~31) + perm32(R & 31)) : R;
        voffA[i] = (unsigned)(R * RB + C * 2); voffB[i] = (unsigned)(Rb * RB + C * 2); }
    const size_t kstep = (size_t)(BK * 2);
    const size_t hstep = (size_t)HALF * RB;
    const size_t hsA = GATHER ? 0 : hstep;
    int gR[2], gC[2];
#pragma unroll
    for (int i = 0; i < 2; ++i) stage_rc(tid * 16 + i * 8192, gR[i], gC[i]);
    unsigned vgC0[2], vgC1[2], vgN0[2], vgN1[2];
#define PG8_GLOAD(dst0, dst1, u) do { _Pragma("unroll") for (int _i = 0; _i < 2; ++_i) { const int _r0 = (u).ridx[gR[_i]], _r1 = (u).ridx[HALF + gR[_i]]; \
        dst0[_i] = (unsigned)((_r0 < 0 ? 0 : _r0 >> 2) * RB + gC[_i] * 2); dst1[_i] = (unsigned)((_r1 < 0 ? 0 : _r1 >> 2) * RB + gC[_i] * 2); } } while (0)
    const unsigned ldsw = (unsigned)wid * 1024u;
    const int aoff = lds_byte(wr * 64 + fr, fq * 8), boff = lds_byte(wc * 32 + fr, fq * 8);
#define PG8_SA(b, h) (((b) * 2 + (h)) * HTB)
#define PG8_SB(b, h) ((4 + (b) * 2 + (h)) * HTB)
#define PG8_STAGE(bufoff, gbase, voff) do { _Pragma("unroll") for (int _i = 0; _i < 2; ++_i) \
        __builtin_amdgcn_global_load_lds((const unsigned*)((const char*)(gbase) + (voff)[_i]), (LAS unsigned*)(lds + (bufoff) + ldsw + _i * 8192), 16, 0, 0); } while (0)
#define PG8_RD8(off) __builtin_shufflevector(*(const LAS v4i32*)(lds + (off)), *(const LAS v4i32*)(lds + (off) + 1024), 0, 1, 2, 3, 4, 5, 6, 7)
#define PG8_LDA(dst, b, h) do { _Pragma("unroll") for (int m = 0; m < 4; ++m) { if constexpr (EB == 2) { _Pragma("unroll") for (int k = 0; k < 2; ++k) dst[m][k] = *(const LAS bf16x8*)(lds + PG8_SA(b, h) + aoff + m * 2048 + k * 1024); } \
        else dst##8[m] = PG8_RD8(PG8_SA(b, h) + aoff + m * 2048); } } while (0)
#define PG8_LDB(dst, b, h) do { _Pragma("unroll") for (int n = 0; n < 2; ++n) { if constexpr (EB == 2) { _Pragma("unroll") for (int k = 0; k < 2; ++k) dst[n][k] = *(const LAS bf16x8*)(lds + PG8_SB(b, h) + boff + n * 2048 + k * 1024); } \
        else dst##8[n] = PG8_RD8(PG8_SB(b, h) + boff + n * 2048); } } while (0)
#define PG8_MMA(ai, bj, At, Bt) do { __builtin_amdgcn_s_setprio(1); _Pragma("unroll") for (int m = 0; m < 4; ++m) _Pragma("unroll") for (int n = 0; n < 2; ++n) { \
        if constexpr (EB == 2) { _Pragma("unroll") for (int k = 0; k < 2; ++k) acc[ai][bj][m][n] = __builtin_amdgcn_mfma_f32_16x16x32_bf16(Bt[n][k], At[m][k], acc[ai][bj][m][n], 0, 0, 0); } \
        else asm volatile("v_mfma_scale_f32_16x16x128_f8f6f4 %0, %1, %2, %0, %3, %4 op_sel_hi:[0,0,0]" : "+v"(acc[ai][bj][m][n]) : "v"(Bt##8[n]), "v"(At##8[m]), "v"(sc_w), "v"(sc_a)); } \
        __builtin_amdgcn_s_setprio(0); } while (0)
#define PG8_WAIT_V(n) asm volatile("s_waitcnt vmcnt(" #n ")" ::: "memory")
#define PG8_WAIT_L(n) asm volatile("s_waitcnt lgkmcnt(" #n ")" ::: "memory")
#define PG8_BAR __builtin_amdgcn_s_barrier()
#define PG8_SCHED __builtin_amdgcn_sched_barrier(0)
    Unit cur, nxt; int ui = 0;
    if (!S.next(0, cur)) return;
    f32x4 acc[2][2][4][2];
#pragma unroll
    for (int a = 0; a < 2; ++a)
#pragma unroll
        for (int b = 0; b < 2; ++b)
#pragma unroll
            for (int m = 0; m < 4; ++m)
#pragma unroll
                for (int n = 0; n < 2; ++n) acc[a][b][m][n] = (f32x4){0.f, 0.f, 0.f, 0.f};
    int sc_w = WSC, sc_a = 127; asm volatile("" : "+v"(sc_w), "+v"(sc_a));
    bf16x8 At[4][2], B0[2][2], B1[2][2]; v8i32 At8[4], B08[2], B18[2];
    const char* cA = cur.a; const char* cB = cur.b;
    if constexpr (GATHER) { PG8_GLOAD(vgC0, vgC1, cur); _Pragma("unroll") for (int i = 0; i < 2; ++i) { vgN0[i] = vgC0[i]; vgN1[i] = vgC1[i]; } }
    if constexpr (SP2) {
        PG8_STAGE(PG8_SB(0, 0), cB, voffB); PG8_STAGE(PG8_SB(0, 1), cB + hstep, voffB); PG8_STAGE(PG8_SA(0, 0), cA, (GATHER ? vgC0 : voffA)); PG8_STAGE(PG8_SA(0, 1), cA + hsA, (GATHER ? vgC1 : voffA));
        if (wr == 1) PG8_BAR;
        PG8_WAIT_V(2); PG8_BAR;
        PG8_STAGE(PG8_SB(1, 0), cB + kstep, voffB); PG8_STAGE(PG8_SA(1, 0), cA + kstep, (GATHER ? vgC0 : voffA)); PG8_STAGE(PG8_SB(1, 1), cB + hstep + kstep, voffB);
        PG8_WAIT_V(6); PG8_BAR;
    } else {
        PG8_STAGE(PG8_SB(0, 0), cB, voffB); PG8_STAGE(PG8_SA(0, 0), cA, voffA); PG8_STAGE(PG8_SB(0, 1), cB + hstep, voffB); PG8_STAGE(PG8_SA(0, 1), cA + hstep, voffA);
        if (wr == 1) PG8_BAR;
        PG8_WAIT_V(4); PG8_BAR;
        PG8_STAGE(PG8_SB(1, 0), cB + kstep, voffB); PG8_STAGE(PG8_SA(1, 0), cA + kstep, voffA); PG8_STAGE(PG8_SB(1, 1), cB + hstep + kstep, voffB);
        PG8_WAIT_V(6); PG8_BAR;
    }
    for (;;) {
        const bool has_next = S.next(ui + 1, nxt);
        const char* nA = has_next ? nxt.a : cA; const char* nB = has_next ? nxt.b : cB;
        if constexpr (GATHER) { if (has_next) PG8_GLOAD(vgN0, vgN1, nxt); }
#pragma unroll 1
        for (int t = 0; t < nt; t += 2) {
            const bool last = (t == nt - 2);
            unsigned vA0[2], vA1[2];
            if constexpr (GATHER) { if (last) { vA0[0] = vgN0[0]; vA0[1] = vgN0[1]; vA1[0] = vgN1[0]; vA1[1] = vgN1[1]; } else { vA0[0] = vgC0[0]; vA0[1] = vgC0[1]; vA1[0] = vgC1[0]; vA1[1] = vgC1[1]; } }
            const char* a1 = cA + (size_t)(t + 1) * kstep;
            const char* a2 = last ? nA : cA + (size_t)(t + 2) * kstep; const char* b2 = last ? nB : cB + (size_t)(t + 2) * kstep;
            const char* a3 = a2 + kstep; const char* b3 = b2 + kstep;
            if constexpr (SP2) {
            PG8_LDB(B0, 0, 0); PG8_LDB(B1, 0, 1); PG8_SCHED; PG8_LDA(At, 0, 0); PG8_STAGE(PG8_SA(1, 1), a1 + hsA, (GATHER ? vgC1 : voffA));
            PG8_WAIT_V(8); PG8_WAIT_L(0); PG8_BAR; PG8_MMA(0, 0, At, B0); PG8_MMA(0, 1, At, B1); PG8_BAR; PG8_SCHED;
            PG8_LDA(At, 0, 1); PG8_STAGE(PG8_SB(0, 0), b2, voffB); PG8_STAGE(PG8_SB(0, 1), b2 + hstep, voffB); PG8_STAGE(PG8_SA(0, 0), a2, (GATHER ? vA0 : voffA));
            PG8_WAIT_V(8); PG8_WAIT_L(0); PG8_BAR; PG8_MMA(1, 0, At, B0); PG8_MMA(1, 1, At, B1); PG8_BAR; PG8_SCHED;
            PG8_LDB(B0, 1, 0); PG8_LDB(B1, 1, 1); PG8_SCHED; PG8_LDA(At, 1, 0); PG8_STAGE(PG8_SA(0, 1), a2 + hsA, (GATHER ? vA1 : voffA));
            PG8_WAIT_V(8); PG8_WAIT_L(0); PG8_BAR; PG8_MMA(0, 0, At, B0); PG8_MMA(0, 1, At, B1); PG8_BAR; PG8_SCHED;
            PG8_LDA(At, 1, 1); PG8_STAGE(PG8_SB(1, 0), b3, voffB); PG8_STAGE(PG8_SB(1, 1), b3 + hstep, voffB); PG8_STAGE(PG8_SA(1, 0), a3, (GATHER ? vA0 : voffA));
            PG8_WAIT_V(8); PG8_WAIT_L(0); PG8_BAR; PG8_MMA(1, 0, At, B0); PG8_MMA(1, 1, At, B1); PG8_BAR; PG8_SCHED;
            } else {
            PG8_LDB(B0, 0, 0); PG8_SCHED; PG8_LDA(At, 0, 0); PG8_STAGE(PG8_SA(1, 1), a1 + hstep, voffA);
            PG8_WAIT_L(8); PG8_BAR; PG8_WAIT_L(0); PG8_MMA(0, 0, At, B0); PG8_BAR; PG8_SCHED;
            PG8_LDB(B1, 0, 1); PG8_STAGE(PG8_SB(0, 0), b2, voffB);
            PG8_BAR; PG8_WAIT_L(0); PG8_MMA(0, 1, At, B1); PG8_BAR;
            PG8_LDA(At, 0, 1); PG8_STAGE(PG8_SA(0, 0), a2, voffA);
            PG8_BAR; PG8_WAIT_L(0); PG8_MMA(1, 0, At, B0); PG8_BAR; PG8_SCHED;
            PG8_STAGE(PG8_SB(0, 1), b2 + hstep, voffB);
            PG8_WAIT_V(6); PG8_BAR; PG8_MMA(1, 1, At, B1); PG8_BAR;
            PG8_LDB(B0, 1, 0); PG8_SCHED; PG8_LDA(At, 1, 0); PG8_STAGE(PG8_SA(0, 1), a2 + hstep, voffA);
            PG8_WAIT_L(8); PG8_BAR; PG8_WAIT_L(0); PG8_MMA(0, 0, At, B0); PG8_BAR; PG8_SCHED;
            PG8_LDB(B1, 1, 1); PG8_STAGE(PG8_SB(1, 0), b3, voffB);
            PG8_BAR; PG8_WAIT_L(0); PG8_MMA(0, 1, At, B1); PG8_BAR;
            PG8_LDA(At, 1, 1); PG8_STAGE(PG8_SA(1, 0), a3, voffA);
            PG8_BAR; PG8_WAIT_L(0); PG8_MMA(1, 0, At, B0); PG8_BAR; PG8_SCHED;
            PG8_STAGE(PG8_SB(1, 1), b3 + hstep, voffB);
            PG8_WAIT_V(6); PG8_BAR; PG8_MMA(1, 1, At, B1); PG8_BAR;
            }
        }
        if constexpr (ALIGN_EPI) { if (wr == 0) PG8_BAR; }
        if constexpr (EB == 1) asm volatile("s_nop 15\n\ts_nop 7" ::: "memory");
        E(acc, cur, wr, wc, fr, fq);
        if (!has_next) break;
#pragma unroll
        for (int a = 0; a < 2; ++a)
#pragma unroll
            for (int b = 0; b < 2; ++b)
#pragma unroll
                for (int m = 0; m < 4; ++m)
#pragma unroll
                    for (int n = 0; n < 2; ++n) acc[a][b][m][n] = (f32x4){0.f, 0.f, 0.f, 0.f};
        cur = nxt; cA = nA; cB = nB; ++ui;
        if constexpr (GATHER) { _Pragma("unroll") for (int i = 0; i < 2; ++i) { vgC0[i] = vgN0[i]; vgC1[i] = vgN1[i]; } }
        if constexpr (ALIGN_EPI) { if (wr == 1) PG8_BAR; }
    }
    PG8_WAIT_V(0);
    if constexpr (!ALIGN_EPI) { if (wr == 0) PG8_BAR; }
    PG8_BAR;
#undef PG8_GLOAD
#undef PG8_SA
#undef PG8_SB
#undef PG8_STAGE
#undef PG8_LDA
#undef PG8_LDB
#undef PG8_MMA
#undef PG8_RD8
#undef PG8_WAIT_V
#undef PG8_WAIT_L
#undef PG8_BAR
#undef PG8_SCHED
}
}

enum { I_X = 0, I_C, I_RELB, I_WIN, I_WOUT, I_WADA, I_BADA, I_LN1G, I_LN1B, I_LN2G, I_LN2B, I_POOLW, I_POOLS, I_SINKS, I_CONVW, I_ALOG, I_DTB, I_NORMW,
       I_RW, I_RB, I_WUP, I_BUP, I_WDN, I_BDN, N_IN };
struct Params { const float* in[N_IN]; float* out; unsigned char* ws; };

struct Ctx {
    const Params* P; unsigned char* lds; int tid, lane, wave, gw, ngw, bid, nblk;
};

enum { PH_CONV = 0, PH_MOD, PH_PREP0, PH_L0 };
enum { L_GEMM1 = 0, L_MIXA, L_SWA, L_GPREP, L_GSCAN, L_GOUT, L_GEMM2, L_LN1, L_ROUTEA, L_ROUTEB, L_GATHER, L_UP, L_DOWN, L_COMBINE, L_NPH };
constexpr int N_PHASES = PH_L0 + DEPTH_ * L_NPH;

__device__ __forceinline__ void transpose_item_fp8(const float* W, int N, unsigned char* WT, int k0, int n0, int drow0, float* scr, int lane, float scale) {
    const int n = n0 + (lane & 31);
#pragma unroll 8
    for (int i = 0; i < 32; ++i) { const int kk = 2 * i + (lane >> 5); scr[kk * 33 + (lane & 31)] = W[(size_t)(k0 + kk) * N + n] * scale; }
    asm volatile("s_waitcnt lgkmcnt(0)" ::: "memory");
    const int nn = lane >> 1, hf = lane & 1; const float* s = scr + (32 * hf) * 33 + nn;
    u32x4 o0, o1;
    o0.x = pk4_fp8(s[0 * 33], s[1 * 33], s[2 * 33], s[3 * 33]); o0.y = pk4_fp8(s[4 * 33], s[5 * 33], s[6 * 33], s[7 * 33]); o0.z = pk4_fp8(s[8 * 33], s[9 * 33], s[10 * 33], s[11 * 33]); o0.w = pk4_fp8(s[12 * 33], s[13 * 33], s[14 * 33], s[15 * 33]);
    o1.x = pk4_fp8(s[16 * 33], s[17 * 33], s[18 * 33], s[19 * 33]); o1.y = pk4_fp8(s[20 * 33], s[21 * 33], s[22 * 33], s[23 * 33]); o1.z = pk4_fp8(s[24 * 33], s[25 * 33], s[26 * 33], s[27 * 33]); o1.w = pk4_fp8(s[28 * 33], s[29 * 33], s[30 * 33], s[31 * 33]);
    unsigned char* dst = WT + (size_t)(drow0 + nn) * 1024 + k0 + 32 * hf;
    *(u32x4*)dst = o0; *(u32x4*)(dst + 16) = o1;
    asm volatile("s_waitcnt lgkmcnt(0)" ::: "memory");
}
__device__ __forceinline__ void transpose_item(const float* W, int N, bf16_t* WT, int k0, int n0, int drow0, float* scr, int lane) {
    const int n = n0 + (lane & 31); const bool ok = n < N;
#pragma unroll 8
    for (int i = 0; i < 32; ++i) { const int kk = 2 * i + (lane >> 5); scr[kk * 33 + (lane & 31)] = ok ? W[(size_t)(k0 + kk) * N + n] : 0.f; }
    asm volatile("s_waitcnt lgkmcnt(0)" ::: "memory");
    const int c = lane & 7;
#pragma unroll
    for (int j = 0; j < 4; ++j) { const int nn = (lane >> 3) + 8 * j; const float* s = scr + (8 * c) * 33 + nn;
        u32x4 o; o.x = pk2(s[0 * 33], s[1 * 33]); o.y = pk2(s[2 * 33], s[3 * 33]); o.z = pk2(s[4 * 33], s[5 * 33]); o.w = pk2(s[6 * 33], s[7 * 33]);
        *(u32x4*)(WT + (size_t)(drow0 + nn) * 1024 + k0 + 8 * c) = o; }
    asm volatile("s_waitcnt lgkmcnt(0)" ::: "memory");
}
__device__ __forceinline__ void ph_conv(const Ctx& c) {
    const Params& P = *c.P;
    float* scr = (float*)(c.lds + c.wave * 16384);
    constexpr int I_IN = 16 * 80, I_OUT = 16 * 32, I_UP = 32 * 16 * 64, I_DN = 32 * 16 * 32, I_LAYER = I_IN + I_OUT + I_UP + I_DN;
    for (int it = c.gw; it < DEPTH_ * I_LAYER; it += c.ngw) {
        const int l = it / I_LAYER; int r = it % I_LAYER;
        if (r < I_IN) { const int kb = r / 80, nb = r % 80;
            transpose_item(P.in[I_WIN] + (size_t)l * 1024 * IN_DIM, IN_DIM, (bf16_t*)(P.ws + WS_WIN) + (size_t)l * NPROJ * 1024, 64 * kb, 32 * nb, 32 * nb, scr, c.lane); continue; }
        r -= I_IN;
        if (r < I_OUT) { const int kb = r / 32, nb = r % 32;
            transpose_item(P.in[I_WOUT] + (size_t)l * 1024 * 1024, 1024, (bf16_t*)(P.ws + WS_WOUT) + (size_t)l * 1024 * 1024, 64 * kb, 32 * nb, 32 * nb, scr, c.lane); continue; }
        r -= I_OUT;
        if (r < I_UP) { const int e = r / 1024, rr = r % 1024, kb = rr / 64, nb = rr % 64, n0 = 32 * nb, bj = n0 / 1024, rem = n0 % 1024, pn = rem / 128, c0 = rem % 128;
            transpose_item_fp8(P.in[I_WUP] + (size_t)(l * 32 + e) * 1024 * 2048, 2048, P.ws + WS_WUP + (size_t)(l * 32 + e) * 2048 * 1024, 64 * kb, n0, pn * 256 + bj * 128 + c0, scr, c.lane, 64.f); continue; }
        r -= I_UP;
        { const int e = r / 512, rr = r % 512, kb = rr / 32, nb = rr % 32;
            transpose_item_fp8(P.in[I_WDN] + (size_t)(l * 32 + e) * 1024 * 1024, 1024, P.ws + WS_WDN + (size_t)(l * 32 + e) * 1024 * 1024, 64 * kb, 32 * nb, 32 * nb, scr, c.lane, 128.f); }
    }
}

__device__ __forceinline__ void ph_mod(const Ctx& c) {
    const Params& P = *c.P;
    float* cs = (float*)c.lds;
    float* part = cs + 8192;
    for (int i = c.tid; i < 8192; i += NTHREADS) cs[i] = silu_f(P.in[I_C][i]);
    __syncthreads();
    float* mod = (float*)(P.ws + WS_MOD);
    for (int item = c.bid; item < DEPTH_ * 96; item += c.nblk) {
        const int l = item / 96, j = (item % 96) * 64 + c.lane;
        const float* w = P.in[I_WADA] + (size_t)l * 1024 * 6144 + j;
        float acc[8];
#pragma unroll
        for (int b = 0; b < 8; ++b) acc[b] = 0.f;
        const int k0 = c.wave * 128;
#pragma unroll 8
        for (int k = k0; k < k0 + 128; ++k) { const float wv = w[(size_t)k * 6144];
#pragma unroll
            for (int b = 0; b < 8; ++b) acc[b] += cs[b * 1024 + k] * wv; }
#pragma unroll
        for (int b = 0; b < 8; ++b) part[(c.wave * 8 + b) * 64 + c.lane] = acc[b];
        __syncthreads();
        { const int b = c.tid >> 6, col = c.tid & 63; float s = 0.f;
#pragma unroll
          for (int w8 = 0; w8 < 8; ++w8) s += part[(w8 * 8 + b) * 64 + col];
          const int jj = (item % 96) * 64 + col;
          mod[((size_t)l * 8 + b) * 6144 + jj] = s + P.in[I_BADA][l * 6144 + jj]; }
        __syncthreads();
    }
}

__device__ __forceinline__ void store_bf16_row(bf16_t* row, int lane, const f32x4 (&v)[4]) {
#pragma unroll
    for (int j = 0; j < 4; ++j) { u32x2 w; w.x = pk2(v[j][0], v[j][1]); w.y = pk2(v[j][2], v[j][3]); *(u32x2*)(row + 4 * lane + 256 * j) = w; }
}
__device__ __forceinline__ void modulate(f32x4 (&h)[4], const f32x4 (&x)[4], const float* sh, const float* sc, int lane) {
#pragma unroll
    for (int j = 0; j < 4; ++j) { const f32x4 a = *(const f32x4*)(sc + 4 * lane + 256 * j), b = *(const f32x4*)(sh + 4 * lane + 256 * j); h[j] = x[j] * (1.f + a) + b; }
}
__device__ __forceinline__ void ln_rows(f32x4 (&v)[4], const float* g, const float* b, int lane) {
    float s = 0.f;
#pragma unroll
    for (int j = 0; j < 4; ++j) s += (v[j][0] + v[j][1]) + (v[j][2] + v[j][3]);
    const float mean = wave_sum(s) * (1.f / 1024.f); float s2 = 0.f;
#pragma unroll
    for (int j = 0; j < 4; ++j) { v[j] = v[j] - mean; s2 += (v[j][0] * v[j][0] + v[j][1] * v[j][1]) + (v[j][2] * v[j][2] + v[j][3] * v[j][3]); }
    const float rstd = 1.f / sqrtf(wave_sum(s2) * (1.f / 1024.f) + LN_EPS_);
#pragma unroll
    for (int j = 0; j < 4; ++j) { const f32x4 gg = *(const f32x4*)(g + 4 * lane + 256 * j), bb = *(const f32x4*)(b + 4 * lane + 256 * j); v[j] = v[j] * rstd * gg + bb; }
}

__device__ __forceinline__ void ph_prep0(const Ctx& c) {
    const Params& P = *c.P; const float* mod = (const float*)(P.ws + WS_MOD);
    bf16_t* H = (bf16_t*)(P.ws + WS_H);
    for (int t = c.gw; t < T_; t += c.ngw) {
        const int b = t / SEQ_; const float* xr = P.in[I_X] + (size_t)t * 1024;
        f32x4 x[4], h[4];
#pragma unroll
        for (int j = 0; j < 4; ++j) x[j] = *(const f32x4*)(xr + 4 * c.lane + 256 * j);
        modulate(h, x, mod + (size_t)b * 6144, mod + (size_t)b * 6144 + 1024, c.lane);
        store_bf16_row(H + (size_t)t * 1024, c.lane, h);
    }
}

struct DenseSched {
    const char* A; const char* Bt; int nM, nN, G, c;
    __device__ __forceinline__ bool next(int i, pg8::Unit& u) const {
        const int L = i * G + c; if (L >= nM * nN) return false;
        pg8::tile_of(L, nM, nN, u.pm, u.pn); u.e = 0; u.ridx = nullptr;
        u.a = A + (size_t)u.pm * 256 * 2048; u.b = Bt + (size_t)u.pn * 256 * 2048; return true; }
};
struct MoeSched {
    const char* A; const char* Bt; const int* blk_e; int nrb, nN, G, c; size_t estride; const int* rowtok; int gather; int rb;
    __device__ __forceinline__ bool next(int i, pg8::Unit& u) const {
        const int L = i * G + c; if (L >= nrb * nN) return false;
        pg8::tile_of(L, nrb, nN, u.pm, u.pn); u.e = blk_e[u.pm]; u.ridx = rowtok + u.pm * 256;
        u.a = gather ? A : A + (size_t)u.pm * 256 * rb; u.b = Bt + (size_t)u.e * estride + (size_t)u.pn * 256 * rb; return true; }
};
struct EpiStoreBf16 {
    static constexpr bool PERM = true;
    bf16_t* O; int ldc;
    __device__ __forceinline__ void operator()(const f32x4 (&acc)[2][2][4][2], const pg8::Unit& u, int wr, int wc, int fr, int fq) const {
        const int row0 = u.pm * 256 + wr * 64 + fr, col0 = u.pn * 256 + wc * 32 + 8 * fq;
#pragma unroll
        for (int ai = 0; ai < 2; ++ai)
#pragma unroll
            for (int m = 0; m < 4; ++m) { bf16_t* rowp = O + (size_t)(row0 + ai * 128 + m * 16) * ldc + col0;
#pragma unroll
                for (int bj = 0; bj < 2; ++bj) { const f32x4 v0 = acc[ai][bj][m][0], v1 = acc[ai][bj][m][1];
                    u32x4 w; w.x = pg8::cvt_pk_bf16(v0[0], v0[1]); w.y = pg8::cvt_pk_bf16(v0[2], v0[3]); w.z = pg8::cvt_pk_bf16(v1[0], v1[1]); w.w = pg8::cvt_pk_bf16(v1[2], v1[3]);
                    *(u32x4*)(rowp + bj * 128) = w; } }
    }
};
struct EpiResid {
    static constexpr bool PERM = false;
    const float* X; const float* gate; float* Z;
    __device__ __forceinline__ void operator()(const f32x4 (&acc)[2][2][4][2], const pg8::Unit& u, int wr, int wc, int fr, int fq) const {
        const int row0 = u.pm * 256 + wr * 64 + fr, col0 = u.pn * 256 + wc * 32 + 4 * fq;
        const float* gp = gate + (size_t)(u.pm >> 3) * 6144 + col0;
        f32x4 gv[2][2];
#pragma unroll
        for (int bj = 0; bj < 2; ++bj)
#pragma unroll
            for (int n = 0; n < 2; ++n) gv[bj][n] = *(const f32x4*)(gp + bj * 128 + n * 16);
#pragma unroll
        for (int ai = 0; ai < 2; ++ai)
#pragma unroll
            for (int m = 0; m < 4; ++m) { const size_t off = (size_t)(row0 + ai * 128 + m * 16) * 1024 + col0;
#pragma unroll
                for (int bj = 0; bj < 2; ++bj)
#pragma unroll
                    for (int n = 0; n < 2; ++n) { const f32x4 xv = *(const f32x4*)(X + off + bj * 128 + n * 16);
                        *(f32x4*)(Z + off + bj * 128 + n * 16) = xv * ALPHA_ + gv[bj][n] * acc[ai][bj][m][n]; } }
    }
};
struct EpiSwiglu {
    static constexpr bool PERM = true;
    bf16_t* ACT; const float* bup;
    __device__ __forceinline__ void operator()(const f32x4 (&acc)[2][2][4][2], const pg8::Unit& u, int wr, int wc, int fr, int fq) const {
        const int row0 = u.pm * 256 + wr * 64 + fr, j0 = u.pn * 128 + wc * 32 + 8 * fq;
        const float* bp = bup + (size_t)u.e * 2048 + j0;
        f32x4 bg[2], bl[2];
#pragma unroll
        for (int n = 0; n < 2; ++n) { bg[n] = *(const f32x4*)(bp + 4 * n); bl[n] = *(const f32x4*)(bp + 1024 + 4 * n); }
#pragma unroll
        for (int ai = 0; ai < 2; ++ai)
#pragma unroll
            for (int m = 0; m < 4; ++m) { float o[8];
#pragma unroll
                for (int n = 0; n < 2; ++n)
#pragma unroll
                    for (int q = 0; q < 4; ++q) { const float xg = fminf(acc[ai][0][m][n][q] + bg[n][q], 7.f); const float xl = fminf(fmaxf(acc[ai][1][m][n][q] + bl[n][q], -7.f), 7.f);
                        o[4 * n + q] = xg * sigmoid_f(1.702f * xg) * (xl + 1.f); }
                u32x2 w; w.x = pk4_fp8(o[0], o[1], o[2], o[3]); w.y = pk4_fp8(o[4], o[5], o[6], o[7]);
                *(u32x2*)((unsigned char*)ACT + (size_t)(row0 + ai * 128 + m * 16) * 1024 + j0) = w; }
    }
};
struct EpiDown {
    static constexpr bool PERM = true;
    bf16_t* Y4; const float* bdn; const int* rowtok;
    __device__ __forceinline__ void operator()(const f32x4 (&acc)[2][2][4][2], const pg8::Unit& u, int wr, int wc, int fr, int fq) const {
        const int row0 = u.pm * 256 + wr * 64 + fr, col0 = u.pn * 256 + wc * 32 + 8 * fq;
        const float* bp = bdn + (size_t)u.e * 1024 + col0;
        f32x4 bv[2][2];
#pragma unroll
        for (int bj = 0; bj < 2; ++bj)
#pragma unroll
            for (int n = 0; n < 2; ++n) bv[bj][n] = *(const f32x4*)(bp + bj * 128 + 4 * n);
#pragma unroll
        for (int ai = 0; ai < 2; ++ai)
#pragma unroll
            for (int m = 0; m < 4; ++m) { const int a = rowtok[row0 + ai * 128 + m * 16];
                if (a >= 0) { bf16_t* rowp = Y4 + (size_t)a * 1024 + col0;
#pragma unroll
                    for (int bj = 0; bj < 2; ++bj) { const f32x4 v0 = acc[ai][bj][m][0] + bv[bj][0], v1 = acc[ai][bj][m][1] + bv[bj][1];
                        u32x4 w; w.x = pg8::cvt_pk_bf16(v0[0], v0[1]); w.y = pg8::cvt_pk_bf16(v0[2], v0[3]); w.z = pg8::cvt_pk_bf16(v1[0], v1[1]); w.w = pg8::cvt_pk_bf16(v1[2], v1[3]);
                        *(u32x4*)(rowp + bj * 128) = w; } } }
    }
};

__device__ __forceinline__ int t5_bucket(int n) { if (n < 16) return n; const int v = 16 + (int)(logf((float)n * (1.f / 16.f)) / logf(8.f) * 16.f); return v < 31 ? v : 31; }

constexpr int PL_W = 0, PL_U = 65536, PL_P = PL_U + 47 * 512, PL_END = PL_P + 256 * 32 * 4;
__device__ __forceinline__ void ph_pool(const Ctx& c, int l) {
    const Params& P = *c.P; const bf16_t* proj = (const bf16_t*)(P.ws + WS_PROJ); bf16_t* mix = (bf16_t*)(P.ws + WS_MIX);
    float* Wl = (float*)(c.lds + PL_W); bf16_t* us = (bf16_t*)(c.lds + PL_U); float* pt = (float*)(c.lds + PL_P);
    if (c.bid >= T_ / 32) return;
    { const f32x4* pw = (const f32x4*)(P.in[I_POOLW] + (size_t)l * 16384);
      for (int i = c.tid; i < 4096; i += NTHREADS) ((f32x4*)Wl)[i] = pw[i]; }
    const int ch = c.tid & 255, th = c.tid >> 8, gi = ch >> 6, w = 2 << gi;
    const float psc = P.in[I_POOLS][l * 256 + ch];
    for (int tile = c.bid; tile < T_ / 32; tile += c.nblk) {
        const int t0 = tile * 32, s0 = t0 % SEQ_;
        __syncthreads();
        for (int i = c.tid; i < 47 * 32; i += NTHREADS) { const int r = i >> 5, c8 = i & 31; u32x4 v = (u32x4){0u, 0u, 0u, 0u};
            if (s0 - 15 + r >= 0) v = *(const u32x4*)(proj + (size_t)(t0 - 15 + r) * NPROJ + C_POOL + 8 * c8);
            *(u32x4*)(us + r * 256 + 8 * c8) = v; }
        __syncthreads();
        {
            const int i0 = th * 16; float sum = 0.f;
            for (int j = 1; j < w; ++j) sum += bf2f(us[(15 + i0 - j) * 256 + ch]);
#pragma unroll 4
            for (int i = i0; i < i0 + 16; ++i) { const float ui = bf2f(us[(15 + i) * 256 + ch]); sum += ui;
                const int s = s0 + i; const float cnt = (float)((s + 1) < w ? (s + 1) : w);
                pt[ch * 32 + i] = sum / cnt - ui;
                sum -= bf2f(us[(15 + i - (w - 1)) * 256 + ch]); } }
        __syncthreads();
        {
            const int d = ch & 63; float acc[16];
#pragma unroll
            for (int i = 0; i < 16; ++i) acc[i] = 0.f;
            const float* wp = Wl + gi * 4096 + d; const float* pp = pt + (gi * 64) * 32 + th * 16;
#pragma unroll 4
            for (int k = 0; k < 64; ++k) { const float wv = wp[k * 64]; const f32x4 a = *(const f32x4*)(pp + k * 32), b = *(const f32x4*)(pp + k * 32 + 4), cc = *(const f32x4*)(pp + k * 32 + 8), dd = *(const f32x4*)(pp + k * 32 + 12);
#pragma unroll
                for (int q = 0; q < 4; ++q) { acc[q] += a[q] * wv; acc[4 + q] += b[q] * wv; acc[8 + q] += cc[q] * wv; acc[12 + q] += dd[q] * wv; } }
#pragma unroll
            for (int i = 0; i < 16; ++i) mix[(size_t)(t0 + th * 16 + i) * 1024 + ch] = (bf16_t)f2bf(acc[i] * psc); }
    }
    __syncthreads();
}
__device__ __forceinline__ void swa_item(const Ctx& c, int l, int item, float* wl) {
    const Params& P = *c.P; const bf16_t* proj = (const bf16_t*)(P.ws + WS_PROJ); bf16_t* mix = (bf16_t*)(P.ws + WS_MIX);
    float* qs = wl; float* pr = wl + 64;
    const int t = item / 6, hq = item % 6, kvh = hq / 3, s = t % SEQ_, lane = c.lane;
    qs[lane] = bf2f(proj[(size_t)t * NPROJ + C_AQ + hq * 64 + lane]);
    asm volatile("s_waitcnt lgkmcnt(0)" ::: "memory");
    const float sink = P.in[I_SINKS][l * 6 + hq];
    float sc[2];
#pragma unroll
    for (int h2 = 0; h2 < 2; ++h2) { const int kk = lane + 64 * h2, dist = 127 - kk, sk = s - dist;
        float dot = -1e30f;
        if (sk >= 0) { const bf16_t* kr = proj + (size_t)(t - dist) * NPROJ + C_AK + kvh * 64; float a = 0.f;
#pragma unroll
            for (int d8 = 0; d8 < 8; ++d8) { const u32x4 kv = *(const u32x4*)(kr + d8 * 8);
                a += qs[d8 * 8 + 0] * bflo(kv.x) + qs[d8 * 8 + 1] * bfhi(kv.x) + qs[d8 * 8 + 2] * bflo(kv.y) + qs[d8 * 8 + 3] * bfhi(kv.y)
                   + qs[d8 * 8 + 4] * bflo(kv.z) + qs[d8 * 8 + 5] * bfhi(kv.z) + qs[d8 * 8 + 6] * bflo(kv.w) + qs[d8 * 8 + 7] * bfhi(kv.w); }
            dot = a * 0.125f + P.in[I_RELB][t5_bucket(dist) * 6 + hq]; }
        sc[h2] = dot; }
    const float m = fmaxf(wave_max(fmaxf(sc[0], sc[1])), sink);
    const float p0 = (sc[0] > -1e29f) ? __expf(sc[0] - m) : 0.f, p1 = (sc[1] > -1e29f) ? __expf(sc[1] - m) : 0.f;
    const float den = wave_sum(p0 + p1) + __expf(sink - m);
    pr[lane] = p0; pr[lane + 64] = p1;
    asm volatile("s_waitcnt lgkmcnt(0)" ::: "memory");
    float o = 0.f;
    const int kk0 = (s >= 127) ? 0 : (127 - s);
    for (int kk = kk0; kk < 128; ++kk) o += pr[kk] * bf2f(proj[(size_t)(t - 127 + kk) * NPROJ + C_AV + kvh * 64 + lane]);
    mix[(size_t)t * 1024 + 256 + hq * 64 + lane] = (bf16_t)f2bf(o / den);
    asm volatile("s_waitcnt lgkmcnt(0)" ::: "memory");
}
constexpr int SW_KS = 0, SW_KROW = 144, SW_VT = 272 * 144, SW_VROW = 552, SW_BIAS = SW_VT + 64 * SW_VROW, SW_END = SW_BIAS + 3 * 128 * 4;
__device__ __forceinline__ void swa_mfma_item(const Ctx& c, int l, int item) {
    const Params& P = *c.P; const bf16_t* proj = (const bf16_t*)(P.ws + WS_PROJ); bf16_t* mix = (bf16_t*)(P.ws + WS_MIX);
    unsigned char* Ks = c.lds + SW_KS; unsigned char* Vt = c.lds + SW_VT; float* bias_s = (float*)(c.lds + SW_BIAS);
    const int b = item >> 5, n = (item >> 1) & 15, kvh = item & 1;
    const int tok0 = b * SEQ_ + n * 128;
    __syncthreads();
#pragma unroll
    for (int i = 0; i < 4; ++i) { const int idx = c.tid + i * NTHREADS, j = idx >> 3, ch = idx & 7; const bool ok = (n > 0) || (j >= 128);
        u32x4 kv = (u32x4){0u, 0u, 0u, 0u}, vv = kv;
        if (ok) { const bf16_t* rp = proj + (size_t)(tok0 - 128 + j) * NPROJ; kv = *(const u32x4*)(rp + C_AK + kvh * 64 + 8 * ch); vv = *(const u32x4*)(rp + C_AV + kvh * 64 + 8 * ch); }
        *(u32x4*)(Ks + j * SW_KROW + 16 * ch) = kv;
        unsigned short* vt = (unsigned short*)(Vt + (8 * ch) * SW_VROW + 2 * j);
        vt[0 * (SW_VROW / 2)] = (unsigned short)(vv.x & 0xffff); vt[1 * (SW_VROW / 2)] = (unsigned short)(vv.x >> 16);
        vt[2 * (SW_VROW / 2)] = (unsigned short)(vv.y & 0xffff); vt[3 * (SW_VROW / 2)] = (unsigned short)(vv.y >> 16);
        vt[4 * (SW_VROW / 2)] = (unsigned short)(vv.z & 0xffff); vt[5 * (SW_VROW / 2)] = (unsigned short)(vv.z >> 16);
        vt[6 * (SW_VROW / 2)] = (unsigned short)(vv.w & 0xffff); vt[7 * (SW_VROW / 2)] = (unsigned short)(vv.w >> 16); }
    if (c.tid < 144) *(u32x4*)(Ks + 256 * SW_KROW + 16 * c.tid) = (u32x4){0u, 0u, 0u, 0u};
    if (c.tid < 128) { const int d = c.tid >> 1, hf = c.tid & 1; *(u32x4*)(Vt + d * SW_VROW + 512 + 16 * hf) = (u32x4){0u, 0u, 0u, 0u}; }
    if (c.tid < 384) { const int g = c.tid >> 7, dist = c.tid & 127; bias_s[c.tid] = P.in[I_RELB][t5_bucket(dist) * 6 + kvh * 3 + g]; }
    __syncthreads();
    const int lane = c.lane, qc = lane & 15, q4 = lane >> 4, i0 = 16 * c.wave, jw = i0;
    const int iq0 = i0 + qc;
#pragma unroll 1
    for (int g = 0; g < 3; ++g) {
        asm volatile("" ::: "memory");
        int iq = iq0; asm volatile("" : "+v"(iq));
        const int hq = kvh * 3 + g; const float sink = P.in[I_SINKS][l * 6 + hq];
        const bf16_t* qp = proj + (size_t)(tok0 + iq) * NPROJ + C_AQ + hq * 64 + 8 * q4;
        const bf16x8 bq0 = *(const bf16x8*)(qp), bq1 = *(const bf16x8*)(qp + 32);
        f32x4 s[10];
#pragma unroll
        for (int kt = 0; kt < 10; ++kt) { const unsigned char* kp = Ks + (jw + 16 * kt + qc) * SW_KROW + 16 * q4;
            const bf16x8 a0 = *(const bf16x8*)(kp), a1 = *(const bf16x8*)(kp + 64);
            f32x4 acc = (f32x4){0.f, 0.f, 0.f, 0.f};
            acc = __builtin_amdgcn_mfma_f32_16x16x32_bf16(a0, bq0, acc, 0, 0, 0);
            acc = __builtin_amdgcn_mfma_f32_16x16x32_bf16(a1, bq1, acc, 0, 0, 0);
            s[kt] = acc; }
        float m = -1e30f;
        const int nz = (n == 0) ? -1 : 0;
#pragma unroll
        for (int kt = 0; kt < 10; ++kt)
#pragma unroll
            for (int r = 0; r < 4; ++r) { const int j = jw + 16 * kt + 4 * q4 + r, dist = iq + 128 - j;
                const unsigned mk = (unsigned)(~((dist | (127 - dist)) >> 31)) & ~((unsigned)((j - 128) >> 31) & (unsigned)nz);
                const float val = s[kt][r] * 0.125f + bias_s[g * 128 + (dist & 127)];
                const float v = __builtin_bit_cast(float, (__builtin_bit_cast(unsigned, val) & mk) | (0xf149f2cau & ~mk));
                s[kt][r] = v; m = fmaxf(m, v); }
        m = fmaxf(m, __shfl_xor(m, 16)); m = fmaxf(m, __shfl_xor(m, 32)); m = fmaxf(m, sink);
        float sum = 0.f;
#pragma unroll
        for (int kt = 0; kt < 10; ++kt)
#pragma unroll
            for (int r = 0; r < 4; ++r) { const float pv = __expf(s[kt][r] - m); s[kt][r] = pv; sum += pv; }
        sum += __shfl_xor(sum, 16); sum += __shfl_xor(sum, 32);
        const float rden = 1.f / (sum + __expf(sink - m));
        f32x4 o[4];
#pragma unroll
        for (int dt = 0; dt < 4; ++dt) o[dt] = (f32x4){0.f, 0.f, 0.f, 0.f};
#pragma unroll
        for (int k5 = 0; k5 < 5; ++k5) {
            u32x4 pw; pw.x = pk2(s[2 * k5][0], s[2 * k5][1]); pw.y = pk2(s[2 * k5][2], s[2 * k5][3]); pw.z = pk2(s[2 * k5 + 1][0], s[2 * k5 + 1][1]); pw.w = pk2(s[2 * k5 + 1][2], s[2 * k5 + 1][3]);
            const bf16x8 pb = __builtin_bit_cast(bf16x8, pw);
#pragma unroll
            for (int dt = 0; dt < 4; ++dt) { const unsigned char* vp = Vt + (16 * dt + qc) * SW_VROW + 2 * (jw + 32 * k5 + 4 * q4);
                const u32x2 lo = *(const u32x2*)(vp), hi = *(const u32x2*)(vp + 32);
                const bf16x8 av = __builtin_bit_cast(bf16x8, (u32x4){lo.x, lo.y, hi.x, hi.y});
                o[dt] = __builtin_amdgcn_mfma_f32_16x16x32_bf16(av, pb, o[dt], 0, 0, 0); } }
        bf16_t* op = mix + (size_t)(tok0 + iq) * 1024 + 256 + hq * 64 + 4 * q4;
#pragma unroll
        for (int dt = 0; dt < 4; ++dt) { u32x2 w; w.x = pk2(o[dt][0] * rden, o[dt][1] * rden); w.y = pk2(o[dt][2] * rden, o[dt][3] * rden); *(u32x2*)(op + 16 * dt) = w; }
    }
}
__device__ __forceinline__ void gdn_prep_tok(const Ctx& c, int l, int t) {
    const Params& P = *c.P; const bf16_t* proj = (const bf16_t*)(P.ws + WS_PROJ); const int lane = c.lane, s = t % SEQ_;
    float* QN = (float*)(P.ws + WS_QN); float* KN = (float*)(P.ws + WS_KN); float* VV = (float*)(P.ws + WS_VV); float* GB = (float*)(P.ws + WS_GB);
    const float* cw = P.in[I_CONVW] + (size_t)l * 4 * 1152;
#pragma unroll 1
    for (int grp = 0; grp < 18; ++grp) { const int ch = grp * 64 + lane; float a = 0.f;
#pragma unroll
        for (int j = 0; j < 4; ++j) { const int sj = s - 3 + j; if (sj >= 0) a += cw[j * 1152 + ch] * bf2f(proj[(size_t)(t - 3 + j) * NPROJ + C_GQ + ch]); }
        a = silu_f(a);
        if (grp < 12) { const float ss = wave_sum(a * a); a = a * (1.f / sqrtf(ss + NORM_EPS_)); }
        if (grp < 6) QN[(size_t)t * 384 + ch] = a * 0.125f;
        else if (grp < 12) KN[(size_t)t * 384 + (ch - 384)] = a;
        else VV[(size_t)t * 384 + (ch - 768)] = a; }
    if (lane < 6) { const float braw = bf2f(proj[(size_t)t * NPROJ + C_GB + lane]), araw = bf2f(proj[(size_t)t * NPROJ + C_GA + lane]);
        const float xx = araw + P.in[I_DTB][l * 6 + lane]; const float sp = xx > 20.f ? xx : log1pf(__expf(xx));
        GB[(size_t)t * 12 + lane] = -__expf(P.in[I_ALOG][l * 6 + lane]) * sp; GB[(size_t)t * 12 + 6 + lane] = sigmoid_f(braw); }
}
__device__ __forceinline__ void ph_gprep(const Ctx& c, int l);
__device__ __forceinline__ void ph_gscan(const Ctx& c) {
    const Params& P = *c.P;
    const float* QN = (const float*)(P.ws + WS_QN); const float* KN = (const float*)(P.ws + WS_KN); const float* VV = (const float*)(P.ws + WS_VV); const float* GB = (const float*)(P.ws + WS_GB);
    float* OR = (float*)(P.ws + WS_OR);
    float* ks = (float*)c.lds; float* qs = ks + 4096; float* vs = qs + 4096; float* gs = vs + 4096; float* bs = gs + 64;
    const int j = c.tid >> 3, p = c.tid & 7;
    for (int item = c.bid; item < NB_ * 6; item += c.nblk) {
        const int b = item / 6, h = item % 6;
        float S[8];
#pragma unroll
        for (int i = 0; i < 8; ++i) S[i] = 0.f;
        for (int ch = 0; ch < SEQ_ / 64; ++ch) {
            const int tb = b * SEQ_ + ch * 64;
            __syncthreads();
            for (int i = c.tid; i < 4096; i += NTHREADS) { const int r = i >> 6, d = i & 63; const size_t g = (size_t)(tb + r) * 384 + h * 64 + d; ks[i] = KN[g]; qs[i] = QN[g]; vs[i] = VV[g]; }
            if (c.tid < 64) { gs[c.tid] = __expf(GB[(size_t)(tb + c.tid) * 12 + h]); bs[c.tid] = GB[(size_t)(tb + c.tid) * 12 + 6 + h]; }
            __syncthreads();
            for (int r = 0; r < 64; ++r) {
                const float eg = gs[r], be = bs[r]; float kk[8], qq[8];
#pragma unroll
                for (int i = 0; i < 8; ++i) { kk[i] = ks[r * 64 + p * 8 + i]; qq[i] = qs[r * 64 + p * 8 + i]; }
                float kS = 0.f;
#pragma unroll
                for (int i = 0; i < 8; ++i) { S[i] *= eg; kS += kk[i] * S[i]; }
                kS += __shfl_xor(kS, 1); kS += __shfl_xor(kS, 2); kS += __shfl_xor(kS, 4);
                const float dl = be * (vs[r * 64 + j] - kS); float o = 0.f;
#pragma unroll
                for (int i = 0; i < 8; ++i) { S[i] += kk[i] * dl; o += qq[i] * S[i]; }
                o += __shfl_xor(o, 1); o += __shfl_xor(o, 2); o += __shfl_xor(o, 4);
                if (p == 0) OR[(size_t)(tb + r) * 384 + h * 64 + j] = o;
            }
        }
    }
}
constexpr size_t WS_GOP = WS_QN;
constexpr size_t WS_GCD = WS_QN + 64 * MiB;
constexpr int GOP_BYTES = 40960, GOP_W = 0, GOP_QD = 8192, GOP_AT = 16384, GOP_KT = 24576, GOP_U = 32768;
constexpr int GP_HALF = 55296, GP_RAW = 0, GP_LS = 0, GP_WT = 16384, GP_KB = 25728, GP_QB = 34944, GP_VB = 44160, GP_GT = 53376, GP_ROW = 144;

__device__ __forceinline__ void gdn_subst(float (&x)[64], const float* Ls, int lane) {
#pragma unroll
    for (int j = 0; j < 63; ++j) {
        const int col = __builtin_bit_cast(int, Ls[j * 64 + lane]);
        const float xj = x[j];
#pragma unroll
        for (int i = j + 1; i < 64; ++i) x[i] -= __builtin_bit_cast(float, __builtin_amdgcn_readlane(col, i)) * xj;
    }
}
__device__ __forceinline__ void gdn_prep_pair(const Ctx& c, int l, int item, bool active) {
    const Params& P = *c.P; const bf16_t* proj = (const bf16_t*)(P.ws + WS_PROJ);
    const int half = c.wave >> 2, hw = c.wave & 3, lane = c.lane, htid = c.tid & 255, qc = lane & 15, q4 = lane >> 4;
    unsigned char* L0 = c.lds + half * GP_HALF;
    bf16_t* raw = (bf16_t*)(L0 + GP_RAW); float* Ls = (float*)(L0 + GP_LS); unsigned char* WT = L0 + GP_WT;
    unsigned char* KB = L0 + GP_KB; unsigned char* QB = L0 + GP_QB; unsigned char* VB = L0 + GP_VB;
    float* gc = (float*)(L0 + GP_GT); float* eg = gc + 64; float* bt = gc + 128;
    const int h = item % 6, n = (item / 6) & 31, b = item / 192;
    const int tb = b * SEQ_ + n * 64;
    const int ci = (b * 6 + h) * 32 + n;
    unsigned char* gop = P.ws + WS_GOP + (size_t)ci * GOP_BYTES;
    __syncthreads();
    if (active) {
        for (int idx = htid; idx < 67 * 24; idx += 256) { const int r = idx / 24, ch = idx % 24, grp = ch >> 3, c8 = ch & 7;
            u32x4 v = (u32x4){0u, 0u, 0u, 0u};
            if (n * 64 + r - 3 >= 0) v = *(const u32x4*)(proj + (size_t)(tb + r - 3) * NPROJ + C_GQ + grp * 384 + h * 64 + 8 * c8);
            *(u32x4*)((unsigned char*)raw + r * 384 + ch * 16) = v; }
        if (hw == 0) { const float braw = bf2f(proj[(size_t)(tb + lane) * NPROJ + C_GB + h]), araw = bf2f(proj[(size_t)(tb + lane) * NPROJ + C_GA + h]);
            const float xx = araw + P.in[I_DTB][l * 6 + h]; const float sp = xx > 20.f ? xx : log1pf(__expf(xx));
            float g = -__expf(P.in[I_ALOG][l * 6 + h]) * sp;
#pragma unroll
            for (int o = 1; o < 64; o <<= 1) { const float t = __shfl_up(g, o); if (lane >= o) g += t; }
            gc[lane] = g; eg[lane] = __expf(g); bt[lane] = sigmoid_f(braw); }
    }
    __syncthreads();
    if (active) {
        const float* cw = P.in[I_CONVW] + (size_t)l * 4 * 1152 + h * 64 + lane;
        float wq[4], wk[4], wv[4];
#pragma unroll
        for (int j = 0; j < 4; ++j) { wq[j] = cw[j * 1152]; wk[j] = cw[j * 1152 + 384]; wv[j] = cw[j * 1152 + 768]; }
#pragma unroll 4
        for (int ii = 16 * hw; ii < 16 * hw + 16; ++ii) { float aq = 0.f, ak = 0.f, av = 0.f;
#pragma unroll
            for (int j = 0; j < 4; ++j) { const bf16_t* rr = raw + (ii + j) * 192 + lane; aq += wq[j] * bf2f(rr[0]); ak += wk[j] * bf2f(rr[64]); av += wv[j] * bf2f(rr[128]); }
            aq = silu_f(aq); ak = silu_f(ak); av = silu_f(av);
            const float sq = wave_sum(aq * aq), sk = wave_sum(ak * ak);
            aq *= 0.125f / sqrtf(sq + NORM_EPS_); ak *= 1.f / sqrtf(sk + NORM_EPS_);
            *(bf16_t*)(QB + ii * GP_ROW + 2 * lane) = (bf16_t)f2bf(aq); *(bf16_t*)(KB + ii * GP_ROW + 2 * lane) = (bf16_t)f2bf(ak); *(bf16_t*)(VB + ii * GP_ROW + 2 * lane) = (bf16_t)f2bf(av); }
    }
    __syncthreads();
    if (active) {
        bf16x8 ka[2], qa[2];
#pragma unroll
        for (int ks = 0; ks < 2; ++ks) { ka[ks] = *(const bf16x8*)(KB + (16 * hw + qc) * GP_ROW + 64 * ks + 16 * q4); qa[ks] = *(const bf16x8*)(QB + (16 * hw + qc) * GP_ROW + 64 * ks + 16 * q4); }
        f32x4 at[4];
#pragma unroll
        for (int t = 0; t < 4; ++t) at[t] = (f32x4){0.f, 0.f, 0.f, 0.f};
#pragma unroll
        for (int ct = 0; ct < 4; ++ct) if (ct <= hw) {
            bf16x8 kb2[2];
#pragma unroll
            for (int ks = 0; ks < 2; ++ks) kb2[ks] = *(const bf16x8*)(KB + (16 * ct + qc) * GP_ROW + 64 * ks + 16 * q4);
            f32x4 acc = (f32x4){0.f, 0.f, 0.f, 0.f};
            acc = __builtin_amdgcn_mfma_f32_16x16x32_bf16(ka[0], kb2[0], acc, 0, 0, 0); acc = __builtin_amdgcn_mfma_f32_16x16x32_bf16(ka[1], kb2[1], acc, 0, 0, 0);
            { const int j = 16 * ct + qc; const float gj = gc[j]; f32x4 lv;
#pragma unroll
              for (int r = 0; r < 4; ++r) { const int i = 16 * hw + 4 * q4 + r; lv[r] = (i > j) ? bt[i] * acc[r] * __expf(gc[i] - gj) : 0.f; }
              *(f32x4*)(Ls + j * 64 + 16 * hw + 4 * q4) = lv; }
            f32x4 a2 = (f32x4){0.f, 0.f, 0.f, 0.f};
            a2 = __builtin_amdgcn_mfma_f32_16x16x32_bf16(kb2[0], qa[0], a2, 0, 0, 0); a2 = __builtin_amdgcn_mfma_f32_16x16x32_bf16(kb2[1], qa[1], a2, 0, 0, 0);
            { const int i = 16 * hw + qc; const float gi = gc[i];
#pragma unroll
              for (int r = 0; r < 4; ++r) { const int j = 16 * ct + 4 * q4 + r; at[ct][r] = (i >= j) ? a2[r] * __expf(gi - gc[j]) : 0.f; } }
        }
#pragma unroll
        for (int ks = 0; ks < 2; ++ks) { u32x4 w; w.x = pk2(at[2 * ks][0], at[2 * ks][1]); w.y = pk2(at[2 * ks][2], at[2 * ks][3]); w.z = pk2(at[2 * ks + 1][0], at[2 * ks + 1][1]); w.w = pk2(at[2 * ks + 1][2], at[2 * ks + 1][3]);
            *(u32x4*)(gop + GOP_AT + (hw * 2 + ks) * 1024 + lane * 16) = w; }
    }
    __syncthreads();
    if (active) {
        if (hw == 0) { float x[64];
#pragma unroll
            for (int i = 0; i < 64; ++i) x[i] = bt[i] * bf2f(*(const bf16_t*)(VB + i * GP_ROW + 2 * lane));
            gdn_subst(x, Ls, lane);
            unsigned char* up = gop + GOP_U + (lane >> 4) * 2048 + (lane & 15) * 32;
#pragma unroll
            for (int rt = 0; rt < 4; ++rt)
#pragma unroll
                for (int qq = 0; qq < 4; ++qq) { u32x2 w; w.x = pk2(x[16 * rt + 4 * qq], x[16 * rt + 4 * qq + 1]); w.y = pk2(x[16 * rt + 4 * qq + 2], x[16 * rt + 4 * qq + 3]); *(u32x2*)(up + qq * 512 + rt * 8) = w; }
        } else if (hw == 1) { float x[64];
#pragma unroll
            for (int i = 0; i < 64; ++i) x[i] = bt[i] * eg[i] * bf2f(*(const bf16_t*)(KB + i * GP_ROW + 2 * lane));
            gdn_subst(x, Ls, lane);
#pragma unroll
            for (int i = 0; i < 64; ++i) *(bf16_t*)(WT + i * GP_ROW + 2 * lane) = (bf16_t)f2bf(x[i]);
            asm volatile("s_waitcnt lgkmcnt(0)" ::: "memory");
#pragma unroll
            for (int mt = 0; mt < 4; ++mt)
#pragma unroll
                for (int ks = 0; ks < 2; ++ks) { const unsigned char* wp = WT + (16 * mt + qc) * GP_ROW + 64 * ks + 8 * q4; const u32x2 lo = *(const u32x2*)(wp), hi = *(const u32x2*)(wp + 32);
                    *(u32x4*)(gop + GOP_W + (mt * 2 + ks) * 1024 + lane * 16) = (u32x4){lo.x, lo.y, hi.x, hi.y}; }
        } else if (hw == 2) {
#pragma unroll
            for (int mt = 0; mt < 4; ++mt) { const float e = eg[16 * mt + qc];
#pragma unroll
                for (int ks = 0; ks < 2; ++ks) { const unsigned char* qp = QB + (16 * mt + qc) * GP_ROW + 64 * ks + 8 * q4; const u32x2 lo = *(const u32x2*)(qp), hi = *(const u32x2*)(qp + 32);
                    u32x4 w; w.x = pk2(bflo(lo.x) * e, bfhi(lo.x) * e); w.y = pk2(bflo(lo.y) * e, bfhi(lo.y) * e); w.z = pk2(bflo(hi.x) * e, bfhi(hi.x) * e); w.w = pk2(bflo(hi.y) * e, bfhi(hi.y) * e);
                    *(u32x4*)(gop + GOP_QD + (mt * 2 + ks) * 1024 + lane * 16) = w; } }
        } else { const float gl = gc[63];
#pragma unroll
            for (int mt = 0; mt < 4; ++mt)
#pragma unroll
                for (int ks = 0; ks < 2; ++ks) { float v[8];
#pragma unroll
                    for (int e = 0; e < 8; ++e) { const int i = 32 * ks + 4 * q4 + (e < 4 ? e : 12 + e); v[e] = bf2f(*(const bf16_t*)(KB + i * GP_ROW + 2 * (16 * mt + qc))) * __expf(gl - gc[i]); }
                    u32x4 w; w.x = pk2(v[0], v[1]); w.y = pk2(v[2], v[3]); w.z = pk2(v[4], v[5]); w.w = pk2(v[6], v[7]);
                    *(u32x4*)(gop + GOP_KT + (mt * 2 + ks) * 1024 + lane * 16) = w; }
            if (lane == 0) ((float*)(P.ws + WS_GCD))[ci] = eg[63];
        }
    }
}
__device__ __forceinline__ void ph_gprep(const Ctx& c, int l) {
    const int half = c.wave >> 2, nit = NB_ * 32 * 6, npair = (nit + 1) / 2;
    for (int pr = c.bid; pr < npair; pr += c.nblk) { const int item = 2 * pr + half; gdn_prep_pair(c, l, item < nit ? item : nit - 1, item < nit); }
    __syncthreads();
}
__device__ __forceinline__ void ph_gscan2(const Ctx& c) {
    const Params& P = *c.P; float* OR = (float*)(P.ws + WS_OR); const float* CD = (const float*)(P.ws + WS_GCD);
    const int lane = c.lane, qc = lane & 15, q4 = lane >> 4;
    if (c.wave >= 4) return;
    for (int bh = c.bid; bh < NB_ * 6; bh += c.nblk) {
        const int b = bh / 6, h = bh % 6, s = c.wave;
        f32x4 S[4];
#pragma unroll
        for (int t = 0; t < 4; ++t) S[t] = (f32x4){0.f, 0.f, 0.f, 0.f};
#pragma unroll 1
        for (int n = 0; n < 32; ++n) {
            const int ci = bh * 32 + n; const unsigned char* gop = P.ws + WS_GOP + (size_t)ci * GOP_BYTES;
            const float cd = CD[ci];
            bf16x8 sb[2];
#pragma unroll
            for (int ks = 0; ks < 2; ++ks) { u32x4 w; w.x = pk2(S[2 * ks][0], S[2 * ks][1]); w.y = pk2(S[2 * ks][2], S[2 * ks][3]); w.z = pk2(S[2 * ks + 1][0], S[2 * ks + 1][1]); w.w = pk2(S[2 * ks + 1][2], S[2 * ks + 1][3]); sb[ks] = __builtin_bit_cast(bf16x8, w); }
            const u32x4 u0 = *(const u32x4*)(gop + GOP_U + s * 2048 + lane * 32), u1 = *(const u32x4*)(gop + GOP_U + s * 2048 + lane * 32 + 16);
            f32x4 vn[4], o[4];
#pragma unroll
            for (int mt = 0; mt < 4; ++mt) { f32x4 p1 = (f32x4){0.f, 0.f, 0.f, 0.f}, q1 = p1;
#pragma unroll
                for (int ks = 0; ks < 2; ++ks) { const bf16x8 wf = *(const bf16x8*)(gop + GOP_W + (mt * 2 + ks) * 1024 + lane * 16), qf = *(const bf16x8*)(gop + GOP_QD + (mt * 2 + ks) * 1024 + lane * 16);
                    p1 = __builtin_amdgcn_mfma_f32_16x16x32_bf16(wf, sb[ks], p1, 0, 0, 0); q1 = __builtin_amdgcn_mfma_f32_16x16x32_bf16(qf, sb[ks], q1, 0, 0, 0); }
                const unsigned ua = (mt == 0) ? u0.x : (mt == 1) ? u0.z : (mt == 2) ? u1.x : u1.z, ub = (mt == 0) ? u0.y : (mt == 1) ? u0.w : (mt == 2) ? u1.y : u1.w;
                vn[mt] = (f32x4){bflo(ua), bfhi(ua), bflo(ub), bfhi(ub)} - p1; o[mt] = q1; }
            bf16x8 vb[2];
#pragma unroll
            for (int ks = 0; ks < 2; ++ks) { u32x4 w; w.x = pk2(vn[2 * ks][0], vn[2 * ks][1]); w.y = pk2(vn[2 * ks][2], vn[2 * ks][3]); w.z = pk2(vn[2 * ks + 1][0], vn[2 * ks + 1][1]); w.w = pk2(vn[2 * ks + 1][2], vn[2 * ks + 1][3]); vb[ks] = __builtin_bit_cast(bf16x8, w); }
#pragma unroll
            for (int mt = 0; mt < 4; ++mt) { S[mt] = S[mt] * cd;
#pragma unroll
                for (int ks = 0; ks < 2; ++ks) { const bf16x8 af = *(const bf16x8*)(gop + GOP_AT + (mt * 2 + ks) * 1024 + lane * 16), kf = *(const bf16x8*)(gop + GOP_KT + (mt * 2 + ks) * 1024 + lane * 16);
                    o[mt] = __builtin_amdgcn_mfma_f32_16x16x32_bf16(af, vb[ks], o[mt], 0, 0, 0); S[mt] = __builtin_amdgcn_mfma_f32_16x16x32_bf16(kf, vb[ks], S[mt], 0, 0, 0); } }
            float* op = OR + (size_t)(b * SEQ_ + n * 64 + 4 * q4) * 384 + h * 64 + 16 * s + qc;
#pragma unroll
            for (int mt = 0; mt < 4; ++mt)
#pragma unroll
                for (int r = 0; r < 4; ++r) op[(size_t)(16 * mt + r) * 384] = o[mt][r];
        }
    }
}
__device__ __forceinline__ void ph_gout(const Ctx& c, int l) {
    const Params& P = *c.P; const bf16_t* proj = (const bf16_t*)(P.ws + WS_PROJ); bf16_t* mix = (bf16_t*)(P.ws + WS_MIX); const float* OR = (const float*)(P.ws + WS_OR);
    const float nw = P.in[I_NORMW][l * 64 + c.lane];
    for (int t = c.gw; t < T_; t += c.ngw) {
#pragma unroll
        for (int h = 0; h < 6; ++h) { const float o = OR[(size_t)t * 384 + h * 64 + c.lane]; const float ms = wave_sum(o * o) * (1.f / 64.f);
            const float z = bf2f(proj[(size_t)t * NPROJ + C_GZ + h * 64 + c.lane]);
            mix[(size_t)t * 1024 + 640 + h * 64 + c.lane] = (bf16_t)f2bf(o * (1.f / sqrtf(ms + NORM_EPS_)) * nw * silu_f(z)); }
    }
}

template <int N, int B> __device__ __forceinline__ void xred_step(const float (&p)[N], float (&q)[N / 2], int lane) {
    const bool up = (lane & B) != 0;
#pragma unroll
    for (int i = 0; i < N / 2; ++i) { const float keep = up ? p[i + N / 2] : p[i], send = up ? p[i] : p[i + N / 2]; q[i] = keep + __shfl_xor(send, B); }
}
__device__ __forceinline__ float xred32(const float (&p)[32], int lane) {
    float a[16], b[8], c4[4], d[2], e[1];
    xred_step<32, 32>(p, a, lane); xred_step<16, 16>(a, b, lane); xred_step<8, 8>(b, c4, lane); xred_step<4, 4>(c4, d, lane); xred_step<2, 2>(d, e, lane);
    return e[0] + __shfl_xor(e[0], 1);
}
__device__ __forceinline__ void top4_store(float mylg, int lane, int* ti, float* tg) {
    int bi[4]; float bv[4];
#pragma unroll
    for (int k = 0; k < 4; ++k) { const float best = wave_max(mylg); const unsigned long long bal = __ballot(mylg == best); const int id = (__ffsll((long long)bal) - 1) >> 1;
        if ((lane >> 1) == id) mylg = -3.0e38f;
        bi[k] = id; bv[k] = best; }
    const float e1 = __expf(bv[1] - bv[0]), e2 = __expf(bv[2] - bv[0]), e3 = __expf(bv[3] - bv[0]), inv = 1.f / (1.f + e1 + e2 + e3);
    if (lane == 0) { *(int4*)ti = make_int4(bi[0], bi[1], bi[2], bi[3]); *(f32x4*)tg = (f32x4){inv, e1 * inv, e2 * inv, e3 * inv}; }
}
__device__ __forceinline__ void ph_ln1(const Ctx& c, int l) {
    const Params& P = *c.P; const float* mod = (const float*)(P.ws + WS_MOD) + (size_t)l * 8 * 6144;
    const float* Z = (const float*)(P.ws + WS_Z); float* X1 = (float*)(P.ws + WS_X1); bf16_t* H2 = (bf16_t*)(P.ws + WS_H2); int* TI = (int*)(P.ws + WS_TOPI); float* TG = (float*)(P.ws + WS_TOPG);
    float* wr = (float*)c.lds;
    const float* rw = P.in[I_RW] + (size_t)l * 1024 * 32;
    for (int i = c.tid; i < 32768; i += NTHREADS) { const int k = i >> 5, e = i & 31; wr[e * 1024 + k] = rw[i]; }
    __syncthreads();
    const float* g = P.in[I_LN1G] + l * 1024; const float* bb = P.in[I_LN1B] + l * 1024; const float rbias = P.in[I_RB][l * 32 + (c.lane >> 1)];
    for (int tp = c.gw; tp < T_ / 2; tp += c.ngw) {
        const int t0 = 2 * tp, b = t0 / SEQ_;
        f32x4 v0[4], v1[4], h0[4], h1[4];
#pragma unroll
        for (int j = 0; j < 4; ++j) { v0[j] = *(const f32x4*)(Z + (size_t)t0 * 1024 + 4 * c.lane + 256 * j); v1[j] = *(const f32x4*)(Z + (size_t)(t0 + 1) * 1024 + 4 * c.lane + 256 * j); }
        ln_rows(v0, g, bb, c.lane); ln_rows(v1, g, bb, c.lane);
#pragma unroll
        for (int j = 0; j < 4; ++j) { *(f32x4*)(X1 + (size_t)t0 * 1024 + 4 * c.lane + 256 * j) = v0[j]; *(f32x4*)(X1 + (size_t)(t0 + 1) * 1024 + 4 * c.lane + 256 * j) = v1[j]; }
        modulate(h0, v0, mod + (size_t)b * 6144 + 3072, mod + (size_t)b * 6144 + 4096, c.lane);
        modulate(h1, v1, mod + (size_t)b * 6144 + 3072, mod + (size_t)b * 6144 + 4096, c.lane);
        { unsigned char* hp = (unsigned char*)H2 + (size_t)t0 * 1024 + 4 * c.lane;
#pragma unroll
          for (int j = 0; j < 4; ++j) { *(unsigned*)(hp + 256 * j) = pk4_fp8(h0[j][0], h0[j][1], h0[j][2], h0[j][3]); *(unsigned*)(hp + 1024 + 256 * j) = pk4_fp8(h1[j][0], h1[j][1], h1[j][2], h1[j][3]); } }
        float p0[32], p1[32];
#pragma unroll
        for (int e = 0; e < 32; ++e) { float a0 = 0.f, a1 = 0.f;
            const float* wp = wr + e * 1024 + 4 * c.lane;
            if (e >= 2) asm volatile("" : "+v"(wp) : "v"(p0[e - 2]));
#pragma unroll
            for (int j = 0; j < 4; ++j) { const f32x4 w = *(const f32x4*)(wp + 256 * j);
                a0 += (h0[j][0] * w[0] + h0[j][1] * w[1]) + (h0[j][2] * w[2] + h0[j][3] * w[3]); a1 += (h1[j][0] * w[0] + h1[j][1] * w[1]) + (h1[j][2] * w[2] + h1[j][3] * w[3]); }
            p0[e] = a0; p1[e] = a1; }
        const float lg0 = xred32(p0, c.lane) + rbias, lg1 = xred32(p1, c.lane) + rbias;
        top4_store(lg0, c.lane, TI + (size_t)t0 * 4, TG + (size_t)t0 * 4);
        top4_store(lg1, c.lane, TI + (size_t)(t0 + 1) * 4, TG + (size_t)(t0 + 1) * 4);
    }
    __syncthreads();
}

__device__ __forceinline__ void ph_routea(const Ctx& c) {
    const Params& P = *c.P; const int* TI = (const int*)(P.ws + WS_TOPI); int* R = (int*)(P.ws + WS_ROUTE);
    int* hist = (int*)c.lds;
    for (int seg = c.bid; seg < 256; seg += c.nblk) {
        if (c.tid < 32) hist[c.tid] = 0;
        __syncthreads();
        if (c.tid < 256) atomicAdd(&hist[TI[seg * 256 + c.tid]], 1);
        __syncthreads();
        if (c.tid < 32) R[R_COUNTS + seg * 32 + c.tid] = hist[c.tid];
        __syncthreads();
    }
}
__device__ __forceinline__ void ph_routeb(const Ctx& c) {
    const Params& P = *c.P; const int* TI = (const int*)(P.ws + WS_TOPI); int* R = (int*)(P.ws + WS_ROUTE);
    int* tot = (int*)c.lds; int* off = tot + 32; int* pst = off + 32; int* eid = pst + 64;
    for (int seg = c.bid; seg < 256; seg += c.nblk) {
        if (c.tid < 32) { int a = 0, o = 0; for (int s2 = 0; s2 < 256; ++s2) { const int v = R[R_COUNTS + s2 * 32 + c.tid]; a += v; if (s2 < seg) o += v; } tot[c.tid] = a; off[c.tid] = o; }
        if (c.tid < 256) eid[c.tid] = TI[seg * 256 + c.tid];
        __syncthreads();
        if (c.tid == 0) { int ps = 0; for (int e = 0; e < 32; ++e) { pst[e] = ps; ps += ((tot[e] + 255) >> 8) << 8; } pst[32] = ps; }
        __syncthreads();
        if (c.tid < 256) { const int e = eid[c.tid]; int rank = 0; for (int q = 0; q < c.tid; ++q) rank += (eid[q] == e) ? 1 : 0;
            R[R_ROWTOK + pst[e] + off[e] + rank] = seg * 256 + c.tid; }
        if (seg == 0) {
            for (int e = 0; e < 32; ++e) { const int lo = pst[e] + tot[e], hi = pst[e + 1]; for (int q = lo + c.tid; q < hi; q += NTHREADS) R[R_ROWTOK + q] = -1; }
            const int nrb = pst[32] >> 8;
            for (int rb = c.tid; rb < nrb; rb += NTHREADS) { int e = 0; for (int q = 1; q < 32; ++q) if ((rb << 8) >= pst[q]) e = q; R[R_BLKE + rb] = e; }
            if (c.tid == 0) R[R_NRB] = nrb;
        }
        __syncthreads();
    }
}
__device__ __forceinline__ void ph_gather(const Ctx& c) {
    const Params& P = *c.P; const int* R = (const int*)(P.ws + WS_ROUTE); const bf16_t* H2 = (const bf16_t*)(P.ws + WS_H2); bf16_t* XB = (bf16_t*)(P.ws + WS_XBUF);
    const int nrows = R[R_NRB] * 256;
    for (int r = c.gw; r < nrows; r += c.ngw) { const int a = R[R_ROWTOK + r];
        u32x4 v0 = (u32x4){0u, 0u, 0u, 0u}, v1 = v0;
        if (a >= 0) { const bf16_t* src = H2 + (size_t)(a >> 2) * 1024; v0 = *(const u32x4*)(src + 8 * c.lane); v1 = *(const u32x4*)(src + 512 + 8 * c.lane); }
        *(u32x4*)(XB + (size_t)r * 1024 + 8 * c.lane) = v0; *(u32x4*)(XB + (size_t)r * 1024 + 512 + 8 * c.lane) = v1; }
}

__device__ __forceinline__ void ph_combine(const Ctx& c, int l) {
    const Params& P = *c.P; const float* mod = (const float*)(P.ws + WS_MOD) + (size_t)l * 8 * 6144;
    const float* X1 = (const float*)(P.ws + WS_X1); const bf16_t* Y4 = (const bf16_t*)(P.ws + WS_Y4); const float* TG = (const float*)(P.ws + WS_TOPG);
    float* XO = (l == DEPTH_ - 1) ? P.out : (float*)(P.ws + WS_X); bf16_t* H = (bf16_t*)(P.ws + WS_H);
    const float* g = P.in[I_LN2G] + l * 1024; const float* bb = P.in[I_LN2B] + l * 1024;
    for (int t = c.gw; t < T_; t += c.ngw) {
        const int b = t / SEQ_; const f32x4 gt = *(const f32x4*)(TG + (size_t)t * 4);
        f32x4 v[4];
#pragma unroll
        for (int j = 0; j < 4; ++j) { const int col = 4 * c.lane + 256 * j; f32x4 y = (f32x4){0.f, 0.f, 0.f, 0.f};
#pragma unroll
            for (int k = 0; k < 4; ++k) { const u32x2 w = *(const u32x2*)(Y4 + (size_t)(t * 4 + k) * 1024 + col); y += gt[k] * (f32x4){bflo(w.x), bfhi(w.x), bflo(w.y), bfhi(w.y)}; }
            const f32x4 x1 = *(const f32x4*)(X1 + (size_t)t * 1024 + col), g2 = *(const f32x4*)(mod + (size_t)b * 6144 + 5120 + col);
            v[j] = x1 * ALPHA_ + g2 * y; }
        ln_rows(v, g, bb, c.lane);
#pragma unroll
        for (int j = 0; j < 4; ++j) *(f32x4*)(XO + (size_t)t * 1024 + 4 * c.lane + 256 * j) = v[j];
        if (l + 1 < DEPTH_) { const float* m2 = (const float*)(P.ws + WS_MOD) + (size_t)(l + 1) * 8 * 6144 + (size_t)b * 6144; f32x4 h[4];
            modulate(h, v, m2, m2 + 1024, c.lane); store_bf16_row(H + (size_t)t * 1024, c.lane, h); }
    }
}

#define XB_TMO      128
#define XB_XCNT(j)  (256  + 64 * (j))
#define XB_XSUB(j)  (1280 + 64 * (j))
#define XB_XGEN(j)  (2304 + 64 * (j))
#define XB_TOP      3328
#define XB_TOPGEN   3392
#define XCD_BAR_WORDS 3456
#define XB_SPIN_CAP (1u << 18)
constexpr int CW_BAR = 4096;
constexpr int MISC_OFF = LDS_BYTES - 256;
__device__ __forceinline__ unsigned xb_ld(unsigned* p)              { return __hip_atomic_load(p, __ATOMIC_RELAXED, __HIP_MEMORY_SCOPE_AGENT); }
__device__ __forceinline__ unsigned xb_add(unsigned* p, unsigned v) { return __hip_atomic_fetch_add(p, v, __ATOMIC_RELAXED, __HIP_MEMORY_SCOPE_AGENT); }
__device__ __forceinline__ unsigned xb_xcc_id() { return (unsigned)__builtin_amdgcn_s_getreg((3 << 11) | 20) & 0xFu; }
#define XB_SPIN(cond, bar) do { unsigned _sp = 0; while (cond) { __builtin_amdgcn_s_sleep(1); \
    if ((++_sp & 255u) == 0u) { if (xb_ld(&(bar)[XB_TMO])) break; if (_sp > XB_SPIN_CAP) { atomicAdd(&(bar)[XB_TMO], 1u); break; } } } } while (0)
struct XcdBarrier { unsigned* bar; unsigned x; volatile LAS unsigned* st; };
__device__ __forceinline__ XcdBarrier xcd_barrier_post(unsigned* bar, volatile LAS unsigned* st) {
    XcdBarrier b; b.bar = bar; b.x = xb_xcc_id(); b.st = st;
    if (threadIdx.x == 0) (void)xb_add(&bar[XB_XCNT(b.x)], 1u);
    return b;
}
__device__ __forceinline__ void xcd_barrier_complete(unsigned* bar, unsigned x, unsigned& nloc, unsigned& nx) {
    const unsigned G = gridDim.x * gridDim.y * gridDim.z;
    unsigned sum, cnt, mine, sp = 0u;
    for (;;) {
        sum = 0u; cnt = 0u; mine = 0u;
#pragma unroll
        for (unsigned j = 0; j < 16; ++j) { const unsigned c = xb_ld(&bar[XB_XCNT(j)]); sum += c; cnt += (c > 0u) ? 1u : 0u; mine = (j == x) ? c : mine; }
        if (sum == G) break;
        __builtin_amdgcn_s_sleep(1);
        if ((++sp & 255u) == 0u) { if (xb_ld(&bar[XB_TMO])) break; if (sp > XB_SPIN_CAP) { atomicAdd(&bar[XB_TMO], 1u); break; } }
    }
    nloc = mine > 0u ? mine : 1u; nx = cnt > 0u ? cnt : 1u;
}
__device__ __forceinline__ void xcd_barrier(const XcdBarrier& b) {
    asm volatile("s_waitcnt vmcnt(0)" ::: "memory");
    __syncthreads();
    if (threadIdx.x == 0) {
        unsigned* bar = b.bar;
        __builtin_amdgcn_s_waitcnt(0);
        unsigned nloc = b.st[0], nx = b.st[1];
        if (nloc == 0u) { xcd_barrier_complete(bar, b.x, nloc, nx); b.st[0] = nloc; b.st[1] = nx; }
        const unsigned old = xb_add(&bar[XB_XSUB(b.x)], 1u);
        const unsigned gen = old / nloc;
        if (old + 1u == (gen + 1u) * nloc) {
            __builtin_amdgcn_fence(__ATOMIC_RELEASE, "agent");
            asm volatile("s_waitcnt vmcnt(0)" ::: "memory");
            const unsigned og = xb_add(&bar[XB_TOP], 1u);
            const unsigned tg = og / nx;
            if (og + 1u == (tg + 1u) * nx) xb_add(&bar[XB_TOPGEN], 1u);
            else XB_SPIN(xb_ld(&bar[XB_TOPGEN]) == tg, bar);
            __builtin_amdgcn_fence(__ATOMIC_ACQUIRE, "agent");
            xb_add(&bar[XB_XGEN(b.x)], 1u);
            asm volatile("s_waitcnt vmcnt(0)" ::: "memory");
        } else {
            XB_SPIN(xb_ld(&bar[XB_XGEN(b.x)]) == gen, bar);
            __builtin_amdgcn_fence(__ATOMIC_ACQUIRE, "agent");
            asm volatile("s_waitcnt vmcnt(0)" ::: "memory");
        }
    }
    __syncthreads();
}

template <int KIND>
__device__ __forceinline__ void run_kind(const Ctx& c0, int l) {
    Ctx c = c0;
    { int t = c0.tid; asm volatile("" : "+v"(t)); c.tid = t; c.lane = t & 63; c.wave = __builtin_amdgcn_readfirstlane(t >> 6); }
    { int b = c0.bid, n = c0.nblk; asm volatile("" : "+s"(b), "+s"(n)); c.bid = b; c.nblk = n; c.gw = b * NWAVES + c.wave; c.ngw = n * NWAVES; }
    { long z = 0; asm volatile("" : "+s"(z)); c.P = (const Params*)((const char*)c0.P + z); }
    const Params& P = *c.P; LAS unsigned char* lds3 = (LAS unsigned char*)c.lds;
    const int* R = (const int*)(P.ws + WS_ROUTE);
    if constexpr (KIND == 0) ph_conv(c);
    else if constexpr (KIND == 1) ph_mod(c);
    else if constexpr (KIND == 2) ph_prep0(c);
    else if constexpr (KIND == 3 + L_GEMM1) { DenseSched S{(const char*)(P.ws + WS_H), (const char*)(P.ws + WS_WIN) + (size_t)l * NPROJ * 2048, T_ / 256, NPROJ / 256, c.nblk, c.bid};
        EpiStoreBf16 E{(bf16_t*)(P.ws + WS_PROJ), NPROJ};
        pg8::gemm_phase<EpiStoreBf16, DenseSched, true, true>(lds3, S, E, c.tid); }
    else if constexpr (KIND == 3 + L_MIXA) ph_pool(c, l);
    else if constexpr (KIND == 3 + L_SWA) { for (int it = c.bid; it < NB_ * 16 * 2; it += c.nblk) swa_mfma_item(c, l, it); __syncthreads(); }
    else if constexpr (KIND == 3 + L_GPREP) ph_gprep(c, l);
    else if constexpr (KIND == 3 + L_GSCAN) ph_gscan2(c);
    else if constexpr (KIND == 3 + L_GOUT) ph_gout(c, l);
    else if constexpr (KIND == 3 + L_GEMM2) { DenseSched S{(const char*)(P.ws + WS_MIX), (const char*)(P.ws + WS_WOUT) + (size_t)l * 1024 * 2048, T_ / 256, 4, c.nblk, c.bid};
        EpiResid E{l == 0 ? P.in[I_X] : (const float*)(P.ws + WS_X), (const float*)(P.ws + WS_MOD) + (size_t)l * 8 * 6144 + 2048, (float*)(P.ws + WS_Z)};
        pg8::gemm_phase<EpiResid, DenseSched, true, true>(lds3, S, E, c.tid); }
    else if constexpr (KIND == 3 + L_LN1) ph_ln1(c, l);
    else if constexpr (KIND == 3 + L_ROUTEA) ph_routea(c);
    else if constexpr (KIND == 3 + L_ROUTEB) ph_routeb(c);
    else if constexpr (KIND == 3 + L_GATHER) ph_gather(c);
    else if constexpr (KIND == 3 + L_UP) { MoeSched S{(const char*)(P.ws + WS_H2), (const char*)(P.ws + WS_WUP) + (size_t)l * 32 * 2048 * 1024, R + R_BLKE, R[R_NRB], 8, c.nblk, c.bid, (size_t)2048 * 1024, R + R_ROWTOK, 1, 1024};
        EpiSwiglu E{(bf16_t*)(P.ws + WS_ACT), P.in[I_BUP] + (size_t)l * 32 * 2048};
        pg8::gemm_phase<EpiSwiglu, MoeSched, true, true, true, 1, 121>(lds3, S, E, c.tid); }
    else if constexpr (KIND == 3 + L_DOWN) { MoeSched S{(const char*)(P.ws + WS_ACT), (const char*)(P.ws + WS_WDN) + (size_t)l * 32 * 1024 * 1024, R + R_BLKE, R[R_NRB], 4, c.nblk, c.bid, (size_t)1024 * 1024, R + R_ROWTOK, 0, 1024};
        EpiDown E{(bf16_t*)(P.ws + WS_Y4), P.in[I_BDN] + (size_t)l * 32 * 1024, R + R_ROWTOK};
        pg8::gemm_phase<EpiDown, MoeSched, true, true, false, 1, 120>(lds3, S, E, c.tid); }
    else if constexpr (KIND == 3 + L_COMBINE) ph_combine(c, l);
}

#define SEAM() xcd_barrier(bar)
#ifndef PROBE_KIND
#define PROBE_KIND -1
#endif
#define RK(K, L) do { run_kind<K>(c, L); if ((K) == PROBE_KIND && (L) == 0) { SEAM(); run_kind<K>(c, L); } } while (0)
template <int L> __device__ __forceinline__ void run_layer(const Ctx& c, const XcdBarrier& bar) {
    RK(3 + L_GEMM1, L); SEAM();
    RK(3 + L_MIXA, L); RK(3 + L_SWA, L); RK(3 + L_GPREP, L); SEAM();
    RK(3 + L_GSCAN, L); SEAM();
    RK(3 + L_GOUT, L); SEAM();
    RK(3 + L_GEMM2, L); SEAM();
    RK(3 + L_LN1, L); SEAM();
    RK(3 + L_ROUTEA, L); SEAM();
    RK(3 + L_ROUTEB, L); SEAM();
    RK(3 + L_UP, L); SEAM();
    RK(3 + L_DOWN, L); SEAM();
    RK(3 + L_COMBINE, L);
}
__global__ void __launch_bounds__(NTHREADS, 2) mk_fwd(Params P) {
    extern __shared__ __attribute__((aligned(16))) unsigned char lds[];
    Ctx c; c.P = &P; c.lds = lds; c.tid = threadIdx.x; c.lane = c.tid & 63; c.wave = __builtin_amdgcn_readfirstlane(c.tid >> 6);
    c.bid = blockIdx.x; c.nblk = gridDim.x; c.gw = c.bid * NWAVES + c.wave; c.ngw = c.nblk * NWAVES;
    for (int u = c.tid; u < 64; u += NTHREADS) ((volatile LAS unsigned*)((LAS unsigned char*)lds + MISC_OFF))[u] = 0u;
    __syncthreads();
    const XcdBarrier bar = xcd_barrier_post((unsigned*)(P.ws + WS_CTL) + CW_BAR, (volatile LAS unsigned*)((LAS unsigned char*)lds + MISC_OFF) + 8);
    RK(0, 0); __syncthreads(); RK(1, 0); SEAM();
    RK(2, 0); SEAM();
    run_layer<0>(c, bar); SEAM();
    run_layer<1>(c, bar);
}

extern "C" void kernel_launch(void* const* d_in, const int* in_sizes, int n_in, void* d_out, int out_size, void* d_ws, size_t ws_size, hipStream_t stream) {
    static int grid = 0;
    if (grid == 0) {
        if (n_in != N_IN || out_size != T_ * D_ || ws_size < WS_END) { fprintf(stderr, "kernel_launch: unexpected shapes (n_in %d out %d ws %zu need %zu)\n", n_in, out_size, ws_size, (size_t)WS_END); grid = -1; return; }
        int dev = 0, cus = 0, per_cu = 0;
        (void)hipGetDevice(&dev); (void)hipDeviceGetAttribute(&cus, hipDeviceAttributeMultiprocessorCount, dev);
        (void)hipFuncSetAttribute((const void*)mk_fwd, hipFuncAttributeMaxDynamicSharedMemorySize, LDS_BYTES);
        if (hipOccupancyMaxActiveBlocksPerMultiprocessor(&per_cu, (const void*)mk_fwd, NTHREADS, LDS_BYTES) != hipSuccess || per_cu < 1) { fprintf(stderr, "kernel_launch: occupancy query says %d blocks/CU\n", per_cu); (void)hipGetLastError(); grid = -1; return; }
        grid = cus > 0 ? cus : 256;
    }
    if (grid < 0) return;
    (void)hipMemsetAsync((char*)d_ws + WS_CTL, 0, 1 * MiB, stream);
    Params p{};
    for (int i = 0; i < N_IN; ++i) p.in[i] = (const float*)d_in[i];
    p.out = (float*)d_out; p.ws = (unsigned char*)d_ws;
    void* args[] = {&p};
    hipError_t e = hipLaunchCooperativeKernel((const void*)mk_fwd, dim3(grid), dim3(NTHREADS), args, LDS_BYTES, stream);
    if (e != hipSuccess) fprintf(stderr, "cooperative launch failed: %s (grid %d)\n", hipGetErrorString(e), grid);
}
```

```cpp
#include <hip/hip_runtime.h>
#include <hip/hip_cooperative_groups.h>
#include <cstdio>
#include <cstdint>
namespace cg = cooperative_groups;

#define LAS __attribute__((address_space(3)))
typedef unsigned short bf16_t;
typedef short bf16x8 __attribute__((ext_vector_type(8)));
typedef short bf16x16 __attribute__((ext_vector_type(16)));
typedef int v8i32 __attribute__((ext_vector_type(8)));
typedef int v4i32 __attribute__((ext_vector_type(4)));
typedef float f32x4 __attribute__((ext_vector_type(4)));
typedef float f32x2 __attribute__((ext_vector_type(2)));
typedef unsigned u32x4 __attribute__((ext_vector_type(4)));
typedef unsigned u32x2 __attribute__((ext_vector_type(2)));

constexpr int T_ = 16384, D_ = 1024, NB_ = 8, SEQ_ = 2048, DEPTH_ = 2;
constexpr int IN_DIM = 2444, NPROJ = 2560;
constexpr int C_POOL = 0, C_AQ = 256, C_AK = 640, C_AV = 768, C_GQ = 896, C_GK = 1280, C_GV = 1664, C_GZ = 2048, C_GB = 2432, C_GA = 2438;
constexpr int NE_ = 32, TOPK_ = 4, NASSIGN = T_ * TOPK_, NRB_MAX = NASSIGN / 256 + NE_, PROWS = NRB_MAX * 256;
constexpr float ALPHA_ = 1.41421356237309515f;
constexpr float LN_EPS_ = 1e-5f, NORM_EPS_ = 1e-6f;
constexpr int NTHREADS = 512, NWAVES = 8;
constexpr int LDS_BYTES = 147456;

constexpr size_t MiB = 1u << 20;
constexpr size_t WS_CTL = 0;
constexpr size_t WS_MOD = 1 * MiB;
constexpr size_t WS_ROUTE = 2 * MiB;
constexpr size_t WS_WIN = 4 * MiB;
constexpr size_t WS_WOUT = 14 * MiB;
constexpr size_t WS_WUP = 18 * MiB;
constexpr size_t WS_WDN = WS_WUP + 256 * MiB;
constexpr size_t WS_H = WS_WDN + 128 * MiB;
constexpr size_t WS_H2 = WS_H + 32 * MiB;
constexpr size_t WS_PROJ = WS_H2 + 32 * MiB;
constexpr size_t WS_MIX = WS_PROJ + 80 * MiB;
constexpr size_t WS_Z = WS_MIX + 32 * MiB;
constexpr size_t WS_X = WS_Z + 64 * MiB;
constexpr size_t WS_QN = WS_X + 64 * MiB;
constexpr size_t WS_KN = WS_QN + 24 * MiB;
constexpr size_t WS_VV = WS_KN + 24 * MiB;
constexpr size_t WS_OR = WS_VV + 24 * MiB;
constexpr size_t WS_GB = WS_OR + 24 * MiB;
constexpr size_t WS_TOPI = WS_GB + 1 * MiB;
constexpr size_t WS_TOPG = WS_TOPI + 1 * MiB;
constexpr size_t WS_XBUF = WS_TOPG + 1 * MiB;
constexpr size_t WS_ACT = WS_XBUF + 144 * MiB;
constexpr size_t WS_Y4 = WS_ACT + 144 * MiB;
constexpr size_t WS_X1 = WS_Y4 + 128 * MiB;
constexpr size_t WS_END = WS_X1 + 64 * MiB;
constexpr int CW_CNT = 8192, CW_CUR = 8448;
constexpr int R_COUNTS = 0;
constexpr int R_BLKE = 8192;
constexpr int R_NRB = 8192 + 512;
constexpr int R_ROWTOK = 16384;

__device__ __forceinline__ unsigned f2bf(float f) { unsigned u = __builtin_bit_cast(unsigned, f); return (u + 0x7fffu + ((u >> 16) & 1u)) >> 16; }
__device__ __forceinline__ unsigned pk2(float lo, float hi) { return f2bf(lo) | (f2bf(hi) << 16); }
__device__ __forceinline__ float bf2f(unsigned short b) { return __builtin_bit_cast(float, (unsigned)b << 16); }
__device__ __forceinline__ float bflo(unsigned w) { return __builtin_bit_cast(float, w << 16); }
__device__ __forceinline__ float bfhi(unsigned w) { return __builtin_bit_cast(float, w & 0xffff0000u); }
__device__ __forceinline__ unsigned pk4_fp8(float a, float b, float c, float d) { int w = __builtin_amdgcn_cvt_pk_fp8_f32(a, b, 0, false); w = __builtin_amdgcn_cvt_pk_fp8_f32(c, d, w, true); return (unsigned)w; }
__device__ __forceinline__ float wave_sum(float v) {
#pragma unroll
    for (int o = 1; o < 64; o <<= 1) v += __shfl_xor(v, o);
    return v;
}
__device__ __forceinline__ float wave_max(float v) {
#pragma unroll
    for (int o = 1; o < 64; o <<= 1) v = fmaxf(v, __shfl_xor(v, o));
    return v;
}
__device__ __forceinline__ float silu_f(float x) { return x / (1.f + __expf(-x)); }
__device__ __forceinline__ float sigmoid_f(float x) { return 1.f / (1.f + __expf(-x)); }

namespace pg8 {
constexpr int BM = 256, BK = 64, HALF = 128, HTB = HALF * BK * 2, STAGE_BYTES = 8 * HTB, NXCD = 8, WGM = 8, KD = 1024;
__host__ __device__ __forceinline__ int lds_byte(int r, int c) { const int st = (r >> 4) * 2 + (c >> 5), rr = r & 15, cc = c & 31, ob = rr * 64 + cc * 2; return st * 1024 + (ob ^ (((ob >> 9) & 1) << 5)); }
__host__ __device__ __forceinline__ void stage_rc(int b, int& R, int& C) { const int st = b / 1024, sb = b % 1024, swz = sb ^ (((sb >> 9) & 1) << 5); R = (st >> 1) * 16 + swz / 64; C = (st & 1) * 32 + (swz % 64) / 2; }
__host__ __device__ __forceinline__ int perm32(int rho) { const int n = rho >> 4, i = rho & 15; return 8 * (i >> 2) + 4 * n + (i & 3); }

struct Unit { int pm, pn, e; const char* a; const char* b; const int* ridx; };

__device__ __forceinline__ void tile_of(int L, int nM, int nN, int& pm, int& pn) {
    const int nwg = nM * nN; int wgid = L;
    { const int q = nwg / NXCD, r = nwg % NXCD, xcd = wgid % NXCD, off = wgid / NXCD; wgid = (xcd < r ? xcd * (q + 1) : r * (q + 1) + (xcd - r) * q) + off; }
    const int nig = WGM * nN, gid = wgid / nig, fm = gid * WGM, gsz = (nM - fm) < WGM ? (nM - fm) : WGM;
    pm = fm + ((wgid % nig) % gsz); pn = (wgid % nig) / gsz;
}

__device__ __forceinline__ unsigned cvt_pk_bf16(float lo, float hi) { unsigned r; asm volatile("v_cvt_pk_bf16_f32 %0, %1, %2" : "=v"(r) : "v"(lo), "v"(hi)); return r; }

template <class Epi, class Sched, bool ALIGN_EPI, bool SP2, bool GATHER = false, int EB = 2, int WSC = 127>
__device__ __forceinline__ void gemm_phase(LAS unsigned char* lds, const Sched& S, const Epi& E, const int tid) {
    const int wid = __builtin_amdgcn_readfirstlane(tid >> 6), lane = tid & 63, wr = wid >> 2, wc = wid & 3, fr = lane & 15, fq = lane >> 4;
    constexpr int K = KD, RB = K * EB  , nt = RB / (BK * 2);
    unsigned voffA[2], voffB[2];
#pragma unroll
    for (int i = 0; i < 2; ++i) { int R, C; stage_rc(tid * 16 + i * 8192, R, C); const int Rb = Epi::PERM ? ((R & ~31) + perm32(R & 31)) : R;
        voffA[i] = (unsigned)(R * RB + C * 2); voffB[i] = (unsigned)(Rb * RB + C * 2); }
    const size_t kstep = (size_t)(BK * 2);
    const size_t hstep = (size_t)HALF * RB;
    const size_t hsA = GATHER ? 0 : hstep;
    int gR[2], gC[2];
#pragma unroll
    for (int i = 0; i < 2; ++i) stage_rc(tid * 16 + i * 8192, gR[i], gC[i]);
    unsigned vgC0[2], vgC1[2], vgN0[2], vgN1[2];
#define PG8_GLOAD(dst0, dst1, u) do { _Pragma("unroll") for (int _i = 0; _i < 2; ++_i) { const int _r0 = (u).ridx[gR[_i]], _r1 = (u).ridx[HALF + gR[_i]]; \
        dst0[_i] = (unsigned)((_r0 < 0 ? 0 : _r0 >> 2) * RB + gC[_i] * 2); dst1[_i] = (unsigned)((_r1 < 0 ? 0 : _r1 >> 2) * RB + gC[_i] * 2); } } while (0)
    const unsigned ldsw = (unsigned)wid * 1024u;
    const int aoff = lds_byte(wr * 64 + fr, fq * 8), boff = lds_byte(wc * 32 + fr, fq * 8);
#define PG8_SA(b, h) (((b) * 2 + (h)) * HTB)
#define PG8_SB(b, h) ((4 + (b) * 2 + (h)) * HTB)
#define PG8_STAGE(bufoff, gbase, voff) do { _Pragma("unroll") for (int _i = 0; _i < 2; ++_i) \
        __builtin_amdgcn_global_load_lds((const unsigned*)((const char*)(gbase) + (voff)[_i]), (LAS unsigned*)(lds + (bufoff) + ldsw + _i * 8192), 16, 0, 0); } while (0)
#define PG8_RD8(off) __builtin_shufflevector(*(const LAS v4i32*)(lds + (off)), *(const LAS v4i32*)(lds + (off) + 1024), 0, 1, 2, 3, 4, 5, 6, 7)
#define PG8_LDA(dst, b, h) do { _Pragma("unroll") for (int m = 0; m < 4; ++m) { if constexpr (EB == 2) { _Pragma("unroll") for (int k = 0; k < 2; ++k) dst[m][k] = *(const LAS bf16x8*)(lds + PG8_SA(b, h) + aoff + m * 2048 + k * 1024); } \
        else dst##8[m] = PG8_RD8(PG8_SA(b, h) + aoff + m * 2048); } } while (0)
#define PG8_LDB(dst, b, h) do { _Pragma("unroll") for (int n = 0; n < 2; ++n) { if constexpr (EB == 2) { _Pragma("unroll") for (int k = 0; k < 2; ++k) dst[n][k] = *(const LAS bf16x8*)(lds + PG8_SB(b, h) + boff + n * 2048 + k * 1024); } \
        else dst##8[n] = PG8_RD8(PG8_SB(b, h) + boff + n * 2048); } } while (0)
#define PG8_MMA(ai, bj, At, Bt) do { __builtin_amdgcn_s_setprio(1); _Pragma("unroll") for (int m = 0; m < 4; ++m) _Pragma("unroll") for (int n = 0; n < 2; ++n) { \
        if constexpr (EB == 2) { _Pragma("unroll") for (int k = 0; k < 2; ++k) acc[ai][bj][m][n] = __builtin_amdgcn_mfma_f32_16x16x32_bf16(Bt[n][k], At[m][k], acc[ai][bj][m][n], 0, 0, 0); } \
        else asm volatile("v_mfma_scale_f32_16x16x128_f8f6f4 %0, %1, %2, %0, %3, %4 op_sel_hi:[0,0,0]" : "+v"(acc[ai][bj][m][n]) : "v"(Bt##8[n]), "v"(At##8[m]), "v"(sc_w), "v"(sc_a)); } \
        __builtin_amdgcn_s_setprio(0); } while (0)
#define PG8_WAIT_V(n) asm volatile("s_waitcnt vmcnt(" #n ")" ::: "memory")
#define PG8_WAIT_L(n) asm volatile("s_waitcnt lgkmcnt(" #n ")" ::: "memory")
#define PG8_BAR __builtin_amdgcn_s_barrier()
#define PG8_SCHED __builtin_amdgcn_sched_barrier(0)
    Unit cur, nxt; int ui = 0;
    if (!S.next(0, cur)) return;
    f32x4 acc[2][2][4][2];
#pragma unroll
    for (int a = 0; a < 2; ++a)
#pragma unroll
        for (int b = 0; b < 2; ++b)
#pragma unroll
            for (int m = 0; m < 4; ++m)
#pragma unroll
                for (int n = 0; n < 2; ++n) acc[a][b][m][n] = (f32x4){0.f, 0.f, 0.f, 0.f};
    int sc_w = WSC, sc_a = 127; asm volatile("" : "+v"(sc_w), "+v"(sc_a));
    bf16x8 At[4][2], B0[2][2], B1[2][2]; v8i32 At8[4], B08[2], B18[2];
    const char* cA = cur.a; const char* cB = cur.b;
    if constexpr (GATHER) { PG8_GLOAD(vgC0, vgC1, cur); _Pragma("unroll") for (int i = 0; i < 2; ++i) { vgN0[i] = vgC0[i]; vgN1[i] = vgC1[i]; } }
    if constexpr (SP2) {
        PG8_STAGE(PG8_SB(0, 0), cB, voffB); PG8_STAGE(PG8_SB(0, 1), cB + hstep, voffB); PG8_STAGE(PG8_SA(0, 0), cA, (GATHER ? vgC0 : voffA)); PG8_STAGE(PG8_SA(0, 1), cA + hsA, (GATHER ? vgC1 : voffA));
        if (wr == 1) PG8_BAR;
        PG8_WAIT_V(2); PG8_BAR;
        PG8_STAGE(PG8_SB(1, 0), cB + kstep, voffB); PG8_STAGE(PG8_SA(1, 0), cA + kstep, (GATHER ? vgC0 : voffA)); PG8_STAGE(PG8_SB(1, 1), cB + hstep + kstep, voffB);
        PG8_WAIT_V(6); PG8_BAR;
    } else {
        PG8_STAGE(PG8_SB(0, 0), cB, voffB); PG8_STAGE(PG8_SA(0, 0), cA, voffA); PG8_STAGE(PG8_SB(0, 1), cB + hstep, voffB); PG8_STAGE(PG8_SA(0, 1), cA + hstep, voffA);
        if (wr == 1) PG8_BAR;
        PG8_WAIT_V(4); PG8_BAR;
        PG8_STAGE(PG8_SB(1, 0), cB + kstep, voffB); PG8_STAGE(PG8_SA(1, 0), cA + kstep, voffA); PG8_STAGE(PG8_SB(1, 1), cB + hstep + kstep, voffB);
        PG8_WAIT_V(6); PG8_BAR;
    }
    for (;;) {
        const bool has_next = S.next(ui + 1, nxt);
        const char* nA = has_next ? nxt.a : cA; const char* nB = has_next ? nxt.b : cB;
        if constexpr (GATHER) { if (has_next) PG8_GLOAD(vgN0, vgN1, nxt); }
#pragma unroll 1
        for (int t = 0; t < nt; t += 2) {
            const bool last = (t == nt - 2);
            unsigned vA0[2], vA1[2];
            if constexpr (GATHER) { if (last) { vA0[0] = vgN0[0]; vA0[1] = vgN0[1]; vA1[0] = vgN1[0]; vA1[1] = vgN1[1]; } else { vA0[0] = vgC0[0]; vA0[1] = vgC0[1]; vA1[0] = vgC1[0]; vA1[1] = vgC1[1]; } }
            const char* a1 = cA + (size_t)(t + 1) * kstep;
            const char* a2 = last ? nA : cA + (size_t)(t + 2) * kstep; const char* b2 = last ? nB : cB + (size_t)(t + 2) * kstep;
            const char* a3 = a2 + kstep; const char* b3 = b2 + kstep;
            if constexpr (SP2) {
            PG8_LDB(B0, 0, 0); PG8_LDB(B1, 0, 1); PG8_SCHED; PG8_LDA(At, 0, 0); PG8_STAGE(PG8_SA(1, 1), a1 + hsA, (GATHER ? vgC1 : voffA));
            PG8_WAIT_V(8); PG8_WAIT_L(0); PG8_BAR; PG8_MMA(0, 0, At, B0); PG8_MMA(0, 1, At, B1); PG8_BAR; PG8_SCHED;
            PG8_LDA(At, 0, 1); PG8_STAGE(PG8_SB(0, 0), b2, voffB); PG8_STAGE(PG8_SB(0, 1), b2 + hstep, voffB); PG8_STAGE(PG8_SA(0, 0), a2, (GATHER ? vA0 : voffA));
            PG8_WAIT_V(8); PG8_WAIT_L(0); PG8_BAR; PG8_MMA(1, 0, At, B0); PG8_MMA(1, 1, At, B1); PG8_BAR; PG8_SCHED;
            PG8_LDB(B0, 1, 0); PG8_LDB(B1, 1, 1); PG8_SCHED; PG8_LDA(At, 1, 0); PG8_STAGE(PG8_SA(0, 1), a2 + hsA, (GATHER ? vA1 : voffA));
            PG8_WAIT_V(8); PG8_WAIT_L(0); PG8_BAR; PG8_MMA(0, 0, At, B0); PG8_MMA(0, 1, At, B1); PG8_BAR; PG8_SCHED;
            PG8_LDA(At, 1, 1); PG8_STAGE(PG8_SB(1, 0), b3, voffB); PG8_STAGE(PG8_SB(1, 1), b3 + hstep, voffB); PG8_STAGE(PG8_SA(1, 0), a3, (GATHER ? vA0 : voffA));
            PG8_WAIT_V(8); PG8_WAIT_L(0); PG8_BAR; PG8_MMA(1, 0, At, B0); PG8_MMA(1, 1, At, B1); PG8_BAR; PG8_SCHED;
            } else {
            PG8_LDB(B0, 0, 0); PG8_SCHED; PG8_LDA(At, 0, 0); PG8_STAGE(PG8_SA(1, 1), a1 + hstep, voffA);
            PG8_WAIT_L(8); PG8_BAR; PG8_WAIT_L(0); PG8_MMA(0, 0, At, B0); PG8_BAR; PG8_SCHED;
            PG8_LDB(B1, 0, 1); PG8_STAGE(PG8_SB(0, 0), b2, voffB);
            PG8_BAR; PG8_WAIT_L(0); PG8_MMA(0, 1, At, B1); PG8_BAR;
            PG8_LDA(At, 0, 1); PG8_STAGE(PG8_SA(0, 0), a2, voffA);
            PG8_BAR; PG8_WAIT_L(0); PG8_MMA(1, 0, At, B0); PG8_BAR; PG8_SCHED;
            PG8_STAGE(PG8_SB(0, 1), b2 + hstep, voffB);
            PG8_WAIT_V(6); PG8_BAR; PG8_MMA(1, 1, At, B1); PG8_BAR;
            PG8_LDB(B0, 1, 0); PG8_SCHED; PG8_LDA(At, 1, 0); PG8_STAGE(PG8_SA(0, 1), a2 + hstep, voffA);
            PG8_WAIT_L(8); PG8_BAR; PG8_WAIT_L(0); PG8_MMA(0, 0, At, B0); PG8_BAR; PG8_SCHED;
            PG8_LDB(B1, 1, 1); PG8_STAGE(PG8_SB(1, 0), b3, voffB);
            PG8_BAR; PG8_WAIT_L(0); PG8_MMA(0, 1, At, B1); PG8_BAR;
            PG8_LDA(At, 1, 1); PG8_STAGE(PG8_SA(1, 0), a3, voffA);
            PG8_BAR; PG8_WAIT_L(0); PG8_MMA(1, 0, At, B0); PG8_BAR; PG8_SCHED;
            PG8_STAGE(PG8_SB(1, 1), b3 + hstep, voffB);
            PG8_WAIT_V(6); PG8_BAR; PG8_MMA(1, 1, At, B1); PG8_BAR;
            }
        }
        if constexpr (ALIGN_EPI) { if (wr == 0) PG8_BAR; }
        if constexpr (EB == 1) asm volatile("s_nop 15\n\ts_nop 7" ::: "memory");
        E(acc, cur, wr, wc, fr, fq);
        if (!has_next) break;
#pragma unroll
        for (int a = 0; a < 2; ++a)
#pragma unroll
            for (int b = 0; b < 2; ++b)
#pragma unroll
                for (int m = 0; m < 4; ++m)
#pragma unroll
                    for (int n = 0; n < 2; ++n) acc[a][b][m][n] = (f32x4){0.f, 0.f, 0.f, 0.f};
        cur = nxt; cA = nA; cB = nB; ++ui;
        if constexpr (GATHER) { _Pragma("unroll") for (int i = 0; i < 2; ++i) { vgC0[i] = vgN0[i]; vgC1[i] = vgN1[i]; } }
        if constexpr (ALIGN_EPI) { if (wr == 1) PG8_BAR; }
    }
    PG8_WAIT_V(0);
    if constexpr (!ALIGN_EPI) { if (wr == 0) PG8_BAR; }
    PG8_BAR;
#undef PG8_GLOAD
#undef PG8_SA
#undef PG8_SB
#undef PG8_STAGE
#undef PG8_LDA
#undef PG8_LDB
#undef PG8_MMA
#undef PG8_RD8
#undef PG8_WAIT_V
#undef PG8_WAIT_L
#undef PG8_BAR
#undef PG8_SCHED
}
}

enum { I_X = 0, I_C, I_RELB, I_WIN, I_WOUT, I_WADA, I_BADA, I_LN1G, I_LN1B, I_LN2G, I_LN2B, I_POOLW, I_POOLS, I_SINKS, I_CONVW, I_ALOG, I_DTB, I_NORMW,
       I_RW, I_RB, I_WUP, I_BUP, I_WDN, I_BDN, N_IN };
struct Params { const float* in[N_IN]; float* out; unsigned char* ws; };

struct Ctx {
    const Params* P; unsigned char* lds; int tid, lane, wave, gw, ngw, bid, nblk;
};

enum { PH_CONV = 0, PH_MOD, PH_PREP0, PH_L0 };
enum { L_GEMM1 = 0, L_MIXA, L_SWA, L_GPREP, L_GSCAN, L_GOUT, L_GEMM2, L_LN1, L_ROUTEA, L_ROUTEB, L_GATHER, L_UP, L_DOWN, L_COMBINE, L_NPH };
constexpr int N_PHASES = PH_L0 + DEPTH_ * L_NPH;

__device__ __forceinline__ void transpose_item_fp8(const float* W, int N, unsigned char* WT, int k0, int n0, int drow0, float* scr, int lane, float scale) {
    const int n = n0 + (lane & 31);
#pragma unroll 8
    for (int i = 0; i < 32; ++i) { const int kk = 2 * i + (lane >> 5); scr[kk * 33 + (lane & 31)] = W[(size_t)(k0 + kk) * N + n] * scale; }
    asm volatile("s_waitcnt lgkmcnt(0)" ::: "memory");
    const int nn = lane >> 1, hf = lane & 1; const float* s = scr + (32 * hf) * 33 + nn;
    u32x4 o0, o1;
    o0.x = pk4_fp8(s[0 * 33], s[1 * 33], s[2 * 33], s[3 * 33]); o0.y = pk4_fp8(s[4 * 33], s[5 * 33], s[6 * 33], s[7 * 33]); o0.z = pk4_fp8(s[8 * 33], s[9 * 33], s[10 * 33], s[11 * 33]); o0.w = pk4_fp8(s[12 * 33], s[13 * 33], s[14 * 33], s[15 * 33]);
    o1.x = pk4_fp8(s[16 * 33], s[17 * 33], s[18 * 33], s[19 * 33]); o1.y = pk4_fp8(s[20 * 33], s[21 * 33], s[22 * 33], s[23 * 33]); o1.z = pk4_fp8(s[24 * 33], s[25 * 33], s[26 * 33], s[27 * 33]); o1.w = pk4_fp8(s[28 * 33], s[29 * 33], s[30 * 33], s[31 * 33]);
    unsigned char* dst = WT + (size_t)(drow0 + nn) * 1024 + k0 + 32 * hf;
    *(u32x4*)dst = o0; *(u32x4*)(dst + 16) = o1;
    asm volatile("s_waitcnt lgkmcnt(0)" ::: "memory");
}
__device__ __forceinline__ void transpose_item(const float* W, int N, bf16_t* WT, int k0, int n0, int drow0, float* scr, int lane) {
    const int n = n0 + (lane & 31); const bool ok = n < N;
#pragma unroll 8
    for (int i = 0; i < 32; ++i) { const int kk = 2 * i + (lane >> 5); scr[kk * 33 + (lane & 31)] = ok ? W[(size_t)(k0 + kk) * N + n] : 0.f; }
    asm volatile("s_waitcnt lgkmcnt(0)" ::: "memory");
    const int c = lane & 7;
#pragma unroll
    for (int j = 0; j < 4; ++j) { const int nn = (lane >> 3) + 8 * j; const float* s = scr + (8 * c) * 33 + nn;
        u32x4 o; o.x = pk2(s[0 * 33], s[1 * 33]); o.y = pk2(s[2 * 33], s[3 * 33]); o.z = pk2(s[4 * 33], s[5 * 33]); o.w = pk2(s[6 * 33], s[7 * 33]);
        *(u32x4*)(WT + (size_t)(drow0 + nn) * 1024 + k0 + 8 * c) = o; }
    asm volatile("s_waitcnt lgkmcnt(0)" ::: "memory");
}
__device__ __forceinline__ void ph_conv(const Ctx& c) {
    const Params& P = *c.P;
    float* scr = (float*)(c.lds + c.wave * 16384);
    constexpr int I_IN = 16 * 80, I_OUT = 16 * 32, I_UP = 32 * 16 * 64, I_DN = 32 * 16 * 32, I_LAYER = I_IN + I_OUT + I_UP + I_DN;
    for (int it = c.gw; it < DEPTH_ * I_LAYER; it += c.ngw) {
        const int l = it / I_LAYER; int r = it % I_LAYER;
        if (r < I_IN) { const int kb = r / 80, nb = r % 80;
            transpose_item(P.in[I_WIN] + (size_t)l * 1024 * IN_DIM, IN_DIM, (bf16_t*)(P.ws + WS_WIN) + (size_t)l * NPROJ * 1024, 64 * kb, 32 * nb, 32 * nb, scr, c.lane); continue; }
        r -= I_IN;
        if (r < I_OUT) { const int kb = r / 32, nb = r % 32;
            transpose_item(P.in[I_WOUT] + (size_t)l * 1024 * 1024, 1024, (bf16_t*)(P.ws + WS_WOUT) + (size_t)l * 1024 * 1024, 64 * kb, 32 * nb, 32 * nb, scr, c.lane); continue; }
        r -= I_OUT;
        if (r < I_UP) { const int e = r / 1024, rr = r % 1024, kb = rr / 64, nb = rr % 64, n0 = 32 * nb, bj = n0 / 1024, rem = n0 % 1024, pn = rem / 128, c0 = rem % 128;
            transpose_item_fp8(P.in[I_WUP] + (size_t)(l * 32 + e) * 1024 * 2048, 2048, P.ws + WS_WUP + (size_t)(l * 32 + e) * 2048 * 1024, 64 * kb, n0, pn * 256 + bj * 128 + c0, scr, c.lane, 64.f); continue; }
        r -= I_UP;
        { const int e = r / 512, rr = r % 512, kb = rr / 32, nb = rr % 32;
            transpose_item_fp8(P.in[I_WDN] + (size_t)(l * 32 + e) * 1024 * 1024, 1024, P.ws + WS_WDN + (size_t)(l * 32 + e) * 1024 * 1024, 64 * kb, 32 * nb, 32 * nb, scr, c.lane, 128.f); }
    }
}

__device__ __forceinline__ void ph_mod(const Ctx& c) {
    const Params& P = *c.P;
    float* cs = (float*)c.lds;
    float* part = cs + 8192;
    for (int i = c.tid; i < 8192; i += NTHREADS) cs[i] = silu_f(P.in[I_C][i]);
    __syncthreads();
    float* mod = (float*)(P.ws + WS_MOD);
    for (int item = c.bid; item < DEPTH_ * 96; item += c.nblk) {
        const int l = item / 96, j = (item % 96) * 64 + c.lane;
        const float* w = P.in[I_WADA] + (size_t)l * 1024 * 6144 + j;
        float acc[8];
#pragma unroll
        for (int b = 0; b < 8; ++b) acc[b] = 0.f;
        const int k0 = c.wave * 128;
#pragma unroll 8
        for (int k = k0; k < k0 + 128; ++k) { const float wv = w[(size_t)k * 6144];
#pragma unroll
            for (int b = 0; b < 8; ++b) acc[b] += cs[b * 1024 + k] * wv; }
#pragma unroll
        for (int b = 0; b < 8; ++b) part[(c.wave * 8 + b) * 64 + c.lane] = acc[b];
        __syncthreads();
        { const int b = c.tid >> 6, col = c.tid & 63; float s = 0.f;
#pragma unroll
          for (int w8 = 0; w8 < 8; ++w8) s += part[(w8 * 8 + b) * 64 + col];
          const int jj = (item % 96) * 64 + col;
          mod[((size_t)l * 8 + b) * 6144 + jj] = s + P.in[I_BADA][l * 6144 + jj]; }
        __syncthreads();
    }
}

__device__ __forceinline__ void store_bf16_row(bf16_t* row, int lane, const f32x4 (&v)[4]) {
#pragma unroll
    for (int j = 0; j < 4; ++j) { u32x2 w; w.x = pk2(v[j][0], v[j][1]); w.y = pk2(v[j][2], v[j][3]); *(u32x2*)(row + 4 * lane + 256 * j) = w; }
}
__device__ __forceinline__ void modulate(f32x4 (&h)[4], const f32x4 (&x)[4], const float* sh, const float* sc, int lane) {
#pragma unroll
    for (int j = 0; j < 4; ++j) { const f32x4 a = *(const f32x4*)(sc + 4 * lane + 256 * j), b = *(const f32x4*)(sh + 4 * lane + 256 * j); h[j] = x[j] * (1.f + a) + b; }
}
__device__ __forceinline__ void ln_rows(f32x4 (&v)[4], const float* g, const float* b, int lane) {
    float s = 0.f;
#pragma unroll
    for (int j = 0; j < 4; ++j) s += (v[j][0] + v[j][1]) + (v[j][2] + v[j][3]);
    const float mean = wave_sum(s) * (1.f / 1024.f); float s2 = 0.f;
#pragma unroll
    for (int j = 0; j < 4; ++j) { v[j] = v[j] - mean; s2 += (v[j][0] * v[j][0] + v[j][1] * v[j][1]) + (v[j][2] * v[j][2] + v[j][3] * v[j][3]); }
    const float rstd = 1.f / sqrtf(wave_sum(s2) * (1.f / 1024.f) + LN_EPS_);
#pragma unroll
    for (int j = 0; j < 4; ++j) { const f32x4 gg = *(const f32x4*)(g + 4 * lane + 256 * j), bb = *(const f32x4*)(b + 4 * lane + 256 * j); v[j] = v[j] * rstd * gg + bb; }
}

__device__ __forceinline__ void ph_prep0(const Ctx& c) {
    const Params& P = *c.P; const float* mod = (const float*)(P.ws + WS_MOD);
    bf16_t* H = (bf16_t*)(P.ws + WS_H);
    for (int t = c.gw; t < T_; t += c.ngw) {
        const int b = t / SEQ_; const float* xr = P.in[I_X] + (size_t)t * 1024;
        f32x4 x[4], h[4];
#pragma unroll
        for (int j = 0; j < 4; ++j) x[j] = *(const f32x4*)(xr + 4 * c.lane + 256 * j);
        modulate(h, x, mod + (size_t)b * 6144, mod + (size_t)b * 6144 + 1024, c.lane);
        store_bf16_row(H + (size_t)t * 1024, c.lane, h);
    }
}

struct DenseSched {
    const char* A; const char* Bt; int nM, nN, G, c;
    __device__ __forceinline__ bool next(int i, pg8::Unit& u) const {
        const int L = i * G + c; if (L >= nM * nN) return false;
        pg8::tile_of(L, nM, nN, u.pm, u.pn); u.e = 0; u.ridx = nullptr;
        u.a = A + (size_t)u.pm * 256 * 2048; u.b = Bt + (size_t)u.pn * 256 * 2048; return true; }
};
struct MoeSched {
    const char* A; const char* Bt; const int* blk_e; int nrb, nN, G, c; size_t estride; const int* rowtok; int gather; int rb;
    __device__ __forceinline__ bool next(int i, pg8::Unit& u) const {
        const int L = i * G + c; if (L >= nrb * nN) return false;
        pg8::tile_of(L, nrb, nN, u.pm, u.pn); u.e = blk_e[u.pm]; u.ridx = rowtok + u.pm * 256;
        u.a = gather ? A : A + (size_t)u.pm * 256 * rb; u.b = Bt + (size_t)u.e * estride + (size_t)u.pn * 256 * rb; return true; }
};
struct EpiStoreBf16 {
    static constexpr bool PERM = true;
    bf16_t* O; int ldc;
    __device__ __forceinline__ void operator()(const f32x4 (&acc)[2][2][4][2], const pg8::Unit& u, int wr, int wc, int fr, int fq) const {
        const int row0 = u.pm * 256 + wr * 64 + fr, col0 = u.pn * 256 + wc * 32 + 8 * fq;
#pragma unroll
        for (int ai = 0; ai < 2; ++ai)
#pragma unroll
            for (int m = 0; m < 4; ++m) { bf16_t* rowp = O + (size_t)(row0 + ai * 128 + m * 16) * ldc + col0;
#pragma unroll
                for (int bj = 0; bj < 2; ++bj) { const f32x4 v0 = acc[ai][bj][m][0], v1 = acc[ai][bj][m][1];
                    u32x4 w; w.x = pg8::cvt_pk_bf16(v0[0], v0[1]); w.y = pg8::cvt_pk_bf16(v0[2], v0[3]); w.z = pg8::cvt_pk_bf16(v1[0], v1[1]); w.w = pg8::cvt_pk_bf16(v1[2], v1[3]);
                    *(u32x4*)(rowp + bj * 128) = w; } }
    }
};
struct EpiResid {
    static constexpr bool PERM = false;
    const float* X; const float* gate; float* Z;
    __device__ __forceinline__ void operator()(const f32x4 (&acc)[2][2][4][2], const pg8::Unit& u, int wr, int wc, int fr, int fq) const {
        const int row0 = u.pm * 256 + wr * 64 + fr, col0 = u.pn * 256 + wc * 32 + 4 * fq;
        const float* gp = gate + (size_t)(u.pm >> 3) * 6144 + col0;
        f32x4 gv[2][2];
#pragma unroll
        for (int bj = 0; bj < 2; ++bj)
#pragma unroll
            for (int n = 0; n < 2; ++n) gv[bj][n] = *(const f32x4*)(gp + bj * 128 + n * 16);
#pragma unroll
        for (int ai = 0; ai < 2; ++ai)
#pragma unroll
            for (int m = 0; m < 4; ++m) { const size_t off = (size_t)(row0 + ai * 128 + m * 16) * 1024 + col0;
#pragma unroll
                for (int bj = 0; bj < 2; ++bj)
#pragma unroll
                    for (int n = 0; n < 2; ++n) { const f32x4 xv = *(const f32x4*)(X + off + bj * 128 + n * 16);
                        *(f32x4*)(Z + off + bj * 128 + n * 16) = xv * ALPHA_ + gv[bj][n] * acc[ai][bj][m][n]; } }
    }
};
struct EpiSwiglu {
    static constexpr bool PERM = true;
    bf16_t* ACT; const float* bup;
    __device__ __forceinline__ void operator()(const f32x4 (&acc)[2][2][4][2], const pg8::Unit& u, int wr, int wc, int fr, int fq) const {
        const int row0 = u.pm * 256 + wr * 64 + fr, j0 = u.pn * 128 + wc * 32 + 8 * fq;
        const float* bp = bup + (size_t)u.e * 2048 + j0;
        f32x4 bg[2], bl[2];
#pragma unroll
        for (int n = 0; n < 2; ++n) { bg[n] = *(const f32x4*)(bp + 4 * n); bl[n] = *(const f32x4*)(bp + 1024 + 4 * n); }
#pragma unroll
        for (int ai = 0; ai < 2; ++ai)
#pragma unroll
            for (int m = 0; m < 4; ++m) { float o[8];
#pragma unroll
                for (int n = 0; n < 2; ++n)
#pragma unroll
                    for (int q = 0; q < 4; ++q) { const float xg = fminf(acc[ai][0][m][n][q] + bg[n][q], 7.f); const float xl = fminf(fmaxf(acc[ai][1][m][n][q] + bl[n][q], -7.f), 7.f);
                        o[4 * n + q] = xg * sigmoid_f(1.702f * xg) * (xl + 1.f); }
                u32x2 w; w.x = pk4_fp8(o[0], o[1], o[2], o[3]); w.y = pk4_fp8(o[4], o[5], o[6], o[7]);
                *(u32x2*)((unsigned char*)ACT + (size_t)(row0 + ai * 128 + m * 16) * 1024 + j0) = w; }
    }
};
struct EpiDown {
    static constexpr bool PERM = true;
    bf16_t* Y4; const float* bdn; const int* rowtok;
    __device__ __forceinline__ void operator()(const f32x4 (&acc)[2][2][4][2], const pg8::Unit& u, int wr, int wc, int fr, int fq) const {
        const int row0 = u.pm * 256 + wr * 64 + fr, col0 = u.pn * 256 + wc * 32 + 8 * fq;
        const float* bp = bdn + (size_t)u.e * 1024 + col0;
        f32x4 bv[2][2];
#pragma unroll
        for (int bj = 0; bj < 2; ++bj)
#pragma unroll
            for (int n = 0; n < 2; ++n) bv[bj][n] = *(const f32x4*)(bp + bj * 128 + 4 * n);
#pragma unroll
        for (int ai = 0; ai < 2; ++ai)
#pragma unroll
            for (int m = 0; m < 4; ++m) { const int a = rowtok[row0 + ai * 128 + m * 16];
                if (a >= 0) { bf16_t* rowp = Y4 + (size_t)a * 1024 + col0;
#pragma unroll
                    for (int bj = 0; bj < 2; ++bj) { const f32x4 v0 = acc[ai][bj][m][0] + bv[bj][0], v1 = acc[ai][bj][m][1] + bv[bj][1];
                        u32x4 w; w.x = pg8::cvt_pk_bf16(v0[0], v0[1]); w.y = pg8::cvt_pk_bf16(v0[2], v0[3]); w.z = pg8::cvt_pk_bf16(v1[0], v1[1]); w.w = pg8::cvt_pk_bf16(v1[2], v1[3]);
                        *(u32x4*)(rowp + bj * 128) = w; } } }
    }
};

__device__ __forceinline__ int t5_bucket(int n) { if (n < 16) return n; const int v = 16 + (int)(logf((float)n * (1.f / 16.f)) / logf(8.f) * 16.f); return v < 31 ? v : 31; }

constexpr int PL_W = 0, PL_U = 65536, PL_P = PL_U + 47 * 512, PL_END = PL_P + 256 * 32 * 4;
__device__ __forceinline__ void ph_pool(const Ctx& c, int l, int b0, int nb) {
    const Params& P = *c.P; const bf16_t* proj = (const bf16_t*)(P.ws + WS_PROJ); bf16_t* mix = (bf16_t*)(P.ws + WS_MIX);
    float* Wl = (float*)(c.lds + PL_W); bf16_t* us = (bf16_t*)(c.lds + PL_U); float* pt = (float*)(c.lds + PL_P);
    if (c.bid - b0 >= T_ / 32) return;
    { const f32x4* pw = (const f32x4*)(P.in[I_POOLW] + (size_t)l * 16384);
      for (int i = c.tid; i < 4096; i += NTHREADS) ((f32x4*)Wl)[i] = pw[i]; }
    const int ch = c.tid & 255, th = c.tid >> 8, gi = ch >> 6, w = 2 << gi;
    const float psc = P.in[I_POOLS][l * 256 + ch];
    for (int tile = c.bid - b0; tile < T_ / 32; tile += nb) {
        const int t0 = tile * 32, s0 = t0 % SEQ_;
        __syncthreads();
        for (int i = c.tid; i < 47 * 32; i += NTHREADS) { const int r = i >> 5, c8 = i & 31; u32x4 v = (u32x4){0u, 0u, 0u, 0u};
            if (s0 - 15 + r >= 0) v = *(const u32x4*)(proj + (size_t)(t0 - 15 + r) * NPROJ + C_POOL + 8 * c8);
            *(u32x4*)(us + r * 256 + 8 * c8) = v; }
        __syncthreads();
        {
            const int i0 = th * 16; float sum = 0.f;
            for (int j = 1; j < w; ++j) sum += bf2f(us[(15 + i0 - j) * 256 + ch]);
#pragma unroll 4
            for (int i = i0; i < i0 + 16; ++i) { const float ui = bf2f(us[(15 + i) * 256 + ch]); sum += ui;
                const int s = s0 + i; const float cnt = (float)((s + 1) < w ? (s + 1) : w);
                pt[ch * 32 + i] = sum / cnt - ui;
                sum -= bf2f(us[(15 + i - (w - 1)) * 256 + ch]); } }
        __syncthreads();
        {
            const int d = ch & 63; float acc[16];
#pragma unroll
            for (int i = 0; i < 16; ++i) acc[i] = 0.f;
            const float* wp = Wl + gi * 4096 + d; const float* pp = pt + (gi * 64) * 32 + th * 16;
#pragma unroll 4
            for (int k = 0; k < 64; ++k) { const float wv = wp[k * 64]; const f32x4 a = *(const f32x4*)(pp + k * 32), b = *(const f32x4*)(pp + k * 32 + 4), cc = *(const f32x4*)(pp + k * 32 + 8), dd = *(const f32x4*)(pp + k * 32 + 12);
#pragma unroll
                for (int q = 0; q < 4; ++q) { acc[q] += a[q] * wv; acc[4 + q] += b[q] * wv; acc[8 + q] += cc[q] * wv; acc[12 + q] += dd[q] * wv; } }
#pragma unroll
            for (int i = 0; i < 16; ++i) mix[(size_t)(t0 + th * 16 + i) * 1024 + ch] = (bf16_t)f2bf(acc[i] * psc); }
    }
    __syncthreads();
}
__device__ __forceinline__ void swa_item(const Ctx& c, int l, int item, float* wl) {
    const Params& P = *c.P; const bf16_t* proj = (const bf16_t*)(P.ws + WS_PROJ); bf16_t* mix = (bf16_t*)(P.ws + WS_MIX);
    float* qs = wl; float* pr = wl + 64;
    const int t = item / 6, hq = item % 6, kvh = hq / 3, s = t % SEQ_, lane = c.lane;
    qs[lane] = bf2f(proj[(size_t)t * NPROJ + C_AQ + hq * 64 + lane]);
    asm volatile("s_waitcnt lgkmcnt(0)" ::: "memory");
    const float sink = P.in[I_SINKS][l * 6 + hq];
    float sc[2];
#pragma unroll
    for (int h2 = 0; h2 < 2; ++h2) { const int kk = lane + 64 * h2, dist = 127 - kk, sk = s - dist;
        float dot = -1e30f;
        if (sk >= 0) { const bf16_t* kr = proj + (size_t)(t - dist) * NPROJ + C_AK + kvh * 64; float a = 0.f;
#pragma unroll
            for (int d8 = 0; d8 < 8; ++d8) { const u32x4 kv = *(const u32x4*)(kr + d8 * 8);
                a += qs[d8 * 8 + 0] * bflo(kv.x) + qs[d8 * 8 + 1] * bfhi(kv.x) + qs[d8 * 8 + 2] * bflo(kv.y) + qs[d8 * 8 + 3] * bfhi(kv.y)
                   + qs[d8 * 8 + 4] * bflo(kv.z) + qs[d8 * 8 + 5] * bfhi(kv.z) + qs[d8 * 8 + 6] * bflo(kv.w) + qs[d8 * 8 + 7] * bfhi(kv.w); }
            dot = a * 0.125f + P.in[I_RELB][t5_bucket(dist) * 6 + hq]; }
        sc[h2] = dot; }
    const float m = fmaxf(wave_max(fmaxf(sc[0], sc[1])), sink);
    const float p0 = (sc[0] > -1e29f) ? __expf(sc[0] - m) : 0.f, p1 = (sc[1] > -1e29f) ? __expf(sc[1] - m) : 0.f;
    const float den = wave_sum(p0 + p1) + __expf(sink - m);
    pr[lane] = p0; pr[lane + 64] = p1;
    asm volatile("s_waitcnt lgkmcnt(0)" ::: "memory");
    float o = 0.f;
    const int kk0 = (s >= 127) ? 0 : (127 - s);
    for (int kk = kk0; kk < 128; ++kk) o += pr[kk] * bf2f(proj[(size_t)(t - 127 + kk) * NPROJ + C_AV + kvh * 64 + lane]);
    mix[(size_t)t * 1024 + 256 + hq * 64 + lane] = (bf16_t)f2bf(o / den);
    asm volatile("s_waitcnt lgkmcnt(0)" ::: "memory");
}
constexpr int SW_KS = 0, SW_KROW = 144, SW_VT = 272 * 144, SW_VROW = 552, SW_BIAS = SW_VT + 64 * SW_VROW, SW_END = SW_BIAS + 3 * 128 * 4;
__device__ __forceinline__ void swa_mfma_item(const Ctx& c, int l, int item) {
    const Params& P = *c.P; const bf16_t* proj = (const bf16_t*)(P.ws + WS_PROJ); bf16_t* mix = (bf16_t*)(P.ws + WS_MIX);
    unsigned char* Ks = c.lds + SW_KS; unsigned char* Vt = c.lds + SW_VT; float* bias_s = (float*)(c.lds + SW_BIAS);
    const int b = item >> 5, n = (item >> 1) & 15, kvh = item & 1;
    const int tok0 = b * SEQ_ + n * 128;
    __syncthreads();
#pragma unroll
    for (int i = 0; i < 4; ++i) { const int idx = c.tid + i * NTHREADS, j = idx >> 3, ch = idx & 7; const bool ok = (n > 0) || (j >= 128);
        u32x4 kv = (u32x4){0u, 0u, 0u, 0u}, vv = kv;
        if (ok) { const bf16_t* rp = proj + (size_t)(tok0 - 128 + j) * NPROJ; kv = *(const u32x4*)(rp + C_AK + kvh * 64 + 8 * ch); vv = *(const u32x4*)(rp + C_AV + kvh * 64 + 8 * ch); }
        *(u32x4*)(Ks + j * SW_KROW + 16 * ch) = kv;
        unsigned short* vt = (unsigned short*)(Vt + (8 * ch) * SW_VROW + 2 * j);
        vt[0 * (SW_VROW / 2)] = (unsigned short)(vv.x & 0xffff); vt[1 * (SW_VROW / 2)] = (unsigned short)(vv.x >> 16);
        vt[2 * (SW_VROW / 2)] = (unsigned short)(vv.y & 0xffff); vt[3 * (SW_VROW / 2)] = (unsigned short)(vv.y >> 16);
        vt[4 * (SW_VROW / 2)] = (unsigned short)(vv.z & 0xffff); vt[5 * (SW_VROW / 2)] = (unsigned short)(vv.z >> 16);
        vt[6 * (SW_VROW / 2)] = (unsigned short)(vv.w & 0xffff); vt[7 * (SW_VROW / 2)] = (unsigned short)(vv.w >> 16); }
    if (c.tid < 144) *(u32x4*)(Ks + 256 * SW_KROW + 16 * c.tid) = (u32x4){0u, 0u, 0u, 0u};
    if (c.tid < 128) { const int d = c.tid >> 1, hf = c.tid & 1; *(u32x4*)(Vt + d * SW_VROW + 512 + 16 * hf) = (u32x4){0u, 0u, 0u, 0u}; }
    if (c.tid < 384) { const int g = c.tid >> 7, dist = c.tid & 127; bias_s[c.tid] = P.in[I_RELB][t5_bucket(dist) * 6 + kvh * 3 + g]; }
    __syncthreads();
    const int lane = c.lane, qc = lane & 15, q4 = lane >> 4, i0 = 16 * c.wave, jw = i0;
    const int iq0 = i0 + qc;
#pragma unroll 1
    for (int g = 0; g < 3; ++g) {
        asm volatile("" ::: "memory");
        int iq = iq0; asm volatile("" : "+v"(iq));
        const int hq = kvh * 3 + g; const float sink = P.in[I_SINKS][l * 6 + hq];
        const bf16_t* qp = proj + (size_t)(tok0 + iq) * NPROJ + C_AQ + hq * 64 + 8 * q4;
        const bf16x8 bq0 = *(const bf16x8*)(qp), bq1 = *(const bf16x8*)(qp + 32);
        f32x4 s[10];
#pragma unroll
        for (int kt = 0; kt < 10; ++kt) { const unsigned char* kp = Ks + (jw + 16 * kt + qc) * SW_KROW + 16 * q4;
            const bf16x8 a0 = *(const bf16x8*)(kp), a1 = *(const bf16x8*)(kp + 64);
            f32x4 acc = (f32x4){0.f, 0.f, 0.f, 0.f};
            acc = __builtin_amdgcn_mfma_f32_16x16x32_bf16(a0, bq0, acc, 0, 0, 0);
            acc = __builtin_amdgcn_mfma_f32_16x16x32_bf16(a1, bq1, acc, 0, 0, 0);
            s[kt] = acc; }
        float m = -1e30f;
        const int nz = (n == 0) ? -1 : 0;
#pragma unroll
        for (int kt = 0; kt < 10; ++kt)
#pragma unroll
            for (int r = 0; r < 4; ++r) { const int j = jw + 16 * kt + 4 * q4 + r, dist = iq + 128 - j;
                const unsigned mk = (unsigned)(~((dist | (127 - dist)) >> 31)) & ~((unsigned)((j - 128) >> 31) & (unsigned)nz);
                const float val = s[kt][r] * 0.125f + bias_s[g * 128 + (dist & 127)];
                const float v = __builtin_bit_cast(float, (__builtin_bit_cast(unsigned, val) & mk) | (0xf149f2cau & ~mk));
                s[kt][r] = v; m = fmaxf(m, v); }
        m = fmaxf(m, __shfl_xor(m, 16)); m = fmaxf(m, __shfl_xor(m, 32)); m = fmaxf(m, sink);
        float sum = 0.f;
#pragma unroll
        for (int kt = 0; kt < 10; ++kt)
#pragma unroll
            for (int r = 0; r < 4; ++r) { const float pv = __expf(s[kt][r] - m); s[kt][r] = pv; sum += pv; }
        sum += __shfl_xor(sum, 16); sum += __shfl_xor(sum, 32);
        const float rden = 1.f / (sum + __expf(sink - m));
        f32x4 o[4];
#pragma unroll
        for (int dt = 0; dt < 4; ++dt) o[dt] = (f32x4){0.f, 0.f, 0.f, 0.f};
#pragma unroll
        for (int k5 = 0; k5 < 5; ++k5) {
            u32x4 pw; pw.x = pk2(s[2 * k5][0], s[2 * k5][1]); pw.y = pk2(s[2 * k5][2], s[2 * k5][3]); pw.z = pk2(s[2 * k5 + 1][0], s[2 * k5 + 1][1]); pw.w = pk2(s[2 * k5 + 1][2], s[2 * k5 + 1][3]);
            const bf16x8 pb = __builtin_bit_cast(bf16x8, pw);
#pragma unroll
            for (int dt = 0; dt < 4; ++dt) { const unsigned char* vp = Vt + (16 * dt + qc) * SW_VROW + 2 * (jw + 32 * k5 + 4 * q4);
                const u32x2 lo = *(const u32x2*)(vp), hi = *(const u32x2*)(vp + 32);
                const bf16x8 av = __builtin_bit_cast(bf16x8, (u32x4){lo.x, lo.y, hi.x, hi.y});
                o[dt] = __builtin_amdgcn_mfma_f32_16x16x32_bf16(av, pb, o[dt], 0, 0, 0); } }
        bf16_t* op = mix + (size_t)(tok0 + iq) * 1024 + 256 + hq * 64 + 4 * q4;
#pragma unroll
        for (int dt = 0; dt < 4; ++dt) { u32x2 w; w.x = pk2(o[dt][0] * rden, o[dt][1] * rden); w.y = pk2(o[dt][2] * rden, o[dt][3] * rden); *(u32x2*)(op + 16 * dt) = w; }
    }
}
__device__ __forceinline__ void gdn_prep_tok(const Ctx& c, int l, int t) {
    const Params& P = *c.P; const bf16_t* proj = (const bf16_t*)(P.ws + WS_PROJ); const int lane = c.lane, s = t % SEQ_;
    float* QN = (float*)(P.ws + WS_QN); float* KN = (float*)(P.ws + WS_KN); float* VV = (float*)(P.ws + WS_VV); float* GB = (float*)(P.ws + WS_GB);
    const float* cw = P.in[I_CONVW] + (size_t)l * 4 * 1152;
#pragma unroll 1
    for (int grp = 0; grp < 18; ++grp) { const int ch = grp * 64 + lane; float a = 0.f;
#pragma unroll
        for (int j = 0; j < 4; ++j) { const int sj = s - 3 + j; if (sj >= 0) a += cw[j * 1152 + ch] * bf2f(proj[(size_t)(t - 3 + j) * NPROJ + C_GQ + ch]); }
        a = silu_f(a);
        if (grp < 12) { const float ss = wave_sum(a * a); a = a * (1.f / sqrtf(ss + NORM_EPS_)); }
        if (grp < 6) QN[(size_t)t * 384 + ch] = a * 0.125f;
        else if (grp < 12) KN[(size_t)t * 384 + (ch - 384)] = a;
        else VV[(size_t)t * 384 + (ch - 768)] = a; }
    if (lane < 6) { const float braw = bf2f(proj[(size_t)t * NPROJ + C_GB + lane]), araw = bf2f(proj[(size_t)t * NPROJ + C_GA + lane]);
        const float xx = araw + P.in[I_DTB][l * 6 + lane]; const float sp = xx > 20.f ? xx : log1pf(__expf(xx));
        GB[(size_t)t * 12 + lane] = -__expf(P.in[I_ALOG][l * 6 + lane]) * sp; GB[(size_t)t * 12 + 6 + lane] = sigmoid_f(braw); }
}
__device__ __forceinline__ void ph_gprep(const Ctx& c, int l);
__device__ __forceinline__ void ph_gscan(const Ctx& c) {
    const Params& P = *c.P;
    const float* QN = (const float*)(P.ws + WS_QN); const float* KN = (const float*)(P.ws + WS_KN); const float* VV = (const float*)(P.ws + WS_VV); const float* GB = (const float*)(P.ws + WS_GB);
    float* OR = (float*)(P.ws + WS_OR);
    float* ks = (float*)c.lds; float* qs = ks + 4096; float* vs = qs + 4096; float* gs = vs + 4096; float* bs = gs + 64;
    const int j = c.tid >> 3, p = c.tid & 7;
    for (int item = c.bid; item < NB_ * 6; item += c.nblk) {
        const int b = item / 6, h = item % 6;
        float S[8];
#pragma unroll
        for (int i = 0; i < 8; ++i) S[i] = 0.f;
        for (int ch = 0; ch < SEQ_ / 64; ++ch) {
            const int tb = b * SEQ_ + ch * 64;
            __syncthreads();
            for (int i = c.tid; i < 4096; i += NTHREADS) { const int r = i >> 6, d = i & 63; const size_t g = (size_t)(tb + r) * 384 + h * 64 + d; ks[i] = KN[g]; qs[i] = QN[g]; vs[i] = VV[g]; }
            if (c.tid < 64) { gs[c.tid] = __expf(GB[(size_t)(tb + c.tid) * 12 + h]); bs[c.tid] = GB[(size_t)(tb + c.tid) * 12 + 6 + h]; }
            __syncthreads();
            for (int r = 0; r < 64; ++r) {
                const float eg = gs[r], be = bs[r]; float kk[8], qq[8];
#pragma unroll
                for (int i = 0; i < 8; ++i) { kk[i] = ks[r * 64 + p * 8 + i]; qq[i] = qs[r * 64 + p * 8 + i]; }
                float kS = 0.f;
#pragma unroll
                for (int i = 0; i < 8; ++i) { S[i] *= eg; kS += kk[i] * S[i]; }
                kS += __shfl_xor(kS, 1); kS += __shfl_xor(kS, 2); kS += __shfl_xor(kS, 4);
                const float dl = be * (vs[r * 64 + j] - kS); float o = 0.f;
#pragma unroll
                for (int i = 0; i < 8; ++i) { S[i] += kk[i] * dl; o += qq[i] * S[i]; }
                o += __shfl_xor(o, 1); o += __shfl_xor(o, 2); o += __shfl_xor(o, 4);
                if (p == 0) OR[(size_t)(tb + r) * 384 + h * 64 + j] = o;
            }
        }
    }
}
constexpr size_t WS_GOP = WS_QN;
constexpr size_t WS_GCD = WS_QN + 64 * MiB;
constexpr int GOP_BYTES = 40960, GOP_W = 0, GOP_QD = 8192, GOP_AT = 16384, GOP_KT = 24576, GOP_U = 32768;
constexpr int GP_HALF = 55296, GP_RAW = 0, GP_LB = 0  , GP_TD = 9216  , GP_WT = 12288, GP_KB = 25728, GP_QB = 34944, GP_VB = 44160, GP_GT = 53376, GP_ROW = 144;

__device__ __forceinline__ void gdn_prep_pair(const Ctx& c, int l, int item, bool active) {
    const Params& P = *c.P; const bf16_t* proj = (const bf16_t*)(P.ws + WS_PROJ);
    const int half = c.wave >> 2, hw = c.wave & 3, lane = c.lane, htid = c.tid & 255, qc = lane & 15, q4 = lane >> 4;
    unsigned char* L0 = c.lds + half * GP_HALF;
    bf16_t* raw = (bf16_t*)(L0 + GP_RAW); unsigned char* LB = L0 + GP_LB; unsigned char* TD = L0 + GP_TD; unsigned char* WT = L0 + GP_WT;
    unsigned char* KB = L0 + GP_KB; unsigned char* QB = L0 + GP_QB; unsigned char* VB = L0 + GP_VB;
    float* gc = (float*)(L0 + GP_GT); float* eg = gc + 64; float* bt = gc + 128;
    const int h = item % 6, n = (item / 6) & 31, b = item / 192;
    const int tb = b * SEQ_ + n * 64;
    const int ci = (b * 6 + h) * 32 + n;
    unsigned char* gop = P.ws + WS_GOP + (size_t)ci * GOP_BYTES;
    __syncthreads();
    if (active) {
        for (int idx = htid; idx < 67 * 24; idx += 256) { const int r = idx / 24, ch = idx % 24, grp = ch >> 3, c8 = ch & 7;
            u32x4 v = (u32x4){0u, 0u, 0u, 0u};
            if (n * 64 + r - 3 >= 0) v = *(const u32x4*)(proj + (size_t)(tb + r - 3) * NPROJ + C_GQ + grp * 384 + h * 64 + 8 * c8);
            *(u32x4*)((unsigned char*)raw + r * 384 + ch * 16) = v; }
        if (hw == 0) { const float braw = bf2f(proj[(size_t)(tb + lane) * NPROJ + C_GB + h]), araw = bf2f(proj[(size_t)(tb + lane) * NPROJ + C_GA + h]);
            const float xx = araw + P.in[I_DTB][l * 6 + h]; const float sp = xx > 20.f ? xx : log1pf(__expf(xx));
            float g = -__expf(P.in[I_ALOG][l * 6 + h]) * sp;
#pragma unroll
            for (int o = 1; o < 64; o <<= 1) { const float t = __shfl_up(g, o); if (lane >= o) g += t; }
            gc[lane] = g; eg[lane] = __expf(g); bt[lane] = sigmoid_f(braw); }
    }
    __syncthreads();
    if (active) {
        const float* cw = P.in[I_CONVW] + (size_t)l * 4 * 1152 + h * 64 + lane;
        float wq[4], wk[4], wv[4];
#pragma unroll
        for (int j = 0; j < 4; ++j) { wq[j] = cw[j * 1152]; wk[j] = cw[j * 1152 + 384]; wv[j] = cw[j * 1152 + 768]; }
#pragma unroll 4
        for (int ii = 16 * hw; ii < 16 * hw + 16; ++ii) { float aq = 0.f, ak = 0.f, av = 0.f;
#pragma unroll
            for (int j = 0; j < 4; ++j) { const bf16_t* rr = raw + (ii + j) * 192 + lane; aq += wq[j] * bf2f(rr[0]); ak += wk[j] * bf2f(rr[64]); av += wv[j] * bf2f(rr[128]); }
            aq = silu_f(aq); ak = silu_f(ak); av = silu_f(av);
            const float sq = wave_sum(aq * aq), sk = wave_sum(ak * ak);
            aq *= 0.125f / sqrtf(sq + NORM_EPS_); ak *= 1.f / sqrtf(sk + NORM_EPS_);
            *(bf16_t*)(QB + ii * GP_ROW + 2 * lane) = (bf16_t)f2bf(aq); *(bf16_t*)(KB + ii * GP_ROW + 2 * lane) = (bf16_t)f2bf(ak); *(bf16_t*)(VB + ii * GP_ROW + 2 * lane) = (bf16_t)f2bf(av); }
    }
    __syncthreads();
    if (active) {
        bf16x8 ka[2], qa[2];
#pragma unroll
        for (int ks = 0; ks < 2; ++ks) { ka[ks] = *(const bf16x8*)(KB + (16 * hw + qc) * GP_ROW + 64 * ks + 16 * q4); qa[ks] = *(const bf16x8*)(QB + (16 * hw + qc) * GP_ROW + 64 * ks + 16 * q4); }
        f32x4 at[4];
#pragma unroll
        for (int t = 0; t < 4; ++t) at[t] = (f32x4){0.f, 0.f, 0.f, 0.f};
#pragma unroll
        for (int ct = 0; ct < 4; ++ct) if (ct <= hw) {
            bf16x8 kb2[2];
#pragma unroll
            for (int ks = 0; ks < 2; ++ks) kb2[ks] = *(const bf16x8*)(KB + (16 * ct + qc) * GP_ROW + 64 * ks + 16 * q4);
            f32x4 acc = (f32x4){0.f, 0.f, 0.f, 0.f};
            acc = __builtin_amdgcn_mfma_f32_16x16x32_bf16(ka[0], kb2[0], acc, 0, 0, 0); acc = __builtin_amdgcn_mfma_f32_16x16x32_bf16(ka[1], kb2[1], acc, 0, 0, 0);
            { const int j = 16 * ct + qc; const float gj = gc[j];
#pragma unroll
              for (int r = 0; r < 4; ++r) { const int i = 16 * hw + 4 * q4 + r; const float lv = (i > j) ? -bt[i] * acc[r] * __expf(gc[i] - gj) : 0.f;
                  *(bf16_t*)(LB + i * GP_ROW + 2 * j) = (bf16_t)f2bf(lv); } }
            f32x4 a2 = (f32x4){0.f, 0.f, 0.f, 0.f};
            a2 = __builtin_amdgcn_mfma_f32_16x16x32_bf16(kb2[0], qa[0], a2, 0, 0, 0); a2 = __builtin_amdgcn_mfma_f32_16x16x32_bf16(kb2[1], qa[1], a2, 0, 0, 0);
            { const int i = 16 * hw + qc; const float gi = gc[i];
#pragma unroll
              for (int r = 0; r < 4; ++r) { const int j = 16 * ct + 4 * q4 + r; at[ct][r] = (i >= j) ? a2[r] * __expf(gi - gc[j]) : 0.f; } }
        }
#pragma unroll
        for (int ks = 0; ks < 2; ++ks) { u32x4 w; w.x = pk2(at[2 * ks][0], at[2 * ks][1]); w.y = pk2(at[2 * ks][2], at[2 * ks][3]); w.z = pk2(at[2 * ks + 1][0], at[2 * ks + 1][1]); w.w = pk2(at[2 * ks + 1][2], at[2 * ks + 1][3]);
            *(u32x4*)(gop + GOP_AT + (hw * 2 + ks) * 1024 + lane * 16) = w; }
    }
    __syncthreads();
    if (active) {
        { float x[16]; const int cc = lane & 15;
#pragma unroll
          for (int i = 0; i < 16; ++i) x[i] = (i == cc) ? 1.f : 0.f;
#pragma unroll
          for (int j = 0; j < 15; ++j) { const int col = __builtin_bit_cast(int, -bf2f(*(const bf16_t*)(LB + (16 * hw + cc) * GP_ROW + 2 * (16 * hw + j)))); const float xj = x[j];
#pragma unroll
              for (int i = j + 1; i < 16; ++i) x[i] -= __builtin_bit_cast(float, __builtin_amdgcn_readlane(col, i)) * xj; }
          if (lane < 16) {
#pragma unroll
              for (int i = 0; i < 16; ++i) *(bf16_t*)(TD + hw * 640 + i * 40 + 2 * cc) = (bf16_t)f2bf(x[i]); } }
    }
    __syncthreads();
    if (active) {
        bf16x8 TA[4], LA1, LA2, LA3a, LA3b;
        { const u32x2 z2 = (u32x2){0u, 0u};
#pragma unroll
          for (int r = 0; r < 4; ++r) { const u32x2 t = *(const u32x2*)(TD + r * 640 + qc * 40 + 8 * q4); TA[r] = __builtin_bit_cast(bf16x8, (u32x4){t.x, t.y, 0u, 0u}); }
          const u32x2 a10 = *(const u32x2*)(LB + (16 + qc) * GP_ROW + 8 * q4);
          const u32x2 a20 = *(const u32x2*)(LB + (32 + qc) * GP_ROW + 8 * q4), a21 = *(const u32x2*)(LB + (32 + qc) * GP_ROW + 32 + 8 * q4);
          const u32x2 a30 = *(const u32x2*)(LB + (48 + qc) * GP_ROW + 8 * q4), a31 = *(const u32x2*)(LB + (48 + qc) * GP_ROW + 32 + 8 * q4), a32 = *(const u32x2*)(LB + (48 + qc) * GP_ROW + 64 + 8 * q4);
          LA1 = __builtin_bit_cast(bf16x8, (u32x4){a10.x, a10.y, z2.x, z2.y}); LA2 = __builtin_bit_cast(bf16x8, (u32x4){a20.x, a20.y, a21.x, a21.y});
          LA3a = __builtin_bit_cast(bf16x8, (u32x4){a30.x, a30.y, a31.x, a31.y}); LA3b = __builtin_bit_cast(bf16x8, (u32x4){a32.x, a32.y, z2.x, z2.y}); }
        const f32x4 zero4 = (f32x4){0.f, 0.f, 0.f, 0.f};
#define GB1(v) __builtin_bit_cast(bf16x8, (u32x4){pk2((v)[0], (v)[1]), pk2((v)[2], (v)[3]), 0u, 0u})
#define GB2(v, w) __builtin_bit_cast(bf16x8, (u32x4){pk2((v)[0], (v)[1]), pk2((v)[2], (v)[3]), pk2((w)[0], (w)[1]), pk2((w)[2], (w)[3])})
#pragma unroll
        for (int nt = 0; nt < 2; ++nt) {
            const int n = 32 * hw + 16 * nt + qc, isw = n >> 6, nc = n & 63;
            const unsigned char* src8 = (isw ? KB : VB) + 2 * nc;
            f32x4 R[4];
#pragma unroll
            for (int rt = 0; rt < 4; ++rt)
#pragma unroll
                for (int r = 0; r < 4; ++r) { const int i = 16 * rt + 4 * q4 + r; R[rt][r] = bt[i] * (isw ? eg[i] : 1.f) * bf2f(*(const bf16_t*)(src8 + i * GP_ROW)); }
            f32x4 X0, X1, X2, X3, Y;
            X0 = __builtin_amdgcn_mfma_f32_16x16x32_bf16(TA[0], GB1(R[0]), zero4, 0, 0, 0);
            Y = __builtin_amdgcn_mfma_f32_16x16x32_bf16(LA1, GB1(X0), R[1], 0, 0, 0);
            X1 = __builtin_amdgcn_mfma_f32_16x16x32_bf16(TA[1], GB1(Y), zero4, 0, 0, 0);
            Y = __builtin_amdgcn_mfma_f32_16x16x32_bf16(LA2, GB2(X0, X1), R[2], 0, 0, 0);
            X2 = __builtin_amdgcn_mfma_f32_16x16x32_bf16(TA[2], GB1(Y), zero4, 0, 0, 0);
            Y = __builtin_amdgcn_mfma_f32_16x16x32_bf16(LA3a, GB2(X0, X1), R[3], 0, 0, 0);
            Y = __builtin_amdgcn_mfma_f32_16x16x32_bf16(LA3b, GB1(X2), Y, 0, 0, 0);
            X3 = __builtin_amdgcn_mfma_f32_16x16x32_bf16(TA[3], GB1(Y), zero4, 0, 0, 0);
            if (hw < 2) {
                unsigned char* up = gop + GOP_U + (2 * hw + nt) * 2048 + lane * 32;
                *(u32x4*)(up) = (u32x4){pk2(X0[0], X0[1]), pk2(X0[2], X0[3]), pk2(X1[0], X1[1]), pk2(X1[2], X1[3])};
                *(u32x4*)(up + 16) = (u32x4){pk2(X2[0], X2[1]), pk2(X2[2], X2[3]), pk2(X3[0], X3[1]), pk2(X3[2], X3[3])};
            } else {
                unsigned char* wp = WT + 2 * nc + (4 * q4) * GP_ROW;
#pragma unroll
                for (int r = 0; r < 4; ++r) { *(bf16_t*)(wp + (0 + r) * GP_ROW) = (bf16_t)f2bf(X0[r]); *(bf16_t*)(wp + (16 + r) * GP_ROW) = (bf16_t)f2bf(X1[r]);
                    *(bf16_t*)(wp + (32 + r) * GP_ROW) = (bf16_t)f2bf(X2[r]); *(bf16_t*)(wp + (48 + r) * GP_ROW) = (bf16_t)f2bf(X3[r]); }
            }
        }
#undef GB1
#undef GB2
        { const int mt = hw; const float e = eg[16 * mt + qc], gl = gc[63];
#pragma unroll
          for (int ks = 0; ks < 2; ++ks) { const unsigned char* qp = QB + (16 * mt + qc) * GP_ROW + 64 * ks + 8 * q4; const u32x2 lo = *(const u32x2*)(qp), hi = *(const u32x2*)(qp + 32);
              u32x4 w; w.x = pk2(bflo(lo.x) * e, bfhi(lo.x) * e); w.y = pk2(bflo(lo.y) * e, bfhi(lo.y) * e); w.z = pk2(bflo(hi.x) * e, bfhi(hi.x) * e); w.w = pk2(bflo(hi.y) * e, bfhi(hi.y) * e);
              *(u32x4*)(gop + GOP_QD + (mt * 2 + ks) * 1024 + lane * 16) = w;
              float v[8];
#pragma unroll
              for (int ee = 0; ee < 8; ++ee) { const int i = 32 * ks + 4 * q4 + (ee < 4 ? ee : 12 + ee); v[ee] = bf2f(*(const bf16_t*)(KB + i * GP_ROW + 2 * (16 * mt + qc))) * __expf(gl - gc[i]); }
              u32x4 w2; w2.x = pk2(v[0], v[1]); w2.y = pk2(v[2], v[3]); w2.z = pk2(v[4], v[5]); w2.w = pk2(v[6], v[7]);
              *(u32x4*)(gop + GOP_KT + (mt * 2 + ks) * 1024 + lane * 16) = w2; }
          if (hw == 3 && lane == 0) ((float*)(P.ws + WS_GCD))[ci] = eg[63]; }
    }
    __syncthreads();
    if (active) {
#pragma unroll
        for (int ks = 0; ks < 2; ++ks) { const unsigned char* wp = WT + (16 * hw + qc) * GP_ROW + 64 * ks + 8 * q4; const u32x2 lo = *(const u32x2*)(wp), hi = *(const u32x2*)(wp + 32);
            *(u32x4*)(gop + GOP_W + (hw * 2 + ks) * 1024 + lane * 16) = (u32x4){lo.x, lo.y, hi.x, hi.y}; }
    }
}
__device__ __forceinline__ void ph_gprep(const Ctx& c, int l) {
    const int half = c.wave >> 2, nit = NB_ * 32 * 6, npair = (nit + 1) / 2;
    for (int pr = c.bid; pr < npair; pr += c.nblk) { const int item = 2 * pr + half; gdn_prep_pair(c, l, item < nit ? item : nit - 1, item < nit); }
    __syncthreads();
}
__device__ __forceinline__ void ph_gscan2(const Ctx& c, int nscan) {
    const Params& P = *c.P; float* OR = (float*)(P.ws + WS_OR); const float* CD = (const float*)(P.ws + WS_GCD);
    const int lane = c.lane, qc = lane & 15, q4 = lane >> 4;
    if (c.wave >= 4) return;
    for (int bh = c.bid; bh < NB_ * 6; bh += nscan) {
        const int b = bh / 6, h = bh % 6, s = c.wave;
        f32x4 S[4];
#pragma unroll
        for (int t = 0; t < 4; ++t) S[t] = (f32x4){0.f, 0.f, 0.f, 0.f};
#pragma unroll 1
        for (int n = 0; n < 32; ++n) {
            const int ci = bh * 32 + n; const unsigned char* gop = P.ws + WS_GOP + (size_t)ci * GOP_BYTES;
            const float cd = CD[ci];
            bf16x8 sb[2];
#pragma unroll
            for (int ks = 0; ks < 2; ++ks) { u32x4 w; w.x = pk2(S[2 * ks][0], S[2 * ks][1]); w.y = pk2(S[2 * ks][2], S[2 * ks][3]); w.z = pk2(S[2 * ks + 1][0], S[2 * ks + 1][1]); w.w = pk2(S[2 * ks + 1][2], S[2 * ks + 1][3]); sb[ks] = __builtin_bit_cast(bf16x8, w); }
            const u32x4 u0 = *(const u32x4*)(gop + GOP_U + s * 2048 + lane * 32), u1 = *(const u32x4*)(gop + GOP_U + s * 2048 + lane * 32 + 16);
            f32x4 vn[4], o[4];
#pragma unroll
            for (int mt = 0; mt < 4; ++mt) { f32x4 p1 = (f32x4){0.f, 0.f, 0.f, 0.f}, q1 = p1;
#pragma unroll
                for (int ks = 0; ks < 2; ++ks) { const bf16x8 wf = *(const bf16x8*)(gop + GOP_W + (mt * 2 + ks) * 1024 + lane * 16), qf = *(const bf16x8*)(gop + GOP_QD + (mt * 2 + ks) * 1024 + lane * 16);
                    p1 = __builtin_amdgcn_mfma_f32_16x16x32_bf16(wf, sb[ks], p1, 0, 0, 0); q1 = __builtin_amdgcn_mfma_f32_16x16x32_bf16(qf, sb[ks], q1, 0, 0, 0); }
                const unsigned ua = (mt == 0) ? u0.x : (mt == 1) ? u0.z : (mt == 2) ? u1.x : u1.z, ub = (mt == 0) ? u0.y : (mt == 1) ? u0.w : (mt == 2) ? u1.y : u1.w;
                vn[mt] = (f32x4){bflo(ua), bfhi(ua), bflo(ub), bfhi(ub)} - p1; o[mt] = q1; }
            bf16x8 vb[2];
#pragma unroll
            for (int ks = 0; ks < 2; ++ks) { u32x4 w; w.x = pk2(vn[2 * ks][0], vn[2 * ks][1]); w.y = pk2(vn[2 * ks][2], vn[2 * ks][3]); w.z = pk2(vn[2 * ks + 1][0], vn[2 * ks + 1][1]); w.w = pk2(vn[2 * ks + 1][2], vn[2 * ks + 1][3]); vb[ks] = __builtin_bit_cast(bf16x8, w); }
#pragma unroll
            for (int mt = 0; mt < 4; ++mt) { S[mt] = S[mt] * cd;
#pragma unroll
                for (int ks = 0; ks < 2; ++ks) { const bf16x8 af = *(const bf16x8*)(gop + GOP_AT + (mt * 2 + ks) * 1024 + lane * 16), kf = *(const bf16x8*)(gop + GOP_KT + (mt * 2 + ks) * 1024 + lane * 16);
                    o[mt] = __builtin_amdgcn_mfma_f32_16x16x32_bf16(af, vb[ks], o[mt], 0, 0, 0); S[mt] = __builtin_amdgcn_mfma_f32_16x16x32_bf16(kf, vb[ks], S[mt], 0, 0, 0); } }
            float* op = OR + (size_t)(b * SEQ_ + n * 64 + 4 * q4) * 384 + h * 64 + 16 * s + qc;
#pragma unroll
            for (int mt = 0; mt < 4; ++mt)
#pragma unroll
                for (int r = 0; r < 4; ++r) op[(size_t)(16 * mt + r) * 384] = o[mt][r];
        }
    }
}
__device__ __forceinline__ void ph_gout(const Ctx& c, int l) {
    const Params& P = *c.P; const bf16_t* proj = (const bf16_t*)(P.ws + WS_PROJ); bf16_t* mix = (bf16_t*)(P.ws + WS_MIX); const float* OR = (const float*)(P.ws + WS_OR);
    const float nw = P.in[I_NORMW][l * 64 + c.lane];
    for (int t = c.gw; t < T_; t += c.ngw) {
#pragma unroll
        for (int h = 0; h < 6; ++h) { const float o = OR[(size_t)t * 384 + h * 64 + c.lane]; const float ms = wave_sum(o * o) * (1.f / 64.f);
            const float z = bf2f(proj[(size_t)t * NPROJ + C_GZ + h * 64 + c.lane]);
            mix[(size_t)t * 1024 + 640 + h * 64 + c.lane] = (bf16_t)f2bf(o * (1.f / sqrtf(ms + NORM_EPS_)) * nw * silu_f(z)); }
    }
}

template <int N, int B> __device__ __forceinline__ void xred_step(const float (&p)[N], float (&q)[N / 2], int lane) {
    const bool up = (lane & B) != 0;
#pragma unroll
    for (int i = 0; i < N / 2; ++i) { const float keep = up ? p[i + N / 2] : p[i], send = up ? p[i] : p[i + N / 2]; q[i] = keep + __shfl_xor(send, B); }
}
__device__ __forceinline__ float xred32(const float (&p)[32], int lane) {
    float a[16], b[8], c4[4], d[2], e[1];
    xred_step<32, 32>(p, a, lane); xred_step<16, 16>(a, b, lane); xred_step<8, 8>(b, c4, lane); xred_step<4, 4>(c4, d, lane); xred_step<2, 2>(d, e, lane);
    return e[0] + __shfl_xor(e[0], 1);
}
__device__ __forceinline__ void top4_store(float mylg, int lane, int* ti, float* tg, int* hist) {
    int bi[4]; float bv[4];
#pragma unroll
    for (int k = 0; k < 4; ++k) { const float best = wave_max(mylg); const unsigned long long bal = __ballot(mylg == best); const int id = (__ffsll((long long)bal) - 1) >> 1;
        if ((lane >> 1) == id) mylg = -3.0e38f;
        bi[k] = id; bv[k] = best; }
    const float e1 = __expf(bv[1] - bv[0]), e2 = __expf(bv[2] - bv[0]), e3 = __expf(bv[3] - bv[0]), inv = 1.f / (1.f + e1 + e2 + e3);
    if (lane == 0) { *(int4*)ti = make_int4(bi[0], bi[1], bi[2], bi[3]); *(f32x4*)tg = (f32x4){inv, e1 * inv, e2 * inv, e3 * inv};
        atomicAdd(&hist[bi[0]], 1); atomicAdd(&hist[bi[1]], 1); atomicAdd(&hist[bi[2]], 1); atomicAdd(&hist[bi[3]], 1); }
}
__device__ __forceinline__ void ph_ln1(const Ctx& c, int l) {
    const Params& P = *c.P; const float* mod = (const float*)(P.ws + WS_MOD) + (size_t)l * 8 * 6144;
    const float* Z = (const float*)(P.ws + WS_Z); float* X1 = (float*)(P.ws + WS_X1); bf16_t* H2 = (bf16_t*)(P.ws + WS_H2); int* TI = (int*)(P.ws + WS_TOPI); float* TG = (float*)(P.ws + WS_TOPG);
    float* wr = (float*)c.lds;
    const float* rw = P.in[I_RW] + (size_t)l * 1024 * 32;
    for (int i = c.tid; i < 32768; i += NTHREADS) { const int k = i >> 5, e = i & 31; wr[e * 1024 + k] = rw[i]; }
    __syncthreads();
    int* hist = (int*)(c.lds + 131072);
    if (c.tid < 32) hist[c.tid] = 0;
    __syncthreads();
    const float* g = P.in[I_LN1G] + l * 1024; const float* bb = P.in[I_LN1B] + l * 1024; const float rbias = P.in[I_RB][l * 32 + (c.lane >> 1)];
    for (int tp = c.gw; tp < T_ / 2; tp += c.ngw) {
        const int t0 = 2 * tp, b = t0 / SEQ_;
        f32x4 v0[4], v1[4], h0[4], h1[4];
#pragma unroll
        for (int j = 0; j < 4; ++j) { v0[j] = *(const f32x4*)(Z + (size_t)t0 * 1024 + 4 * c.lane + 256 * j); v1[j] = *(const f32x4*)(Z + (size_t)(t0 + 1) * 1024 + 4 * c.lane + 256 * j); }
        ln_rows(v0, g, bb, c.lane); ln_rows(v1, g, bb, c.lane);
#pragma unroll
        for (int j = 0; j < 4; ++j) { *(f32x4*)(X1 + (size_t)t0 * 1024 + 4 * c.lane + 256 * j) = v0[j]; *(f32x4*)(X1 + (size_t)(t0 + 1) * 1024 + 4 * c.lane + 256 * j) = v1[j]; }
        modulate(h0, v0, mod + (size_t)b * 6144 + 3072, mod + (size_t)b * 6144 + 4096, c.lane);
        modulate(h1, v1, mod + (size_t)b * 6144 + 3072, mod + (size_t)b * 6144 + 4096, c.lane);
        { unsigned char* hp = (unsigned char*)H2 + (size_t)t0 * 1024 + 4 * c.lane;
#pragma unroll
          for (int j = 0; j < 4; ++j) { *(unsigned*)(hp + 256 * j) = pk4_fp8(h0[j][0], h0[j][1], h0[j][2], h0[j][3]); *(unsigned*)(hp + 1024 + 256 * j) = pk4_fp8(h1[j][0], h1[j][1], h1[j][2], h1[j][3]); } }
        float p0[32], p1[32];
#pragma unroll
        for (int e = 0; e < 32; ++e) { float a0 = 0.f, a1 = 0.f;
            const float* wp = wr + e * 1024 + 4 * c.lane;
            if (e >= 2) asm volatile("" : "+v"(wp) : "v"(p0[e - 2]));
#pragma unroll
            for (int j = 0; j < 4; ++j) { const f32x4 w = *(const f32x4*)(wp + 256 * j);
                a0 += (h0[j][0] * w[0] + h0[j][1] * w[1]) + (h0[j][2] * w[2] + h0[j][3] * w[3]); a1 += (h1[j][0] * w[0] + h1[j][1] * w[1]) + (h1[j][2] * w[2] + h1[j][3] * w[3]); }
            p0[e] = a0; p1[e] = a1; }
        const float lg0 = xred32(p0, c.lane) + rbias, lg1 = xred32(p1, c.lane) + rbias;
        top4_store(lg0, c.lane, TI + (size_t)t0 * 4, TG + (size_t)t0 * 4, hist);
        top4_store(lg1, c.lane, TI + (size_t)(t0 + 1) * 4, TG + (size_t)(t0 + 1) * 4, hist);
    }
    __syncthreads();
    if (c.tid < 32 && hist[c.tid] != 0) atomicAdd((int*)(P.ws + WS_CTL) + CW_CNT + l * 64 + c.tid, hist[c.tid]);
    __syncthreads();
}

__device__ __forceinline__ void ph_routeb(const Ctx& c, int l) {
    const Params& P = *c.P; const int* TI = (const int*)(P.ws + WS_TOPI); int* R = (int*)(P.ws + WS_ROUTE);
    int* CNT = (int*)(P.ws + WS_CTL) + CW_CNT + l * 64; int* CUR = (int*)(P.ws + WS_CTL) + CW_CUR + l * 64;
    int* tot = (int*)c.lds; int* off = tot + 32; int* pst = off + 32; int* eid = pst + 64; int* hist = eid + 256;
    for (int seg = c.bid; seg < 256; seg += c.nblk) {
        if (c.tid < 32) { tot[c.tid] = __hip_atomic_load(CNT + c.tid, __ATOMIC_RELAXED, __HIP_MEMORY_SCOPE_AGENT); hist[c.tid] = 0; }
        if (c.tid < 256) eid[c.tid] = TI[seg * 256 + c.tid];
        __syncthreads();
        if (c.tid == 0) { int ps = 0; for (int e = 0; e < 32; ++e) { pst[e] = ps; ps += ((tot[e] + 255) >> 8) << 8; } pst[32] = ps; }
        if (c.tid < 256) atomicAdd(&hist[eid[c.tid]], 1);
        __syncthreads();
        if (c.tid < 32) off[c.tid] = hist[c.tid] ? atomicAdd(CUR + c.tid, hist[c.tid]) : 0;
        __syncthreads();
        if (c.tid < 256) { const int e = eid[c.tid]; int rank = 0; for (int q = 0; q < c.tid; ++q) rank += (eid[q] == e) ? 1 : 0;
            R[R_ROWTOK + pst[e] + off[e] + rank] = seg * 256 + c.tid; }
        if (seg == 0) {
            for (int e = 0; e < 32; ++e) { const int lo = pst[e] + tot[e], hi = pst[e + 1]; for (int q = lo + c.tid; q < hi; q += NTHREADS) R[R_ROWTOK + q] = -1; }
            const int nrb = pst[32] >> 8;
            for (int rb = c.tid; rb < nrb; rb += NTHREADS) { int e = 0; for (int q = 1; q < 32; ++q) if ((rb << 8) >= pst[q]) e = q; R[R_BLKE + rb] = e; }
            if (c.tid == 0) R[R_NRB] = nrb;
        }
        __syncthreads();
    }
}
__device__ __forceinline__ void ph_gather(const Ctx& c) {
    const Params& P = *c.P; const int* R = (const int*)(P.ws + WS_ROUTE); const bf16_t* H2 = (const bf16_t*)(P.ws + WS_H2); bf16_t* XB = (bf16_t*)(P.ws + WS_XBUF);
    const int nrows = R[R_NRB] * 256;
    for (int r = c.gw; r < nrows; r += c.ngw) { const int a = R[R_ROWTOK + r];
        u32x4 v0 = (u32x4){0u, 0u, 0u, 0u}, v1 = v0;
        if (a >= 0) { const bf16_t* src = H2 + (size_t)(a >> 2) * 1024; v0 = *(const u32x4*)(src + 8 * c.lane); v1 = *(const u32x4*)(src + 512 + 8 * c.lane); }
        *(u32x4*)(XB + (size_t)r * 1024 + 8 * c.lane) = v0; *(u32x4*)(XB + (size_t)r * 1024 + 512 + 8 * c.lane) = v1; }
}

__device__ __forceinline__ void ph_combine(const Ctx& c, int l) {
    const Params& P = *c.P; const float* mod = (const float*)(P.ws + WS_MOD) + (size_t)l * 8 * 6144;
    const float* X1 = (const float*)(P.ws + WS_X1); const bf16_t* Y4 = (const bf16_t*)(P.ws + WS_Y4); const float* TG = (const float*)(P.ws + WS_TOPG);
    float* XO = (l == DEPTH_ - 1) ? P.out : (float*)(P.ws + WS_X); bf16_t* H = (bf16_t*)(P.ws + WS_H);
    const float* g = P.in[I_LN2G] + l * 1024; const float* bb = P.in[I_LN2B] + l * 1024;
    for (int t = c.gw; t < T_; t += c.ngw) {
        const int b = t / SEQ_; const f32x4 gt = *(const f32x4*)(TG + (size_t)t * 4);
        f32x4 v[4];
#pragma unroll
        for (int j = 0; j < 4; ++j) { const int col = 4 * c.lane + 256 * j; f32x4 y = (f32x4){0.f, 0.f, 0.f, 0.f};
#pragma unroll
            for (int k = 0; k < 4; ++k) { const u32x2 w = *(const u32x2*)(Y4 + (size_t)(t * 4 + k) * 1024 + col); y += gt[k] * (f32x4){bflo(w.x), bfhi(w.x), bflo(w.y), bfhi(w.y)}; }
            const f32x4 x1 = *(const f32x4*)(X1 + (size_t)t * 1024 + col), g2 = *(const f32x4*)(mod + (size_t)b * 6144 + 5120 + col);
            v[j] = x1 * ALPHA_ + g2 * y; }
        ln_rows(v, g, bb, c.lane);
#pragma unroll
        for (int j = 0; j < 4; ++j) *(f32x4*)(XO + (size_t)t * 1024 + 4 * c.lane + 256 * j) = v[j];
        if (l + 1 < DEPTH_) { const float* m2 = (const float*)(P.ws + WS_MOD) + (size_t)(l + 1) * 8 * 6144 + (size_t)b * 6144; f32x4 h[4];
            modulate(h, v, m2, m2 + 1024, c.lane); store_bf16_row(H + (size_t)t * 1024, c.lane, h); }
    }
}

#define XB_TMO      128
#define XB_XCNT(j)  (256  + 64 * (j))
#define XB_XSUB(j)  (1280 + 64 * (j))
#define XB_XGEN(j)  (2304 + 64 * (j))
#define XB_TOP      3328
#define XB_TOPGEN   3392
#define XCD_BAR_WORDS 3456
#define XB_SPIN_CAP (1u << 18)
constexpr int CW_BAR = 4096;
constexpr int MISC_OFF = LDS_BYTES - 256;
__device__ __forceinline__ unsigned xb_ld(unsigned* p)              { return __hip_atomic_load(p, __ATOMIC_RELAXED, __HIP_MEMORY_SCOPE_AGENT); }
__device__ __forceinline__ unsigned xb_add(unsigned* p, unsigned v) { return __hip_atomic_fetch_add(p, v, __ATOMIC_RELAXED, __HIP_MEMORY_SCOPE_AGENT); }
__device__ __forceinline__ unsigned xb_xcc_id() { return (unsigned)__builtin_amdgcn_s_getreg((3 << 11) | 20) & 0xFu; }
#define XB_SPIN(cond, bar) do { unsigned _sp = 0; while (cond) { __builtin_amdgcn_s_sleep(1); \
    if ((++_sp & 255u) == 0u) { if (xb_ld(&(bar)[XB_TMO])) break; if (_sp > XB_SPIN_CAP) { atomicAdd(&(bar)[XB_TMO], 1u); break; } } } } while (0)
struct XcdBarrier { unsigned* bar; unsigned x; volatile LAS unsigned* st; };
__device__ __forceinline__ XcdBarrier xcd_barrier_post(unsigned* bar, volatile LAS unsigned* st) {
    XcdBarrier b; b.bar = bar; b.x = xb_xcc_id(); b.st = st;
    if (threadIdx.x == 0) (void)xb_add(&bar[XB_XCNT(b.x)], 1u);
    return b;
}
__device__ __forceinline__ void xcd_barrier_complete(unsigned* bar, unsigned x, unsigned& nloc, unsigned& nx) {
    const unsigned G = gridDim.x * gridDim.y * gridDim.z;
    unsigned sum, cnt, mine, sp = 0u;
    for (;;) {
        sum = 0u; cnt = 0u; mine = 0u;
#pragma unroll
        for (unsigned j = 0; j < 16; ++j) { const unsigned c = xb_ld(&bar[XB_XCNT(j)]); sum += c; cnt += (c > 0u) ? 1u : 0u; mine = (j == x) ? c : mine; }
        if (sum == G) break;
        __builtin_amdgcn_s_sleep(1);
        if ((++sp & 255u) == 0u) { if (xb_ld(&bar[XB_TMO])) break; if (sp > XB_SPIN_CAP) { atomicAdd(&bar[XB_TMO], 1u); break; } }
    }
    nloc = mine > 0u ? mine : 1u; nx = cnt > 0u ? cnt : 1u;
}
__device__ __forceinline__ void xcd_barrier(const XcdBarrier& b) {
    asm volatile("s_waitcnt vmcnt(0)" ::: "memory");
    __syncthreads();
    if (threadIdx.x == 0) {
        unsigned* bar = b.bar;
        __builtin_amdgcn_s_waitcnt(0);
        unsigned nloc = b.st[0], nx = b.st[1];
        if (nloc == 0u) { xcd_barrier_complete(bar, b.x, nloc, nx); b.st[0] = nloc; b.st[1] = nx; }
        const unsigned old = xb_add(&bar[XB_XSUB(b.x)], 1u);
        const unsigned gen = old / nloc;
        if (old + 1u == (gen + 1u) * nloc) {
            __builtin_amdgcn_fence(__ATOMIC_RELEASE, "agent");
            asm volatile("s_waitcnt vmcnt(0)" ::: "memory");
            const unsigned og = xb_add(&bar[XB_TOP], 1u);
            const unsigned tg = og / nx;
            if (og + 1u == (tg + 1u) * nx) xb_add(&bar[XB_TOPGEN], 1u);
            else XB_SPIN(xb_ld(&bar[XB_TOPGEN]) == tg, bar);
            __builtin_amdgcn_fence(__ATOMIC_ACQUIRE, "agent");
            xb_add(&bar[XB_XGEN(b.x)], 1u);
            asm volatile("s_waitcnt vmcnt(0)" ::: "memory");
        } else {
            XB_SPIN(xb_ld(&bar[XB_XGEN(b.x)]) == gen, bar);
            __builtin_amdgcn_fence(__ATOMIC_ACQUIRE, "agent");
            asm volatile("s_waitcnt vmcnt(0)" ::: "memory");
        }
    }
    __syncthreads();
}

template <int KIND>
__device__ __forceinline__ void run_kind(const Ctx& c0, int l) {
    Ctx c = c0;
    { int t = c0.tid; asm volatile("" : "+v"(t)); c.tid = t; c.lane = t & 63; c.wave = __builtin_amdgcn_readfirstlane(t >> 6); }
    { int b = c0.bid, n = c0.nblk; asm volatile("" : "+s"(b), "+s"(n)); c.bid = b; c.nblk = n; c.gw = b * NWAVES + c.wave; c.ngw = n * NWAVES; }
    { long z = 0; asm volatile("" : "+s"(z)); c.P = (const Params*)((const char*)c0.P + z); }
    const Params& P = *c.P; LAS unsigned char* lds3 = (LAS unsigned char*)c.lds;
    const int* R = (const int*)(P.ws + WS_ROUTE);
    if constexpr (KIND == 0) ph_conv(c);
    else if constexpr (KIND == 1) ph_mod(c);
    else if constexpr (KIND == 2) ph_prep0(c);
    else if constexpr (KIND == 3 + L_GEMM1) { DenseSched S{(const char*)(P.ws + WS_H), (const char*)(P.ws + WS_WIN) + (size_t)l * NPROJ * 2048, T_ / 256, NPROJ / 256, c.nblk, c.bid};
        EpiStoreBf16 E{(bf16_t*)(P.ws + WS_PROJ), NPROJ};
        pg8::gemm_phase<EpiStoreBf16, DenseSched, true, true>(lds3, S, E, c.tid); }
    else if constexpr (KIND == 3 + L_MIXA) {
        const int nscan = c.nblk > 96 ? 48 : (c.nblk > 1 ? c.nblk / 2 : 0);
        if (c.bid < nscan || c.nblk == 1) ph_gscan2(c, nscan ? nscan : 1);
        if (c.bid >= nscan) { const int nb = c.nblk - nscan; ph_pool(c, l, nscan, nb); for (int it = c.bid - nscan; it < NB_ * 16 * 2; it += nb) swa_mfma_item(c, l, it); __syncthreads(); } }
    else if constexpr (KIND == 3 + L_GPREP) ph_gprep(c, l);
    else if constexpr (KIND == 3 + L_GOUT) ph_gout(c, l);
    else if constexpr (KIND == 3 + L_GEMM2) { DenseSched S{(const char*)(P.ws + WS_MIX), (const char*)(P.ws + WS_WOUT) + (size_t)l * 1024 * 2048, T_ / 256, 4, c.nblk, c.bid};
        EpiResid E{l == 0 ? P.in[I_X] : (const float*)(P.ws + WS_X), (const float*)(P.ws + WS_MOD) + (size_t)l * 8 * 6144 + 2048, (float*)(P.ws + WS_Z)};
        pg8::gemm_phase<EpiResid, DenseSched, true, true>(lds3, S, E, c.tid); }
    else if constexpr (KIND == 3 + L_LN1) ph_ln1(c, l);
    else if constexpr (KIND == 3 + L_ROUTEB) ph_routeb(c, l);
    else if constexpr (KIND == 3 + L_GATHER) ph_gather(c);
    else if constexpr (KIND == 3 + L_UP) { MoeSched S{(const char*)(P.ws + WS_H2), (const char*)(P.ws + WS_WUP) + (size_t)l * 32 * 2048 * 1024, R + R_BLKE, R[R_NRB], 8, c.nblk, c.bid, (size_t)2048 * 1024, R + R_ROWTOK, 1, 1024};
        EpiSwiglu E{(bf16_t*)(P.ws + WS_ACT), P.in[I_BUP] + (size_t)l * 32 * 2048};
        pg8::gemm_phase<EpiSwiglu, MoeSched, true, true, true, 1, 121>(lds3, S, E, c.tid); }
    else if constexpr (KIND == 3 + L_DOWN) { MoeSched S{(const char*)(P.ws + WS_ACT), (const char*)(P.ws + WS_WDN) + (size_t)l * 32 * 1024 * 1024, R + R_BLKE, R[R_NRB], 4, c.nblk, c.bid, (size_t)1024 * 1024, R + R_ROWTOK, 0, 1024};
        EpiDown E{(bf16_t*)(P.ws + WS_Y4), P.in[I_BDN] + (size_t)l * 32 * 1024, R + R_ROWTOK};
        pg8::gemm_phase<EpiDown, MoeSched, true, true, false, 1, 120>(lds3, S, E, c.tid); }
    else if constexpr (KIND == 3 + L_COMBINE) ph_combine(c, l);
}

#define SEAM() xcd_barrier(bar)
#ifndef PROBE_KIND
#define PROBE_KIND -1
#endif
#define RK(K, L) do { run_kind<K>(c, L); if ((K) == PROBE_KIND && (L) == 0) { SEAM(); run_kind<K>(c, L); } } while (0)
template <int L> __device__ __forceinline__ void run_layer(const Ctx& c, const XcdBarrier& bar) {
    RK(3 + L_GEMM1, L); SEAM();
    RK(3 + L_GPREP, L); SEAM();
    RK(3 + L_MIXA, L); SEAM();
    RK(3 + L_GOUT, L); SEAM();
    RK(3 + L_GEMM2, L); SEAM();
    RK(3 + L_LN1, L); SEAM();
    RK(3 + L_ROUTEB, L); SEAM();
    RK(3 + L_UP, L); SEAM();
    RK(3 + L_DOWN, L); SEAM();
    RK(3 + L_COMBINE, L);
}
__global__ void __launch_bounds__(NTHREADS, 2) mk_fwd(Params P) {
    extern __shared__ __attribute__((aligned(16))) unsigned char lds[];
    Ctx c; c.P = &P; c.lds = lds; c.tid = threadIdx.x; c.lane = c.tid & 63; c.wave = __builtin_amdgcn_readfirstlane(c.tid >> 6);
    c.bid = blockIdx.x; c.nblk = gridDim.x; c.gw = c.bid * NWAVES + c.wave; c.ngw = c.nblk * NWAVES;
    for (int u = c.tid; u < 64; u += NTHREADS) ((volatile LAS unsigned*)((LAS unsigned char*)lds + MISC_OFF))[u] = 0u;
    __syncthreads();
    const XcdBarrier bar = xcd_barrier_post((unsigned*)(P.ws + WS_CTL) + CW_BAR, (volatile LAS unsigned*)((LAS unsigned char*)lds + MISC_OFF) + 8);
    RK(0, 0); __syncthreads(); RK(1, 0); SEAM();
    RK(2, 0); SEAM();
    run_layer<0>(c, bar); SEAM();
    run_layer<1>(c, bar);
}

extern "C" void kernel_launch(void* const* d_in, const int* in_sizes, int n_in, void* d_out, int out_size, void* d_ws, size_t ws_size, hipStream_t stream) {
    static int grid = 0;
    if (grid == 0) {
        if (n_in != N_IN || out_size != T_ * D_ || ws_size < WS_END) { fprintf(stderr, "kernel_launch: unexpected shapes (n_in %d out %d ws %zu need %zu)\n", n_in, out_size, ws_size, (size_t)WS_END); grid = -1; return; }
        int dev = 0, cus = 0, per_cu = 0;
        (void)hipGetDevice(&dev); (void)hipDeviceGetAttribute(&cus, hipDeviceAttributeMultiprocessorCount, dev);
        (void)hipFuncSetAttribute((const void*)mk_fwd, hipFuncAttributeMaxDynamicSharedMemorySize, LDS_BYTES);
        if (hipOccupancyMaxActiveBlocksPerMultiprocessor(&per_cu, (const void*)mk_fwd, NTHREADS, LDS_BYTES) != hipSuccess || per_cu < 1) { fprintf(stderr, "kernel_launch: occupancy query says %d blocks/CU\n", per_cu); (void)hipGetLastError(); grid = -1; return; }
        grid = cus > 0 ? cus : 256;
    }
    if (grid < 0) return;
    (void)hipMemsetAsync((char*)d_ws + WS_CTL, 0, 1 * MiB, stream);
    Params p{};
    for (int i = 0; i < N_IN; ++i) p.in[i] = (const float*)d_in[i];
    p.out = (float*)d_out; p.ws = (unsigned char*)d_ws;
    void* args[] = {&p};
    hipError_t e = hipLaunchCooperativeKernel((const void*)mk_fwd, dim3(grid), dim3(NTHREADS), args, LDS_BYTES, stream);
    if (e != hipSuccess) fprintf(stderr, "cooperative launch failed: %s (grid %d)\n", hipGetErrorString(e), grid);
}
```
